# Optimizing an MI355X kernel written in HIP

```python
import jax, jax.numpy as jnp
from jax import lax
import numpy as np

D_MODEL = 2048
BATCH = 8
SEQ = 2048
DEPTH = 1

D_MIX = D_MODEL
GM_WIDTH = D_MIX // 2
GM_GROUPS = 8
GM_DG = GM_WIDTH // GM_GROUPS
CHUNK = 128
SB_WIDTH = D_MIX - GM_WIDTH
SB_HEADS = 8
SB_HEAD_DIM = SB_WIDTH // SB_HEADS
Q_BLOCK = 128
D_FF = -(-(8 * D_MODEL) // (3 * 256)) * 256
N_IN = 2 * GM_WIDTH + 3 * SB_WIDTH
N_MOD = 6
EPS = 1e-6

kernel_name = "hybrid_gmlp_stickbreaking_adaln_block"


def rmsnorm(x, g):
    xf = x.astype(jnp.float32)
    y = xf * lax.rsqrt(jnp.mean(xf * xf, axis=-1, keepdims=True) + EPS)
    return (y * g.astype(jnp.float32)).astype(x.dtype)


def group_rmsnorm(x, g, groups):
    xf = x.astype(jnp.float32).reshape(*x.shape[:-1], groups, -1)
    y = xf * lax.rsqrt(jnp.mean(xf * xf, axis=-1, keepdims=True) + EPS)
    return (y.reshape(x.shape) * g.astype(jnp.float32)).astype(x.dtype)


def group_layernorm(x, g, groups):
    xf = x.astype(jnp.float32).reshape(*x.shape[:-1], groups, -1)
    mu = jnp.mean(xf, axis=-1, keepdims=True)
    xc = xf - mu
    y = xc * lax.rsqrt(jnp.mean(xc * xc, axis=-1, keepdims=True) + EPS)
    return (y.reshape(x.shape) * g.astype(jnp.float32)).astype(x.dtype)


def chunked_spatial_gating(z, v_norm_g, w_s, b_s):
    B, S, _ = z.shape
    u, v = z[..., :GM_WIDTH], z[..., GM_WIDTH:]
    v = group_layernorm(v, v_norm_g, GM_GROUPS)
    v = v.reshape(B, S // CHUNK, CHUNK, GM_GROUPS, GM_DG)
    causal = jnp.tril(jnp.ones((CHUNK, CHUNK), dtype=bool))
    w = jnp.where(causal[None], w_s, 0).astype(v.dtype)
    mixed = jnp.einsum('gts,bnsgd->bntgd', w, v) + b_s.T.astype(v.dtype)[None, None, :, :, None]
    return u * mixed.reshape(B, S, GM_WIDTH)


def stick_breaking_attention(q, k, v):
    B, S, H, Dh = q.shape
    scale = Dh ** -0.5
    outs = []
    for i in range(S // Q_BLOCK):
        start, end = i * Q_BLOCK, (i + 1) * Q_BLOCK
        qs, ks, vs = q[:, start:end], k[:, :end], v[:, :end]
        z = jnp.einsum('bqhd,bkhd->bhqk', qs, ks).astype(jnp.float32) * scale
        t_pos = start + jnp.arange(Q_BLOCK)[:, None]
        s_pos = jnp.arange(end)[None, :]
        mask = s_pos < t_pos
        log_beta = jax.nn.log_sigmoid(z)
        log_1m = jnp.where(mask, jax.nn.log_sigmoid(-z), 0.0)
        tail = lax.cumsum(log_1m, axis=3, reverse=True) - log_1m
        a = jnp.where(mask, jnp.exp(log_beta + tail), 0.0)
        outs.append(jnp.einsum('bhqk,bkhd->bqhd', a.astype(vs.dtype), vs))
    return jnp.concatenate(outs, axis=1)


def setup_inputs(seed: int = 0) -> dict:
    key = jax.random.key(seed)
    ks = jax.random.split(key, 16)
    f32 = jnp.float32
    n = lambda k, shape: jax.random.normal(k, shape, dtype=f32)
    return {
        "x": n(ks[0], (BATCH, SEQ, D_MODEL)),
        "c": n(ks[1], (BATCH, D_MODEL)),
        "w_ada": n(ks[2], (DEPTH, D_MODEL, N_MOD * D_MODEL)) * (0.5 * D_MODEL ** -0.5),
        "b_ada": n(ks[3], (DEPTH, N_MOD * D_MODEL)) * 0.01,
        "norm1_g": 1.0 + 0.01 * n(ks[4], (DEPTH, D_MODEL)),
        "w_in": n(ks[5], (DEPTH, D_MODEL, N_IN)) * D_MODEL ** -0.5,
        "v_norm_g": 1.0 + 0.01 * n(ks[6], (DEPTH, GM_WIDTH)),
        "w_spatial": n(ks[7], (DEPTH, GM_GROUPS, CHUNK, CHUNK)) * CHUNK ** -0.5,
        "b_spatial": 1.0 + 0.01 * n(ks[8], (DEPTH, GM_GROUPS, CHUNK)),
        "out_norm_g": 1.0 + 0.01 * n(ks[9], (DEPTH, D_MIX)),
        "w_out": n(ks[10], (DEPTH, D_MIX, D_MODEL)) * D_MIX ** -0.5,
        "norm2_g": 1.0 + 0.01 * n(ks[11], (DEPTH, D_MODEL)),
        "w_gate": n(ks[12], (DEPTH, D_MODEL, D_FF)) * D_MODEL ** -0.5,
        "w_up": n(ks[13], (DEPTH, D_MODEL, D_FF)) * D_MODEL ** -0.5,
        "w_down": n(ks[14], (DEPTH, D_FF, D_MODEL)) * D_FF ** -0.5,
        "final_g": 1.0 + 0.01 * n(ks[15], (D_MODEL,)),
    }


def reference(x, c, w_ada, b_ada, norm1_g, w_in, v_norm_g, w_spatial, b_spatial,
              out_norm_g, w_out, norm2_g, w_gate, w_up, w_down, final_g):
    B, S, _ = x.shape
    c_act = jax.nn.silu(c)
    for l in range(DEPTH):
        mod = c_act @ w_ada[l] + b_ada[l]
        shift1, scale1, gate1, shift2, scale2, gate2 = [m[:, None, :] for m in jnp.split(mod, N_MOD, axis=-1)]

        h = rmsnorm(x, norm1_g[l]) * (1.0 + scale1) + shift1
        proj = h @ w_in[l]
        z_gm = jax.nn.gelu(proj[..., :2 * GM_WIDTH], approximate=False)
        o_gm = chunked_spatial_gating(z_gm, v_norm_g[l], w_spatial[l], b_spatial[l])
        qkv = proj[..., 2 * GM_WIDTH:].reshape(B, S, 3, SB_HEADS, SB_HEAD_DIM)
        o_sb = stick_breaking_attention(qkv[:, :, 0], qkv[:, :, 1], qkv[:, :, 2]).reshape(B, S, SB_WIDTH)
        o = jnp.concatenate([o_gm, o_sb], axis=-1)
        o = group_rmsnorm(o, out_norm_g[l], GM_GROUPS + SB_HEADS)
        x = x + gate1 * (o @ w_out[l])

        h = rmsnorm(x, norm2_g[l]) * (1.0 + scale2) + shift2
        f = (jax.nn.silu(h @ w_gate[l]) * (h @ w_up[l])) @ w_down[l]
        x = x + gate2 * f
    return rmsnorm(x, final_g)
```

```cpp
#include <hip/hip_runtime.h>
#include <hip/hip_cooperative_groups.h>
#include <cstdio>
#include <cstdint>
namespace cg = cooperative_groups;
__device__ __forceinline__ int fresh_tid() { int t = threadIdx.x; asm volatile("" : "+v"(t)); return t; }
namespace pg8 {
#define PG8_LAS __attribute__((address_space(3)))
typedef unsigned short bf16_t;
typedef short bf16x8 __attribute__((ext_vector_type(8)));
typedef float f32x4 __attribute__((ext_vector_type(4)));
typedef unsigned u32x4 __attribute__((ext_vector_type(4)));
constexpr int BM = 256, BK = 64, HALF = 128, HTB = HALF * BK * 2  , STAGE_BYTES = 8 * HTB, NXCD = 8, WGM = 8;

__host__ __device__ __forceinline__ int lds_byte(int r, int c) { const int st = (r >> 4) * 2 + (c >> 5), rr = r & 15, cc = c & 31, ob = rr * 64 + cc * 2; return st * 1024 + (ob ^ (((ob >> 9) & 1) << 5)); }
__host__ __device__ __forceinline__ void stage_rc(int b, int& R, int& C) { const int st = b / 1024, sb = b % 1024, swz = sb ^ (((sb >> 9) & 1) << 5); R = (st >> 1) * 16 + swz / 64; C = (st & 1) * 32 + (swz % 64) / 2; }
__host__ __device__ __forceinline__ int perm32(int rho) { const int n = rho >> 4, i = rho & 15; return 8 * (i >> 2) + 4 * n + (i & 3); }

struct Unit { int pm, pn; };
struct Gemm { const bf16_t* A; const bf16_t* Bt; int M, N, K; };

struct StaticOrder {
    int nM, nN, nwg, G, c;
    __host__ __device__ void init(int M, int N, int G_, int c_) { nM = M / BM; nN = N / BM; nwg = nM * nN; G = G_; c = c_; }
    __host__ __device__ bool next(int i, Unit& u) const {
        const long L = (long)i * G + c; if (L >= nwg) return false;
        int wgid = (int)L; { const int q = nwg / NXCD, r = nwg % NXCD, xcd = wgid % NXCD, off = wgid / NXCD; wgid = (xcd < r ? xcd * (q + 1) : r * (q + 1) + (xcd - r) * q) + off; }
        const int nig = WGM * nN, gid = wgid / nig, fm = gid * WGM, gsz = (nM - fm) < WGM ? (nM - fm) : WGM;
        u.pm = fm + ((wgid % nig) % gsz); u.pn = (wgid % nig) / gsz; return true;
    }
    __device__ __forceinline__ void a_ready(const Unit&) const {}
    __device__ __forceinline__ void done(const Unit&) const {}
};

__device__ __forceinline__ unsigned cvt_pk_bf16(float lo, float hi) { unsigned r; asm volatile("v_cvt_pk_bf16_f32 %0, %1, %2" : "=v"(r) : "v"(lo), "v"(hi)); return r; }
typedef float f32x2 __attribute__((ext_vector_type(2)));
__device__ __forceinline__ f32x2 gelu_pk(f32x2 v) {
    const f32x2 av = __builtin_elementwise_abs(v), d = av * 0.2316418882f + 1.0f;
    f32x2 t; t.x = __builtin_amdgcn_rcpf(d.x); t.y = __builtin_amdgcn_rcpf(d.y);
    f32x2 q = t * 0.5307027145f + (-0.7265760135f); q = q * t + 0.7107068705f; q = q * t + (-0.142248368f); q = q * t + 0.127414796f; q = q * t;
    const f32x2 s = (v * v) * (-0.72134752044f);
    f32x2 e; e.x = __builtin_amdgcn_exp2f(s.x); e.y = __builtin_amdgcn_exp2f(s.y);
    const f32x2 m = v * (q * e), r = v - m;
    f32x2 o; o.x = v.x < 0.f ? m.x : r.x; o.y = v.y < 0.f ? m.y : r.y; return o;
}

struct EpiProj {
    static constexpr bool PERM = true, AFTER_DRAIN = false;
    bf16_t* O; int ldc; int gelu_tiles; int sc_lo, sc_hi; float sc;
    __device__ __forceinline__ void operator()(const f32x4 (&acc)[2][2][4][2], const Unit& u, int wr, int wc, int fr, int fq) const {
        const int row0 = u.pm * BM + wr * 64 + fr, col0 = u.pn * BM + wc * 32 + 8 * fq;
        const bool g = u.pn < gelu_tiles; const float s = (u.pn >= sc_lo && u.pn < sc_hi) ? sc : 1.f;
#pragma unroll
        for (int ai = 0; ai < 2; ++ai)
#pragma unroll
            for (int m = 0; m < 4; ++m) { bf16_t* rowp = O + (size_t)(row0 + ai * HALF + m * 16) * ldc + col0;
#pragma unroll
                for (int bj = 0; bj < 2; ++bj) { f32x4 v0 = acc[ai][bj][m][0], v1 = acc[ai][bj][m][1];
                    if (g) { f32x2 a = gelu_pk((f32x2){v0[0], v0[1]}), b = gelu_pk((f32x2){v0[2], v0[3]}), c = gelu_pk((f32x2){v1[0], v1[1]}), d = gelu_pk((f32x2){v1[2], v1[3]});
                        v0 = (f32x4){a.x, a.y, b.x, b.y}; v1 = (f32x4){c.x, c.y, d.x, d.y}; }
                    v0 = v0 * s; v1 = v1 * s; u32x4 w; w.x = cvt_pk_bf16(v0[0], v0[1]); w.y = cvt_pk_bf16(v0[2], v0[3]); w.z = cvt_pk_bf16(v1[0], v1[1]); w.w = cvt_pk_bf16(v1[2], v1[3]);
                    *(u32x4*)(rowp + bj * HALF) = w; } }
    }
};
struct EpiRes {
    static constexpr bool PERM = false, AFTER_DRAIN = false;
    const float* base; float* out; int ldc; const float* gacc; const float* gbias; float* ssp;
    __device__ __forceinline__ void operator()(const f32x4 (&acc)[2][2][4][2], const Unit& u, int wr, int wc, int fr, int fq) const {
        const int row0 = u.pm * BM + wr * 64 + fr, col0 = u.pn * BM + wc * 32 + 4 * fq;
        const int b = u.pm >> 3;
        f32x4 gv[2][2];
#pragma unroll
        for (int bj = 0; bj < 2; ++bj)
#pragma unroll
            for (int n = 0; n < 2; ++n) gv[bj][n] = *(const f32x4*)(gacc + (size_t)b * 12288 + col0 + bj * HALF + n * 16) + *(const f32x4*)(gbias + col0 + bj * HALF + n * 16);
#pragma unroll
        for (int ai = 0; ai < 2; ++ai)
#pragma unroll
            for (int m = 0; m < 4; ++m) { const int r = row0 + ai * HALF + m * 16; const size_t off = (size_t)r * ldc + col0; float ss = 0.f;
#pragma unroll
                for (int bj = 0; bj < 2; ++bj)
#pragma unroll
                    for (int n = 0; n < 2; ++n) { const f32x4 bs = *(const f32x4*)(base + off + bj * HALF + n * 16); const f32x4 o = bs + gv[bj][n] * acc[ai][bj][m][n];
                        *(f32x4*)(out + off + bj * HALF + n * 16) = o; ss += (o[0] * o[0] + o[1] * o[1]) + (o[2] * o[2] + o[3] * o[3]); }
                ss += __shfl_xor(ss, 16); ss += __shfl_xor(ss, 32);
                if (fq == 0) ssp[(size_t)r * 32 + u.pn * 4 + wc] = ss;
                asm volatile("" ::: "memory"); }
    }
};
struct EpiGU {
    static constexpr bool PERM = true, AFTER_DRAIN = false;
    bf16_t* O; int ldc;
    __device__ __forceinline__ void operator()(const f32x4 (&acc)[2][2][4][2], const Unit& u, int wr, int wc, int fr, int fq) const {
        const int row0 = u.pm * BM + wr * 64 + fr, col0 = u.pn * HALF + wc * 32 + 8 * fq;
#pragma unroll
        for (int ai = 0; ai < 2; ++ai)
#pragma unroll
            for (int m = 0; m < 4; ++m) { bf16_t* rowp = O + (size_t)(row0 + ai * HALF + m * 16) * ldc + col0; float v[8];
#pragma unroll
                for (int n = 0; n < 2; ++n)
#pragma unroll
                    for (int j = 0; j < 4; ++j) { const float g = acc[ai][0][m][n][j], up = acc[ai][1][m][n][j];
                        const float e = __builtin_amdgcn_exp2f(g * (-1.44269504089f)); v[n * 4 + j] = g * __builtin_amdgcn_rcpf(1.0f + e) * up; }
                u32x4 w; w.x = cvt_pk_bf16(v[0], v[1]); w.y = cvt_pk_bf16(v[2], v[3]); w.z = cvt_pk_bf16(v[4], v[5]); w.w = cvt_pk_bf16(v[6], v[7]);
                *(u32x4*)rowp = w; }
    }
};
template <class Epi, class Sched, bool ALIGN_EPI = false, bool SP2 = false>
__device__ __forceinline__ void gemm_phase(PG8_LAS unsigned char* lds, const Gemm g, const Sched& S, const Epi& E) {
    const int tid = fresh_tid(), wid = __builtin_amdgcn_readfirstlane(tid >> 6), lane = tid & 63, wr = wid >> 2, wc = wid & 3, fr = lane & 15, fq = lane >> 4;
    const int K = g.K, nt = K / BK;
    unsigned voffA[2], voffB[2];
#pragma unroll
    for (int i = 0; i < 2; ++i) { int R, C; stage_rc(tid * 16 + i * 8192, R, C); const int Rb = Epi::PERM ? ((R & ~31) + perm32(R & 31)) : R;
        voffA[i] = (unsigned)(R * K + C) * 2u; voffB[i] = (unsigned)(Rb * K + C) * 2u; }
    const size_t kstep = (size_t)(BK * 2);
    const size_t hstep = (size_t)HALF * K * 2;
    const size_t tstep = 2 * hstep;
    const unsigned ldsw = (unsigned)wid * 1024u;
    const int aoff = lds_byte(wr * 64 + fr, fq * 8), boff = lds_byte(wc * 32 + fr, fq * 8);
#define PG8_SA(b, h) (((b) * 2 + (h)) * HTB)
#define PG8_SB(b, h) ((4 + (b) * 2 + (h)) * HTB)
#define PG8_STAGE(bufoff, gbase, voff) do { _Pragma("unroll") for (int _i = 0; _i < 2; ++_i) \
        __builtin_amdgcn_global_load_lds((const unsigned*)((const char*)(gbase) + (voff)[_i]), (PG8_LAS unsigned*)(lds + (bufoff) + ldsw + _i * 8192), 16, 0, 0); } while (0)
#define PG8_LDA(dst, b, h) do { _Pragma("unroll") for (int m = 0; m < 4; ++m) _Pragma("unroll") for (int k = 0; k < 2; ++k) dst[m][k] = *(const PG8_LAS bf16x8*)(lds + PG8_SA(b, h) + aoff + m * 2048 + k * 1024); } while (0)
#define PG8_LDB(dst, b, h) do { _Pragma("unroll") for (int n = 0; n < 2; ++n) _Pragma("unroll") for (int k = 0; k < 2; ++k) dst[n][k] = *(const PG8_LAS bf16x8*)(lds + PG8_SB(b, h) + boff + n * 2048 + k * 1024); } while (0)
#define PG8_MMA(ai, bj, At, Bt) do { __builtin_amdgcn_s_setprio(1); _Pragma("unroll") for (int m = 0; m < 4; ++m) _Pragma("unroll") for (int n = 0; n < 2; ++n) _Pragma("unroll") for (int k = 0; k < 2; ++k) \
        acc[ai][bj][m][n] = __builtin_amdgcn_mfma_f32_16x16x32_bf16(Bt[n][k], At[m][k], acc[ai][bj][m][n], 0, 0, 0); __builtin_amdgcn_s_setprio(0); } while (0)
#define PG8_WAIT_V(n) asm volatile("s_waitcnt vmcnt(" #n ")" ::: "memory")
#define PG8_WAIT_L(n) asm volatile("s_waitcnt lgkmcnt(" #n ")" ::: "memory")
#define PG8_BAR __builtin_amdgcn_s_barrier()
#define PG8_SCHED __builtin_amdgcn_sched_barrier(0)
    Unit cur, nxt; int ui = 0;
    if (!S.next(0, cur)) return;
    f32x4 acc[2][2][4][2];
#pragma unroll
    for (int a = 0; a < 2; ++a)
#pragma unroll
        for (int b = 0; b < 2; ++b)
#pragma unroll
            for (int m = 0; m < 4; ++m)
#pragma unroll
                for (int n = 0; n < 2; ++n) acc[a][b][m][n] = (f32x4){0.f, 0.f, 0.f, 0.f};
    bf16x8 At[4][2], B0[2][2], B1[2][2];
    const char* cA = (const char*)g.A + (size_t)cur.pm * tstep; const char* cB = (const char*)g.Bt + (size_t)cur.pn * tstep;
    S.a_ready(cur);
    if constexpr (SP2) {
        PG8_STAGE(PG8_SB(0, 0), cB, voffB); PG8_STAGE(PG8_SB(0, 1), cB + hstep, voffB); PG8_STAGE(PG8_SA(0, 0), cA, voffA); PG8_STAGE(PG8_SA(0, 1), cA + hstep, voffA);
        if (wr == 1) PG8_BAR;
        PG8_WAIT_V(2); PG8_BAR;
        PG8_STAGE(PG8_SB(1, 0), cB + kstep, voffB); PG8_STAGE(PG8_SA(1, 0), cA + kstep, voffA); PG8_STAGE(PG8_SB(1, 1), cB + hstep + kstep, voffB);
        PG8_WAIT_V(6); PG8_BAR;
    } else {
        PG8_STAGE(PG8_SB(0, 0), cB, voffB); PG8_STAGE(PG8_SA(0, 0), cA, voffA); PG8_STAGE(PG8_SB(0, 1), cB + hstep, voffB); PG8_STAGE(PG8_SA(0, 1), cA + hstep, voffA);
        if (wr == 1) PG8_BAR;
        PG8_WAIT_V(4); PG8_BAR;
        PG8_STAGE(PG8_SB(1, 0), cB + kstep, voffB); PG8_STAGE(PG8_SA(1, 0), cA + kstep, voffA); PG8_STAGE(PG8_SB(1, 1), cB + hstep + kstep, voffB);
        PG8_WAIT_V(6); PG8_BAR;
    }
    for (;;) {
        const bool has_next = S.next(ui + 1, nxt);
        const char* nA = has_next ? (const char*)g.A + (size_t)nxt.pm * tstep : cA; const char* nB = has_next ? (const char*)g.Bt + (size_t)nxt.pn * tstep : cB;
        for (int t = 0; t < nt; t += 2) {
            const bool last = (t == nt - 2);
            const char* a1 = cA + (size_t)(t + 1) * kstep;
            const char* a2 = last ? nA : cA + (size_t)(t + 2) * kstep; const char* b2 = last ? nB : cB + (size_t)(t + 2) * kstep;
            const char* a3 = a2 + kstep; const char* b3 = b2 + kstep;
            if (last && has_next) S.a_ready(nxt);
            if constexpr (SP2) {
            PG8_LDB(B0, 0, 0); PG8_LDB(B1, 0, 1); PG8_SCHED; PG8_LDA(At, 0, 0); PG8_STAGE(PG8_SA(1, 1), a1 + hstep, voffA);
            PG8_WAIT_V(8); PG8_WAIT_L(0); PG8_BAR; PG8_MMA(0, 0, At, B0); PG8_MMA(0, 1, At, B1); PG8_BAR; PG8_SCHED;
            PG8_LDA(At, 0, 1); PG8_STAGE(PG8_SB(0, 0), b2, voffB); PG8_STAGE(PG8_SB(0, 1), b2 + hstep, voffB); PG8_STAGE(PG8_SA(0, 0), a2, voffA);
            PG8_WAIT_V(8); PG8_WAIT_L(0); PG8_BAR; PG8_MMA(1, 0, At, B0); PG8_MMA(1, 1, At, B1); PG8_BAR; PG8_SCHED;
            PG8_LDB(B0, 1, 0); PG8_LDB(B1, 1, 1); PG8_SCHED; PG8_LDA(At, 1, 0); PG8_STAGE(PG8_SA(0, 1), a2 + hstep, voffA);
            PG8_WAIT_V(8); PG8_WAIT_L(0); PG8_BAR; PG8_MMA(0, 0, At, B0); PG8_MMA(0, 1, At, B1); PG8_BAR; PG8_SCHED;
            PG8_LDA(At, 1, 1); PG8_STAGE(PG8_SB(1, 0), b3, voffB); PG8_STAGE(PG8_SB(1, 1), b3 + hstep, voffB); PG8_STAGE(PG8_SA(1, 0), a3, voffA);
            PG8_WAIT_V(8); PG8_WAIT_L(0); PG8_BAR; PG8_MMA(1, 0, At, B0); PG8_MMA(1, 1, At, B1); PG8_BAR; PG8_SCHED;
            } else {
            PG8_LDB(B0, 0, 0); PG8_SCHED; PG8_LDA(At, 0, 0); PG8_STAGE(PG8_SA(1, 1), a1 + hstep, voffA);
            PG8_WAIT_L(8); PG8_BAR; PG8_WAIT_L(0); PG8_MMA(0, 0, At, B0); PG8_BAR; PG8_SCHED;
            PG8_LDB(B1, 0, 1); PG8_STAGE(PG8_SB(0, 0), b2, voffB);
            PG8_BAR; PG8_WAIT_L(0); PG8_MMA(0, 1, At, B1); PG8_BAR;
            PG8_LDA(At, 0, 1); PG8_STAGE(PG8_SA(0, 0), a2, voffA);
            PG8_BAR; PG8_WAIT_L(0); PG8_MMA(1, 0, At, B0); PG8_BAR; PG8_SCHED;
            PG8_STAGE(PG8_SB(0, 1), b2 + hstep, voffB);
            PG8_WAIT_V(6); PG8_BAR; PG8_MMA(1, 1, At, B1); PG8_BAR;
            PG8_LDB(B0, 1, 0); PG8_SCHED; PG8_LDA(At, 1, 0); PG8_STAGE(PG8_SA(0, 1), a2 + hstep, voffA);
            PG8_WAIT_L(8); PG8_BAR; PG8_WAIT_L(0); PG8_MMA(0, 0, At, B0); PG8_BAR; PG8_SCHED;
            PG8_LDB(B1, 1, 1); PG8_STAGE(PG8_SB(1, 0), b3, voffB);
            PG8_BAR; PG8_WAIT_L(0); PG8_MMA(0, 1, At, B1); PG8_BAR;
            PG8_LDA(At, 1, 1); PG8_STAGE(PG8_SA(1, 0), a3, voffA);
            PG8_BAR; PG8_WAIT_L(0); PG8_MMA(1, 0, At, B0); PG8_BAR; PG8_SCHED;
            PG8_STAGE(PG8_SB(1, 1), b3 + hstep, voffB);
            PG8_WAIT_V(6); PG8_BAR; PG8_MMA(1, 1, At, B1); PG8_BAR;
            }
        }
        if constexpr (ALIGN_EPI) { if (wr == 0) PG8_BAR; }
        if constexpr (!Epi::AFTER_DRAIN) { E(acc, cur, wr, wc, fr, fq); S.done(cur); }
        if (!has_next) break;
#pragma unroll
        for (int a = 0; a < 2; ++a)
#pragma unroll
            for (int b = 0; b < 2; ++b)
#pragma unroll
                for (int m = 0; m < 4; ++m)
#pragma unroll
                    for (int n = 0; n < 2; ++n) acc[a][b][m][n] = (f32x4){0.f, 0.f, 0.f, 0.f};
        cur = nxt; cA = nA; cB = nB; ++ui;
        if constexpr (ALIGN_EPI) { if (wr == 1) PG8_BAR; }
    }
    PG8_WAIT_V(0);
    if constexpr (!ALIGN_EPI) { if (wr == 0) PG8_BAR; }
    PG8_BAR;
    if constexpr (Epi::AFTER_DRAIN) { E.fused(acc, cur, wr, wc, fr, fq, lds, wid, lane); S.done(cur); }
#undef PG8_SA
#undef PG8_SB
#undef PG8_STAGE
#undef PG8_LDA
#undef PG8_LDB
#undef PG8_MMA
#undef PG8_WAIT_V
#undef PG8_WAIT_L
#undef PG8_BAR
#undef PG8_SCHED
}
}

constexpr int NB = 8, SEQ = 2048, DM = 2048, T = NB * SEQ;
constexpr int DFF = 5632, NIN = 5120, NMOD = 6 * DM;
constexpr int NPROJ = 4096;
constexpr float EPS = 1e-6f;
constexpr int NTHREADS = 512, NWAVES = 8;
constexpr int LDS_BYTES = 147456;
constexpr float QSCALE = 0.08838834764831845f * 1.4426950408889634f;

constexpr size_t MiB = 1u << 20;
constexpr size_t WS_MOD = 0;
constexpr size_t WS_SS1 = 1 * MiB;
constexpr size_t WS_SS2 = 3 * MiB;
constexpr size_t WS_WIN = 6 * MiB;
constexpr size_t WS_WOUT = 26 * MiB;
constexpr size_t WS_WGU = 34 * MiB;
constexpr size_t WS_WDN = 78 * MiB;
constexpr size_t WS_H = 100 * MiB;
constexpr size_t WS_PROJ = 164 * MiB;
constexpr size_t WS_VT = 292 * MiB;
constexpr size_t WS_O = 324 * MiB;
constexpr size_t WS_GU = 164 * MiB;
constexpr size_t WS_END = 388 * MiB;
static_assert(WS_GU + (size_t)T * DFF * 2 <= WS_END, "ws map");

#define LAS __attribute__((address_space(3)))
typedef unsigned short bf16;
typedef unsigned v4u __attribute__((ext_vector_type(4)));
typedef unsigned v2u __attribute__((ext_vector_type(2)));
typedef float f32x4 __attribute__((ext_vector_type(4)));
typedef short bf16x8 __attribute__((ext_vector_type(8)));
typedef short bf16x4 __attribute__((ext_vector_type(4)));

__device__ __forceinline__ unsigned pk2(float lo, float hi) { return pg8::cvt_pk_bf16(lo, hi); }
__device__ __forceinline__ float bflo(unsigned w) { return __uint_as_float(w << 16); }
__device__ __forceinline__ float bfhi(unsigned w) { return __uint_as_float(w & 0xffff0000u); }
__device__ __forceinline__ float wave_sum(float v) {
#pragma unroll
    for (int o = 1; o < 64; o <<= 1) v += __shfl_xor(v, o);
    return v;
}

struct Params {
    const float *x, *c, *w_ada, *b_ada, *norm1_g, *w_in, *v_norm_g, *w_spatial, *b_spatial, *out_norm_g, *w_out, *norm2_g, *w_gate, *w_up, *w_down, *final_g;
    float* out; unsigned char* ws;
};

__device__ __forceinline__ void transpose_item(const float* W, int K, int N, bf16* WT, int k0, int n0, int drow0, LAS float* scr, int lane) {
#pragma unroll 8
    for (int i = 0; i < 32; ++i) { const int kk = 2 * i + (lane >> 5); scr[kk * 33 + (lane & 31)] = W[(size_t)(k0 + kk) * N + n0 + (lane & 31)]; }
    asm volatile("s_waitcnt lgkmcnt(0)" ::: "memory");
    const int c = lane & 7;
#pragma unroll
    for (int j = 0; j < 4; ++j) { const int n = (lane >> 3) + 8 * j; const LAS float* s = scr + (8 * c) * 33 + n;
        v4u o; o.x = pk2(s[0 * 33], s[1 * 33]); o.y = pk2(s[2 * 33], s[3 * 33]); o.z = pk2(s[4 * 33], s[5 * 33]); o.w = pk2(s[6 * 33], s[7 * 33]);
        *(v4u*)(WT + (size_t)(drow0 + n) * K + k0 + 8 * c) = o; }
    asm volatile("s_waitcnt lgkmcnt(0)" ::: "memory");
}

__device__ __forceinline__ void phase_prep(const Params& p, LAS unsigned char* lds, int vcu, int G) {
    const int tid = fresh_tid(), lane = tid & 63, wave = __builtin_amdgcn_readfirstlane(tid >> 6);
    LAS float* scr = (LAS float*)(lds + wave * 16384);
    const int gw = vcu * NWAVES + wave, NGW = G * NWAVES;
    unsigned char* ws = p.ws;
    bf16* Win = (bf16*)(ws + WS_WIN); bf16* Wout = (bf16*)(ws + WS_WOUT); bf16* Wgu = (bf16*)(ws + WS_WGU); bf16* Wdn = (bf16*)(ws + WS_WDN);
    {
        float* mod = (float*)(ws + WS_MOD);
        for (int it = gw; it < 1536; it += NGW) {
            const int kc = it / 48, cgp = it % 48, k0 = kc * 64, col = cgp * 256 + lane * 4;
#pragma unroll
            for (int b = 0; b < 8; ++b) { const float cv = p.c[b * DM + k0 + lane]; scr[b * 64 + lane] = cv / (1.0f + __expf(-cv)); }
            asm volatile("s_waitcnt lgkmcnt(0)" ::: "memory");
            f32x4 a[8];
#pragma unroll
            for (int b = 0; b < 8; ++b) a[b] = (f32x4){0.f, 0.f, 0.f, 0.f};
#pragma unroll 4
            for (int k = 0; k < 64; ++k) { const f32x4 w = *(const f32x4*)(p.w_ada + (size_t)(k0 + k) * NMOD + col);
#pragma unroll
                for (int b = 0; b < 8; ++b) { const float s = scr[b * 64 + k]; a[b] += w * s; } }
#pragma unroll
            for (int b = 0; b < 8; ++b)
#pragma unroll
                for (int j = 0; j < 4; ++j) atomicAdd(mod + b * NMOD + col + j, a[b][j]);
            asm volatile("s_waitcnt lgkmcnt(0)" ::: "memory");
        }
    }
    constexpr int I_IN = (DM / 64) * (NIN / 32), I_OUT = (DM / 64) * (DM / 32), I_G = (DM / 64) * (DFF / 32), I_D = (DFF / 64) * (DM / 32);
    constexpr int NITEMS = I_IN + I_OUT + 2 * I_G + I_D;
    for (int it = gw; it < NITEMS; it += NGW) {
        int r = it;
        if (r < I_IN) { const int nb = NIN / 32, kb = r / nb, n0 = (r % nb) * 32; transpose_item(p.w_in, DM, NIN, Win, kb * 64, n0, n0, scr, lane); continue; } r -= I_IN;
        if (r < I_OUT) { const int nb = DM / 32, kb = r / nb, n0 = (r % nb) * 32; transpose_item(p.w_out, DM, DM, Wout, kb * 64, n0, n0, scr, lane); continue; } r -= I_OUT;
        if (r < I_G) { const int nb = DFF / 32, kb = r / nb, n0 = (r % nb) * 32; transpose_item(p.w_gate, DM, DFF, Wgu, kb * 64, n0, (n0 >> 7) * 256 + (n0 & 127), scr, lane); continue; } r -= I_G;
        if (r < I_G) { const int nb = DFF / 32, kb = r / nb, n0 = (r % nb) * 32; transpose_item(p.w_up, DM, DFF, Wgu, kb * 64, n0, (n0 >> 7) * 256 + 128 + (n0 & 127), scr, lane); continue; } r -= I_G;
        { const int nb = DM / 32, kb = r / nb, n0 = (r % nb) * 32; transpose_item(p.w_down, DFF, DM, Wdn, kb * 64, n0, n0, scr, lane); }
    }
}

template <int MODE>
__device__ __forceinline__ void phase_norm_mod(const Params& p, const float* src, const float* ssp, const float* ng, int shift_chunk, bf16* dst, int vcu, int G) {
    const int tid = fresh_tid(), lane = tid & 63, wave = __builtin_amdgcn_readfirstlane(tid >> 6);
    const int gw = vcu * NWAVES + wave, NGW = G * NWAVES;
    const float* mod = (const float*)(p.ws + WS_MOD);
    for (int rb = gw; rb < T / 8; rb += NGW) {
        const int b = (rb * 8) / SEQ;
        f32x4 A[8], B[8];
#pragma unroll
        for (int j = 0; j < 8; ++j) { const int cidx = lane * 4 + 256 * j;
            const f32x4 g = *(const f32x4*)(ng + cidx);
            const f32x4 sh = *(const f32x4*)(mod + (size_t)b * NMOD + shift_chunk * DM + cidx) + *(const f32x4*)(p.b_ada + shift_chunk * DM + cidx);
            const f32x4 sc = *(const f32x4*)(mod + (size_t)b * NMOD + (shift_chunk + 1) * DM + cidx) + *(const f32x4*)(p.b_ada + (shift_chunk + 1) * DM + cidx);
            A[j] = g * (sc + 1.0f); B[j] = sh; }
        for (int rr = 0; rr < 8; ++rr) {
            const int row = rb * 8 + rr;
            const f32x4* xr = (const f32x4*)(src + (size_t)row * DM) + lane;
            f32x4 v[8]; float s = 0.f;
#pragma unroll
            for (int j = 0; j < 8; ++j) { v[j] = xr[64 * j]; s += (v[j][0] * v[j][0] + v[j][1] * v[j][1]) + (v[j][2] * v[j][2] + v[j][3] * v[j][3]); }
            float tot;
            if (MODE == 0) tot = wave_sum(s);
            else { float q = (lane < 32) ? ssp[(size_t)row * 32 + lane] : 0.f; tot = wave_sum(q); }
            const float rstd = 1.0f / sqrtf(tot * (1.0f / DM) + EPS);
            v2u* o8 = (v2u*)(dst + (size_t)row * DM) + lane;
#pragma unroll
            for (int j = 0; j < 8; ++j) { const f32x4 h = (v[j] * rstd) * A[j] + B[j]; v2u w; w.x = pk2(h[0], h[1]); w.y = pk2(h[2], h[3]); o8[64 * j] = w; }
        }
    }
}

__device__ __forceinline__ void phase_final(const Params& p, const float* ssp, int vcu, int G) {
    const int tid = fresh_tid(), lane = tid & 63, wave = __builtin_amdgcn_readfirstlane(tid >> 6);
    const int gw = vcu * NWAVES + wave, NGW = G * NWAVES;
    f32x4 g[8];
#pragma unroll
    for (int j = 0; j < 8; ++j) g[j] = *(const f32x4*)(p.final_g + lane * 4 + 256 * j);
    for (int row = gw; row < T; row += NGW) {
        f32x4* xr = (f32x4*)(p.out + (size_t)row * DM) + lane;
        f32x4 v[8];
#pragma unroll
        for (int j = 0; j < 8; ++j) v[j] = xr[64 * j];
        float q = (lane < 32) ? ssp[(size_t)row * 32 + lane] : 0.f; const float tot = wave_sum(q);
        const float rstd = 1.0f / sqrtf(tot * (1.0f / DM) + EPS);
#pragma unroll
        for (int j = 0; j < 8; ++j) xr[64 * j] = (v[j] * rstd) * g[j];
    }
}

constexpr int TP = 136;
__device__ __forceinline__ void gmlp_tile(const Params& p, LAS unsigned char* lds, int b, int n, int g) {
    const int tid = fresh_tid(), lane = tid & 63, w = __builtin_amdgcn_readfirstlane(tid >> 6), r = lane & 15, cgp = lane >> 4;
    const bf16* PROJ = (const bf16*)(p.ws + WS_PROJ); bf16* O = (bf16*)(p.ws + WS_O);
    LAS bf16* Vt = (LAS bf16*)lds;
    const int tok0 = b * SEQ + n * 128;
    {
        const int s = 16 * w + r;
        const bf16* src = PROJ + (size_t)(tok0 + s) * NPROJ + 1024 + g * 128;
        float xv[4][8]; float s1 = 0.f;
#pragma unroll
        for (int pp = 0; pp < 4; ++pp) { const v4u raw = *(const v4u*)(src + (cgp * 4 + pp) * 8);
            xv[pp][0] = bflo(raw.x); xv[pp][1] = bfhi(raw.x); xv[pp][2] = bflo(raw.y); xv[pp][3] = bfhi(raw.y); xv[pp][4] = bflo(raw.z); xv[pp][5] = bfhi(raw.z); xv[pp][6] = bflo(raw.w); xv[pp][7] = bfhi(raw.w);
#pragma unroll
            for (int j = 0; j < 8; ++j) s1 += xv[pp][j]; }
        s1 += __shfl_xor(s1, 16); s1 += __shfl_xor(s1, 32);
        const float mean = s1 * (1.0f / 128.0f); float s2 = 0.f;
#pragma unroll
        for (int pp = 0; pp < 4; ++pp)
#pragma unroll
            for (int j = 0; j < 8; ++j) { xv[pp][j] -= mean; s2 += xv[pp][j] * xv[pp][j]; }
        s2 += __shfl_xor(s2, 16); s2 += __shfl_xor(s2, 32);
        const float rstd = 1.0f / sqrtf(s2 * (1.0f / 128.0f) + EPS);
#pragma unroll
        for (int pp = 0; pp < 4; ++pp) { const int d0 = (cgp * 4 + pp) * 8;
            const f32x4 g0 = *(const f32x4*)(p.v_norm_g + g * 128 + d0), g1 = *(const f32x4*)(p.v_norm_g + g * 128 + d0 + 4);
#pragma unroll
            for (int j = 0; j < 8; ++j) { const float y = xv[pp][j] * rstd * (j < 4 ? g0[j & 3] : g1[j & 3]); Vt[(d0 + j) * TP + s] = (bf16)(pk2(y, 0.f) & 0xffffu); } }
    }
    __syncthreads();
    f32x4 acc[8];
#pragma unroll
    for (int nd = 0; nd < 8; ++nd) acc[nd] = (f32x4){0.f, 0.f, 0.f, 0.f};
    const int t = 16 * w + r;
    const float* wrow = p.w_spatial + (size_t)(g * 128 + t) * 128;
    for (int kk = 0; kk <= (w >> 1); ++kk) {
        const int s0 = kk * 32 + cgp * 8;
        const f32x4 w0 = *(const f32x4*)(wrow + s0), w1 = *(const f32x4*)(wrow + s0 + 4);
        float wv[8] = {w0[0], w0[1], w0[2], w0[3], w1[0], w1[1], w1[2], w1[3]};
#pragma unroll
        for (int j = 0; j < 8; ++j) wv[j] = (s0 + j <= t) ? wv[j] : 0.f;
        v4u wp; wp.x = pk2(wv[0], wv[1]); wp.y = pk2(wv[2], wv[3]); wp.z = pk2(wv[4], wv[5]); wp.w = pk2(wv[6], wv[7]);
        const bf16x8 wf = __builtin_bit_cast(bf16x8, wp);
#pragma unroll
        for (int nd = 0; nd < 8; ++nd) { const bf16x8 vf = *(const LAS bf16x8*)(Vt + (nd * 16 + r) * TP + s0);
            acc[nd] = __builtin_amdgcn_mfma_f32_16x16x32_bf16(vf, wf, acc[nd], 0, 0, 0); }
    }
    const float bsv = p.b_spatial[g * 128 + t];
    const bf16* urow = PROJ + (size_t)(tok0 + t) * NPROJ + g * 128 + cgp * 4;
    float ss = 0.f;
#pragma unroll
    for (int nd = 0; nd < 8; ++nd) { const v2u uw = *(const v2u*)(urow + nd * 16);
        f32x4 o; o[0] = bflo(uw.x) * (acc[nd][0] + bsv); o[1] = bfhi(uw.x) * (acc[nd][1] + bsv); o[2] = bflo(uw.y) * (acc[nd][2] + bsv); o[3] = bfhi(uw.y) * (acc[nd][3] + bsv);
        acc[nd] = o; ss += (o[0] * o[0] + o[1] * o[1]) + (o[2] * o[2] + o[3] * o[3]); }
    ss += __shfl_xor(ss, 16); ss += __shfl_xor(ss, 32);
    const float rs = 1.0f / sqrtf(ss * (1.0f / 128.0f) + EPS);
    bf16* orow = O + (size_t)(tok0 + t) * DM + g * 128 + cgp * 4;
#pragma unroll
    for (int nd = 0; nd < 8; ++nd) { const f32x4 og = *(const f32x4*)(p.out_norm_g + g * 128 + nd * 16 + cgp * 4);
        v2u wv2; wv2.x = pk2(acc[nd][0] * rs * og[0], acc[nd][1] * rs * og[1]); wv2.y = pk2(acc[nd][2] * rs * og[2], acc[nd][3] * rs * og[3]);
        *(v2u*)(orow + nd * 16) = wv2; }
    __syncthreads();
}

__device__ __forceinline__ void sb_unit(const Params& p, LAS unsigned char* lds, int b, int h, int i) {
    const int tid = fresh_tid(), lane = tid & 63, w = __builtin_amdgcn_readfirstlane(tid >> 6), r = lane & 15, cgp = lane >> 4;
    const bf16* PROJ = (const bf16*)(p.ws + WS_PROJ); const bf16* VT = (const bf16*)(p.ws + WS_VT); bf16* O = (bf16*)(p.ws + WS_O);
    LAS bf16* Ks = (LAS bf16*)lds;
    LAS bf16* Vs = (LAS bf16*)(lds + 2 * 128 * TP * 2);
    const int tok0 = b * SEQ;
    bf16x8 qf[4];
    { const bf16* qrow = PROJ + (size_t)(tok0 + i * 128 + 16 * w + r) * NPROJ + 2048 + h * 128 + cgp * 8;
#pragma unroll
      for (int kk = 0; kk < 4; ++kk) qf[kk] = *(const bf16x8*)(qrow + kk * 32); }
    const bf16* kbase = PROJ + (size_t)tok0 * NPROJ + 3072 + h * 128;
    const bf16* vbase = VT + (size_t)(h * 128) * T + tok0;
    v4u kr[4], vr[4];
#define SB_LOAD(jb) do { _Pragma("unroll") for (int pp = 0; pp < 4; ++pp) { const int c = tid + 512 * pp, rw = c >> 4, pc = c & 15; \
        kr[pp] = *(const v4u*)(kbase + (size_t)((jb) * 128 + rw) * NPROJ + pc * 8); vr[pp] = *(const v4u*)(vbase + (size_t)rw * T + (jb) * 128 + pc * 8); } } while (0)
#define SB_STORE(buf) do { _Pragma("unroll") for (int pp = 0; pp < 4; ++pp) { const int c = tid + 512 * pp, rw = c >> 4, pc = c & 15; \
        *(LAS v4u*)(Ks + ((buf) * 128 + rw) * TP + pc * 8) = kr[pp]; *(LAS v4u*)(Vs + ((buf) * 128 + rw) * TP + pc * 8) = vr[pp]; } } while (0)
    f32x4 oacc[8];
#pragma unroll
    for (int nd = 0; nd < 8; ++nd) oacc[nd] = (f32x4){0.f, 0.f, 0.f, 0.f};
    float carry = 0.f;
    SB_LOAD(i); SB_STORE(0);
    __syncthreads();
    for (int jb = i; jb >= 0; --jb) {
        const int cur = (i - jb) & 1;
        if (jb > 0) SB_LOAD(jb - 1);
        f32x4 z[8];
#pragma unroll
        for (int n = 0; n < 8; ++n) { z[n] = (f32x4){0.f, 0.f, 0.f, 0.f};
#pragma unroll
            for (int kk = 0; kk < 4; ++kk) { const bf16x8 kf = *(const LAS bf16x8*)(Ks + (cur * 128 + n * 16 + r) * TP + kk * 32 + cgp * 8);
                z[n] = __builtin_amdgcn_mfma_f32_16x16x32_bf16(kf, qf[kk], z[n], 0, 0, 0); } }
        const bool diag = (jb == i);
        f32x4 lb[8]; float P[8];
#pragma unroll
        for (int n = 0; n < 8; ++n) { float ps = 0.f;
#pragma unroll
            for (int jj = 0; jj < 4; ++jj) { const float zz = z[n][jj];
                const float e = __builtin_amdgcn_exp2f(-fabsf(zz)); const float lg = __builtin_amdgcn_logf(1.0f + e);
                const float l = fminf(zz, 0.f) - lg; float l1 = l - zz;
                if (diag) { const bool valid = (16 * n + 4 * cgp + jj) < (16 * w + r); l1 = valid ? l1 : 0.f; }
                lb[n][jj] = l; z[n][jj] = l1; ps += l1; }
            P[n] = ps; }
        float run = carry;
#pragma unroll
        for (int n = 7; n >= 0; --n) {
            const float x1 = __shfl_xor(P[n], 16); const float pp2 = P[n] + x1; const float x2 = __shfl_xor(pp2, 32);
            const float sgt = ((cgp & 1) ? 0.f : x1) + ((cgp & 2) ? 0.f : x2);
            float tl = run + sgt; run += pp2 + x2;
            float a3 = __builtin_amdgcn_exp2f(lb[n][3] + tl); tl += z[n][3];
            float a2 = __builtin_amdgcn_exp2f(lb[n][2] + tl); tl += z[n][2];
            float a1 = __builtin_amdgcn_exp2f(lb[n][1] + tl); tl += z[n][1];
            float a0 = __builtin_amdgcn_exp2f(lb[n][0] + tl);
            if (diag) { const int sb = 16 * n + 4 * cgp, tt = 16 * w + r;
                a0 = (sb + 0 < tt) ? a0 : 0.f; a1 = (sb + 1 < tt) ? a1 : 0.f; a2 = (sb + 2 < tt) ? a2 : 0.f; a3 = (sb + 3 < tt) ? a3 : 0.f; }
            z[n][0] = a0; z[n][1] = a1; z[n][2] = a2; z[n][3] = a3;
        }
        carry = run;
#pragma unroll
        for (int m = 0; m < 4; ++m) {
            v4u pw; pw.x = pk2(z[2 * m][0], z[2 * m][1]); pw.y = pk2(z[2 * m][2], z[2 * m][3]); pw.z = pk2(z[2 * m + 1][0], z[2 * m + 1][1]); pw.w = pk2(z[2 * m + 1][2], z[2 * m + 1][3]);
            const bf16x8 pf = __builtin_bit_cast(bf16x8, pw);
#pragma unroll
            for (int nd = 0; nd < 8; ++nd) { const LAS bf16* vp = Vs + (cur * 128 + nd * 16 + r) * TP + 32 * m + 4 * cgp;
                const v2u lo = *(const LAS v2u*)vp, hi = *(const LAS v2u*)(vp + 16);
                v4u vw; vw.x = lo.x; vw.y = lo.y; vw.z = hi.x; vw.w = hi.y;
                oacc[nd] = __builtin_amdgcn_mfma_f32_16x16x32_bf16(__builtin_bit_cast(bf16x8, vw), pf, oacc[nd], 0, 0, 0); }
        }
        if (jb > 0) SB_STORE(cur ^ 1);
        __syncthreads();
    }
#undef SB_LOAD
#undef SB_STORE
    float ss = 0.f;
#pragma unroll
    for (int nd = 0; nd < 8; ++nd) ss += (oacc[nd][0] * oacc[nd][0] + oacc[nd][1] * oacc[nd][1]) + (oacc[nd][2] * oacc[nd][2] + oacc[nd][3] * oacc[nd][3]);
    ss += __shfl_xor(ss, 16); ss += __shfl_xor(ss, 32);
    const float rs = 1.0f / sqrtf(ss * (1.0f / 128.0f) + EPS);
    bf16* orow = O + (size_t)(tok0 + i * 128 + 16 * w + r) * DM + 1024 + h * 128 + cgp * 4;
#pragma unroll
    for (int nd = 0; nd < 8; ++nd) { const f32x4 og = *(const f32x4*)(p.out_norm_g + 1024 + h * 128 + nd * 16 + cgp * 4);
        v2u wv2; wv2.x = pk2(oacc[nd][0] * rs * og[0], oacc[nd][1] * rs * og[1]); wv2.y = pk2(oacc[nd][2] * rs * og[2], oacc[nd][3] * rs * og[3]);
        *(v2u*)(orow + nd * 16) = wv2; }
}

__device__ __forceinline__ void phase_mixers(const Params& p, LAS unsigned char* lds, int vcu, int G) {
    for (int pr = vcu; pr < 512; pr += G) {
        const int bh = pr >> 3, ip = pr & 7, b = bh >> 3, h = bh & 7;
        sb_unit(p, lds, b, h, 15 - ip);
        sb_unit(p, lds, b, h, ip);
    }
    for (int tl = vcu; tl < 1024; tl += G) { const int g = tl & 7, n = (tl >> 3) & 15, b = tl >> 7; gmlp_tile(p, lds, b, n, g); }
}

#ifndef PH_MASK
#define PH_MASK 0x3ff
#endif
#define PH(k) if constexpr ((PH_MASK >> (k)) & 1)
__global__ void __launch_bounds__(NTHREADS, 2) fwd_megakernel(Params p) {
    extern __shared__ __attribute__((aligned(16))) unsigned char lds_raw[];
    LAS unsigned char* lds = (LAS unsigned char*)lds_raw;
    cg::grid_group grid = cg::this_grid();
    const int G = gridDim.x, bx = blockIdx.x;
    const int vcu = (G % 8 == 0) ? (bx % 8) * (G / 8) + bx / 8 : bx;
    unsigned char* ws = p.ws;
    bf16* Win = (bf16*)(ws + WS_WIN); bf16* Wout = (bf16*)(ws + WS_WOUT); bf16* Wgu = (bf16*)(ws + WS_WGU); bf16* Wdn = (bf16*)(ws + WS_WDN);
    bf16* H = (bf16*)(ws + WS_H); bf16* PROJ = (bf16*)(ws + WS_PROJ); bf16* VT = (bf16*)(ws + WS_VT); bf16* O = (bf16*)(ws + WS_O); bf16* GU = (bf16*)(ws + WS_GU);
    float* mod = (float*)(ws + WS_MOD); float* SS1 = (float*)(ws + WS_SS1); float* SS2 = (float*)(ws + WS_SS2);

    PH(0) phase_prep(p, lds, vcu, G);
    grid.sync();
    PH(1) phase_norm_mod<0>(p, p.x, nullptr, p.norm1_g, 0, H, vcu, G);
    grid.sync();
    PH(2) {
        pg8::Gemm g{H, Win, T, NPROJ, DM}; pg8::StaticOrder S; S.init(T, NPROJ, G, bx);
        pg8::EpiProj E{PROJ, NPROJ, 8, 8, 12, QSCALE};
        pg8::gemm_phase<pg8::EpiProj, pg8::StaticOrder, true, true>(lds, g, S, E);
    }
    PH(9) {
        pg8::Gemm g{Win + (size_t)NPROJ * DM, H, 1024, T, DM}; pg8::StaticOrder S; S.init(1024, T, G, bx);
        pg8::EpiProj E{VT, T, 0, 0, 0, 1.f};
        pg8::gemm_phase<pg8::EpiProj, pg8::StaticOrder, true, true>(lds, g, S, E);
    }
    grid.sync();
    PH(3) phase_mixers(p, lds, vcu, G);
    grid.sync();
    PH(4) {
        pg8::Gemm g{O, Wout, T, DM, DM}; pg8::StaticOrder S; S.init(T, DM, G, bx);
        pg8::EpiRes E{p.x, p.out, DM, mod + 2 * DM, p.b_ada + 2 * DM, SS1};
        pg8::gemm_phase<pg8::EpiRes, pg8::StaticOrder, true, true>(lds, g, S, E);
    }
    grid.sync();
    PH(5) phase_norm_mod<1>(p, p.out, SS1, p.norm2_g, 3, H, vcu, G);
    grid.sync();
    PH(6) {
        pg8::Gemm g{H, Wgu, T, 2 * DFF, DM}; pg8::StaticOrder S; S.init(T, 2 * DFF, G, bx);
        pg8::EpiGU E{GU, DFF};
        pg8::gemm_phase<pg8::EpiGU, pg8::StaticOrder, true, true>(lds, g, S, E);
    }
    grid.sync();
    PH(7) {
        pg8::Gemm g{GU, Wdn, T, DM, DFF}; pg8::StaticOrder S; S.init(T, DM, G, bx);
        pg8::EpiRes E{p.out, p.out, DM, mod + 5 * DM, p.b_ada + 5 * DM, SS2};
        pg8::gemm_phase<pg8::EpiRes, pg8::StaticOrder, true, true>(lds, g, S, E);
    }
    grid.sync();
    PH(8) phase_final(p, SS2, vcu, G);
}

extern "C" void kernel_launch(void* const* d_in, const int* in_sizes, int n_in, void* d_out, int out_size, void* d_ws, size_t ws_size, hipStream_t stream) {
    static int grid_blocks = 0;
    if (grid_blocks == 0) {
        if (n_in != 16 || ws_size < WS_END) { fprintf(stderr, "kernel_launch: unexpected n_in %d / ws_size %zu (need %zu)\n", n_in, ws_size, (size_t)WS_END); grid_blocks = -1; return; }
        int dev = 0, cus = 0, per_cu = 0;
        hipGetDevice(&dev);
        hipDeviceGetAttribute(&cus, hipDeviceAttributeMultiprocessorCount, dev);
        if (hipFuncSetAttribute((const void*)fwd_megakernel, hipFuncAttributeMaxDynamicSharedMemorySize, LDS_BYTES) != hipSuccess) { fprintf(stderr, "kernel_launch: hipFuncSetAttribute failed\n"); grid_blocks = -1; return; }
        if (hipOccupancyMaxActiveBlocksPerMultiprocessor(&per_cu, (const void*)fwd_megakernel, NTHREADS, LDS_BYTES) != hipSuccess || per_cu < 1) { fprintf(stderr, "kernel_launch: occupancy query says %d\n", per_cu); per_cu = 1; }
        (void)hipGetLastError();
        grid_blocks = cus * 1;
    }
    if (grid_blocks < 0) return;
    hipMemsetAsync((char*)d_ws + WS_MOD, 0, (size_t)NB * NMOD * sizeof(float), stream);
    Params p{};
    p.x = (const float*)d_in[0]; p.c = (const float*)d_in[1]; p.w_ada = (const float*)d_in[2]; p.b_ada = (const float*)d_in[3]; p.norm1_g = (const float*)d_in[4];
    p.w_in = (const float*)d_in[5]; p.v_norm_g = (const float*)d_in[6]; p.w_spatial = (const float*)d_in[7]; p.b_spatial = (const float*)d_in[8]; p.out_norm_g = (const float*)d_in[9];
    p.w_out = (const float*)d_in[10]; p.norm2_g = (const float*)d_in[11]; p.w_gate = (const float*)d_in[12]; p.w_up = (const float*)d_in[13]; p.w_down = (const float*)d_in[14]; p.final_g = (const float*)d_in[15];
    p.out = (float*)d_out; p.ws = (unsigned char*)d_ws;
    void* args[] = {&p};
    hipError_t e = hipLaunchCooperativeKernel((const void*)fwd_megakernel, dim3(grid_blocks), dim3(NTHREADS), args, LDS_BYTES, stream);
    if (e != hipSuccess) fprintf(stderr, "cooperative launch failed: %s (grid %d)\n", hipGetErrorString(e), grid_blocks);
}
```

```cpp
#define DUP_MASK 0x0
#include <hip/hip_runtime.h>
#include <hip/hip_cooperative_groups.h>
#include <cstdio>
#include <cstdint>
namespace cg = cooperative_groups;
__device__ __forceinline__ int fresh_tid() { int t = threadIdx.x; asm volatile("" : "+v"(t)); return t; }
namespace pg8 {
#define PG8_LAS __attribute__((address_space(3)))
typedef unsigned short bf16_t;
typedef short bf16x8 __attribute__((ext_vector_type(8)));
typedef float f32x4 __attribute__((ext_vector_type(4)));
typedef unsigned u32x4 __attribute__((ext_vector_type(4)));
constexpr int BM = 256, BK = 64, HALF = 128, HTB = HALF * BK * 2  , STAGE_BYTES = 8 * HTB, NXCD = 8, WGM = 8;

__host__ __device__ __forceinline__ int lds_byte(int r, int c) { const int st = (r >> 4) * 2 + (c >> 5), rr = r & 15, cc = c & 31, ob = rr * 64 + cc * 2; return st * 1024 + (ob ^ (((ob >> 9) & 1) << 5)); }
__host__ __device__ __forceinline__ void stage_rc(int b, int& R, int& C) { const int st = b / 1024, sb = b % 1024, swz = sb ^ (((sb >> 9) & 1) << 5); R = (st >> 1) * 16 + swz / 64; C = (st & 1) * 32 + (swz % 64) / 2; }
__host__ __device__ __forceinline__ int perm32(int rho) { const int n = rho >> 4, i = rho & 15; return 8 * (i >> 2) + 4 * n + (i & 3); }

struct Unit { int pm, pn; };
struct Gemm { const bf16_t* A; const bf16_t* Bt; int M, N, K; };

struct StaticOrder {
    int nM, nN, nwg, G, c;
    __host__ __device__ void init(int M, int N, int G_, int c_) { nM = M / BM; nN = N / BM; nwg = nM * nN; G = G_; c = c_; }
    __host__ __device__ bool next(int i, Unit& u) const {
        const long L = (long)i * G + c; if (L >= nwg) return false;
        int wgid = (int)L; { const int q = nwg / NXCD, r = nwg % NXCD, xcd = wgid % NXCD, off = wgid / NXCD; wgid = (xcd < r ? xcd * (q + 1) : r * (q + 1) + (xcd - r) * q) + off; }
        const int nig = WGM * nN, gid = wgid / nig, fm = gid * WGM, gsz = (nM - fm) < WGM ? (nM - fm) : WGM;
        u.pm = fm + ((wgid % nig) % gsz); u.pn = (wgid % nig) / gsz; return true;
    }
    __device__ __forceinline__ void a_ready(const Unit&) const {}
    __device__ __forceinline__ void done(const Unit&) const {}
};

__device__ __forceinline__ unsigned cvt_pk_bf16(float lo, float hi) { unsigned r; asm volatile("v_cvt_pk_bf16_f32 %0, %1, %2" : "=v"(r) : "v"(lo), "v"(hi)); return r; }
typedef float f32x2 __attribute__((ext_vector_type(2)));
__device__ __forceinline__ f32x2 gelu_pk(f32x2 v) {
    const f32x2 av = __builtin_elementwise_abs(v), d = av * 0.2316418882f + 1.0f;
    f32x2 t; t.x = __builtin_amdgcn_rcpf(d.x); t.y = __builtin_amdgcn_rcpf(d.y);
    f32x2 q = t * 0.5307027145f + (-0.7265760135f); q = q * t + 0.7107068705f; q = q * t + (-0.142248368f); q = q * t + 0.127414796f; q = q * t;
    const f32x2 s = (v * v) * (-0.72134752044f);
    f32x2 e; e.x = __builtin_amdgcn_exp2f(s.x); e.y = __builtin_amdgcn_exp2f(s.y);
    const f32x2 m = v * (q * e), r = v - m;
    f32x2 o; o.x = v.x < 0.f ? m.x : r.x; o.y = v.y < 0.f ? m.y : r.y; return o;
}

struct EpiProj {
    static constexpr bool PERM = true, AFTER_DRAIN = false;
    bf16_t* O; int ldc; int gelu_tiles; int sc_lo, sc_hi; float sc;
    __device__ __forceinline__ void operator()(const f32x4 (&acc)[2][2][4][2], const Unit& u, int wr, int wc, int fr, int fq) const {
        const int row0 = u.pm * BM + wr * 64 + fr, col0 = u.pn * BM + wc * 32 + 8 * fq;
        const bool g = u.pn < gelu_tiles; const float s = (u.pn >= sc_lo && u.pn < sc_hi) ? sc : 1.f;
#pragma unroll
        for (int ai = 0; ai < 2; ++ai)
#pragma unroll
            for (int m = 0; m < 4; ++m) { bf16_t* rowp = O + (size_t)(row0 + ai * HALF + m * 16) * ldc + col0;
#pragma unroll
                for (int bj = 0; bj < 2; ++bj) { f32x4 v0 = acc[ai][bj][m][0], v1 = acc[ai][bj][m][1];
                    if (g) { f32x2 a = gelu_pk((f32x2){v0[0], v0[1]}), b = gelu_pk((f32x2){v0[2], v0[3]}), c = gelu_pk((f32x2){v1[0], v1[1]}), d = gelu_pk((f32x2){v1[2], v1[3]});
                        v0 = (f32x4){a.x, a.y, b.x, b.y}; v1 = (f32x4){c.x, c.y, d.x, d.y}; }
                    v0 = v0 * s; v1 = v1 * s; u32x4 w; w.x = cvt_pk_bf16(v0[0], v0[1]); w.y = cvt_pk_bf16(v0[2], v0[3]); w.z = cvt_pk_bf16(v1[0], v1[1]); w.w = cvt_pk_bf16(v1[2], v1[3]);
                    *(u32x4*)(rowp + bj * HALF) = w; } }
    }
};
struct EpiRes {
    static constexpr bool PERM = false, AFTER_DRAIN = false;
    const float* base; float* out; int ldc; const float* gacc; float* ssp;
    __device__ __forceinline__ void operator()(const f32x4 (&acc)[2][2][4][2], const Unit& u, int wr, int wc, int fr, int fq) const {
        const int row0 = u.pm * BM + wr * 64 + fr, col0 = u.pn * BM + wc * 32 + 4 * fq;
        const int b = u.pm >> 3;
        f32x4 gv[2][2];
#pragma unroll
        for (int bj = 0; bj < 2; ++bj)
#pragma unroll
            for (int n = 0; n < 2; ++n) gv[bj][n] = *(const f32x4*)(gacc + (size_t)b * 12288 + col0 + bj * HALF + n * 16);
#pragma unroll
        for (int ai = 0; ai < 2; ++ai)
#pragma unroll
            for (int m = 0; m < 4; ++m) { const int r = row0 + ai * HALF + m * 16; const size_t off = (size_t)r * ldc + col0; float ss = 0.f;
#pragma unroll
                for (int bj = 0; bj < 2; ++bj)
#pragma unroll
                    for (int n = 0; n < 2; ++n) { const f32x4 bs = *(const f32x4*)(base + off + bj * HALF + n * 16); const f32x4 o = bs + gv[bj][n] * acc[ai][bj][m][n];
                        *(f32x4*)(out + off + bj * HALF + n * 16) = o; ss += (o[0] * o[0] + o[1] * o[1]) + (o[2] * o[2] + o[3] * o[3]); }
                ss += __shfl_xor(ss, 16); ss += __shfl_xor(ss, 32);
                if (fq == 0) ssp[(size_t)r * 32 + u.pn * 4 + wc] = ss;
                asm volatile("" ::: "memory"); }
    }
};
struct EpiGU {
    static constexpr bool PERM = true, AFTER_DRAIN = false;
    bf16_t* O; int ldc;
    __device__ __forceinline__ void operator()(const f32x4 (&acc)[2][2][4][2], const Unit& u, int wr, int wc, int fr, int fq) const {
        const int row0 = u.pm * BM + wr * 64 + fr, col0 = u.pn * HALF + wc * 32 + 8 * fq;
#pragma unroll
        for (int ai = 0; ai < 2; ++ai)
#pragma unroll
            for (int m = 0; m < 4; ++m) { bf16_t* rowp = O + (size_t)(row0 + ai * HALF + m * 16) * ldc + col0; float v[8];
#pragma unroll
                for (int n = 0; n < 2; ++n)
#pragma unroll
                    for (int j = 0; j < 4; ++j) { const float g = acc[ai][0][m][n][j], up = acc[ai][1][m][n][j];
                        const float e = __builtin_amdgcn_exp2f(g * (-1.44269504089f)); v[n * 4 + j] = g * __builtin_amdgcn_rcpf(1.0f + e) * up; }
                u32x4 w; w.x = cvt_pk_bf16(v[0], v[1]); w.y = cvt_pk_bf16(v[2], v[3]); w.z = cvt_pk_bf16(v[4], v[5]); w.w = cvt_pk_bf16(v[6], v[7]);
                *(u32x4*)rowp = w; }
    }
};
template <class Epi, class Sched, bool ALIGN_EPI = false, bool SP2 = false>
__device__ __forceinline__ void gemm_phase(PG8_LAS unsigned char* lds, const Gemm g, const Sched& S, const Epi& E) {
    const int tid = fresh_tid(), wid = __builtin_amdgcn_readfirstlane(tid >> 6), lane = tid & 63, wr = wid >> 2, wc = wid & 3, fr = lane & 15, fq = lane >> 4;
    const int K = g.K, nt = K / BK;
    unsigned voffA[2], voffB[2];
#pragma unroll
    for (int i = 0; i < 2; ++i) { int R, C; stage_rc(tid * 16 + i * 8192, R, C); const int Rb = Epi::PERM ? ((R & ~31) + perm32(R & 31)) : R;
        voffA[i] = (unsigned)(R * K + C) * 2u; voffB[i] = (unsigned)(Rb * K + C) * 2u; }
    const size_t kstep = (size_t)(BK * 2);
    const size_t hstep = (size_t)HALF * K * 2;
    const size_t tstep = 2 * hstep;
    const unsigned ldsw = (unsigned)wid * 1024u;
    const int aoff = lds_byte(wr * 64 + fr, fq * 8), boff = lds_byte(wc * 32 + fr, fq * 8);
#define PG8_SA(b, h) (((b) * 2 + (h)) * HTB)
#define PG8_SB(b, h) ((4 + (b) * 2 + (h)) * HTB)
#define PG8_STAGE(bufoff, gbase, voff) do { _Pragma("unroll") for (int _i = 0; _i < 2; ++_i) \
        __builtin_amdgcn_global_load_lds((const unsigned*)((const char*)(gbase) + (voff)[_i]), (PG8_LAS unsigned*)(lds + (bufoff) + ldsw + _i * 8192), 16, 0, 0); } while (0)
#define PG8_LDA(dst, b, h) do { _Pragma("unroll") for (int m = 0; m < 4; ++m) _Pragma("unroll") for (int k = 0; k < 2; ++k) dst[m][k] = *(const PG8_LAS bf16x8*)(lds + PG8_SA(b, h) + aoff + m * 2048 + k * 1024); } while (0)
#define PG8_LDB(dst, b, h) do { _Pragma("unroll") for (int n = 0; n < 2; ++n) _Pragma("unroll") for (int k = 0; k < 2; ++k) dst[n][k] = *(const PG8_LAS bf16x8*)(lds + PG8_SB(b, h) + boff + n * 2048 + k * 1024); } while (0)
#define PG8_MMA(ai, bj, At, Bt) do { __builtin_amdgcn_s_setprio(1); _Pragma("unroll") for (int m = 0; m < 4; ++m) _Pragma("unroll") for (int n = 0; n < 2; ++n) _Pragma("unroll") for (int k = 0; k < 2; ++k) \
        acc[ai][bj][m][n] = __builtin_amdgcn_mfma_f32_16x16x32_bf16(Bt[n][k], At[m][k], acc[ai][bj][m][n], 0, 0, 0); __builtin_amdgcn_s_setprio(0); } while (0)
#define PG8_WAIT_V(n) asm volatile("s_waitcnt vmcnt(" #n ")" ::: "memory")
#define PG8_WAIT_L(n) asm volatile("s_waitcnt lgkmcnt(" #n ")" ::: "memory")
#define PG8_BAR __builtin_amdgcn_s_barrier()
#define PG8_SCHED __builtin_amdgcn_sched_barrier(0)
    Unit cur, nxt; int ui = 0;
    if (!S.next(0, cur)) return;
    f32x4 acc[2][2][4][2];
#pragma unroll
    for (int a = 0; a < 2; ++a)
#pragma unroll
        for (int b = 0; b < 2; ++b)
#pragma unroll
            for (int m = 0; m < 4; ++m)
#pragma unroll
                for (int n = 0; n < 2; ++n) acc[a][b][m][n] = (f32x4){0.f, 0.f, 0.f, 0.f};
    bf16x8 At[4][2], B0[2][2], B1[2][2];
    const char* cA = (const char*)g.A + (size_t)cur.pm * tstep; const char* cB = (const char*)g.Bt + (size_t)cur.pn * tstep;
    S.a_ready(cur);
    if constexpr (SP2) {
        PG8_STAGE(PG8_SB(0, 0), cB, voffB); PG8_STAGE(PG8_SB(0, 1), cB + hstep, voffB); PG8_STAGE(PG8_SA(0, 0), cA, voffA); PG8_STAGE(PG8_SA(0, 1), cA + hstep, voffA);
        if (wr == 1) PG8_BAR;
        PG8_WAIT_V(2); PG8_BAR;
        PG8_STAGE(PG8_SB(1, 0), cB + kstep, voffB); PG8_STAGE(PG8_SA(1, 0), cA + kstep, voffA); PG8_STAGE(PG8_SB(1, 1), cB + hstep + kstep, voffB);
        PG8_WAIT_V(6); PG8_BAR;
    } else {
        PG8_STAGE(PG8_SB(0, 0), cB, voffB); PG8_STAGE(PG8_SA(0, 0), cA, voffA); PG8_STAGE(PG8_SB(0, 1), cB + hstep, voffB); PG8_STAGE(PG8_SA(0, 1), cA + hstep, voffA);
        if (wr == 1) PG8_BAR;
        PG8_WAIT_V(4); PG8_BAR;
        PG8_STAGE(PG8_SB(1, 0), cB + kstep, voffB); PG8_STAGE(PG8_SA(1, 0), cA + kstep, voffA); PG8_STAGE(PG8_SB(1, 1), cB + hstep + kstep, voffB);
        PG8_WAIT_V(6); PG8_BAR;
    }
    for (;;) {
        const bool has_next = S.next(ui + 1, nxt);
        const char* nA = has_next ? (const char*)g.A + (size_t)nxt.pm * tstep : cA; const char* nB = has_next ? (const char*)g.Bt + (size_t)nxt.pn * tstep : cB;
        for (int t = 0; t < nt; t += 2) {
            const bool last = (t == nt - 2);
            const char* a1 = cA + (size_t)(t + 1) * kstep;
            const char* a2 = last ? nA : cA + (size_t)(t + 2) * kstep; const char* b2 = last ? nB : cB + (size_t)(t + 2) * kstep;
            const char* a3 = a2 + kstep; const char* b3 = b2 + kstep;
            if (last && has_next) S.a_ready(nxt);
            if constexpr (SP2) {
            PG8_LDB(B0, 0, 0); PG8_LDB(B1, 0, 1); PG8_SCHED; PG8_LDA(At, 0, 0); PG8_STAGE(PG8_SA(1, 1), a1 + hstep, voffA);
            PG8_WAIT_V(8); PG8_WAIT_L(0); PG8_BAR; PG8_MMA(0, 0, At, B0); PG8_MMA(0, 1, At, B1); PG8_BAR; PG8_SCHED;
            PG8_LDA(At, 0, 1); PG8_STAGE(PG8_SB(0, 0), b2, voffB); PG8_STAGE(PG8_SB(0, 1), b2 + hstep, voffB); PG8_STAGE(PG8_SA(0, 0), a2, voffA);
            PG8_WAIT_V(8); PG8_WAIT_L(0); PG8_BAR; PG8_MMA(1, 0, At, B0); PG8_MMA(1, 1, At, B1); PG8_BAR; PG8_SCHED;
            PG8_LDB(B0, 1, 0); PG8_LDB(B1, 1, 1); PG8_SCHED; PG8_LDA(At, 1, 0); PG8_STAGE(PG8_SA(0, 1), a2 + hstep, voffA);
            PG8_WAIT_V(8); PG8_WAIT_L(0); PG8_BAR; PG8_MMA(0, 0, At, B0); PG8_MMA(0, 1, At, B1); PG8_BAR; PG8_SCHED;
            PG8_LDA(At, 1, 1); PG8_STAGE(PG8_SB(1, 0), b3, voffB); PG8_STAGE(PG8_SB(1, 1), b3 + hstep, voffB); PG8_STAGE(PG8_SA(1, 0), a3, voffA);
            PG8_WAIT_V(8); PG8_WAIT_L(0); PG8_BAR; PG8_MMA(1, 0, At, B0); PG8_MMA(1, 1, At, B1); PG8_BAR; PG8_SCHED;
            } else {
            PG8_LDB(B0, 0, 0); PG8_SCHED; PG8_LDA(At, 0, 0); PG8_STAGE(PG8_SA(1, 1), a1 + hstep, voffA);
            PG8_WAIT_L(8); PG8_BAR; PG8_WAIT_L(0); PG8_MMA(0, 0, At, B0); PG8_BAR; PG8_SCHED;
            PG8_LDB(B1, 0, 1); PG8_STAGE(PG8_SB(0, 0), b2, voffB);
            PG8_BAR; PG8_WAIT_L(0); PG8_MMA(0, 1, At, B1); PG8_BAR;
            PG8_LDA(At, 0, 1); PG8_STAGE(PG8_SA(0, 0), a2, voffA);
            PG8_BAR; PG8_WAIT_L(0); PG8_MMA(1, 0, At, B0); PG8_BAR; PG8_SCHED;
            PG8_STAGE(PG8_SB(0, 1), b2 + hstep, voffB);
            PG8_WAIT_V(6); PG8_BAR; PG8_MMA(1, 1, At, B1); PG8_BAR;
            PG8_LDB(B0, 1, 0); PG8_SCHED; PG8_LDA(At, 1, 0); PG8_STAGE(PG8_SA(0, 1), a2 + hstep, voffA);
            PG8_WAIT_L(8); PG8_BAR; PG8_WAIT_L(0); PG8_MMA(0, 0, At, B0); PG8_BAR; PG8_SCHED;
            PG8_LDB(B1, 1, 1); PG8_STAGE(PG8_SB(1, 0), b3, voffB);
            PG8_BAR; PG8_WAIT_L(0); PG8_MMA(0, 1, At, B1); PG8_BAR;
            PG8_LDA(At, 1, 1); PG8_STAGE(PG8_SA(1, 0), a3, voffA);
            PG8_BAR; PG8_WAIT_L(0); PG8_MMA(1, 0, At, B0); PG8_BAR; PG8_SCHED;
            PG8_STAGE(PG8_SB(1, 1), b3 + hstep, voffB);
            PG8_WAIT_V(6); PG8_BAR; PG8_MMA(1, 1, At, B1); PG8_BAR;
            }
        }
        if constexpr (ALIGN_EPI) { if (wr == 0) PG8_BAR; }
        if constexpr (!Epi::AFTER_DRAIN) { E(acc, cur, wr, wc, fr, fq); S.done(cur); }
        if (!has_next) break;
#pragma unroll
        for (int a = 0; a < 2; ++a)
#pragma unroll
            for (int b = 0; b < 2; ++b)
#pragma unroll
                for (int m = 0; m < 4; ++m)
#pragma unroll
                    for (int n = 0; n < 2; ++n) acc[a][b][m][n] = (f32x4){0.f, 0.f, 0.f, 0.f};
        cur = nxt; cA = nA; cB = nB; ++ui;
        if constexpr (ALIGN_EPI) { if (wr == 1) PG8_BAR; }
    }
    PG8_WAIT_V(0);
    if constexpr (!ALIGN_EPI) { if (wr == 0) PG8_BAR; }
    PG8_BAR;
    if constexpr (Epi::AFTER_DRAIN) { E.fused(acc, cur, wr, wc, fr, fq, lds, wid, lane); S.done(cur); }
#undef PG8_SA
#undef PG8_SB
#undef PG8_STAGE
#undef PG8_LDA
#undef PG8_LDB
#undef PG8_MMA
#undef PG8_WAIT_V
#undef PG8_WAIT_L
#undef PG8_BAR
#undef PG8_SCHED
}
}

constexpr int NB = 8, SEQ = 2048, DM = 2048, T = NB * SEQ;
constexpr int DFF = 5632, NIN = 5120, NMOD = 6 * DM;
constexpr int NPROJ = 4096;
constexpr float EPS = 1e-6f;
constexpr int NTHREADS = 512, NWAVES = 8;
constexpr int LDS_BYTES = 147456;
constexpr float QSCALE = 0.08838834764831845f * 1.4426950408889634f;

constexpr size_t MiB = 1u << 20;
constexpr size_t WS_BAR = 0;
constexpr size_t WS_MOD = 512 * 1024;
constexpr size_t WS_SS1 = 1 * MiB;
constexpr size_t WS_SS2 = 3 * MiB;
constexpr size_t WS_WIN = 6 * MiB;
constexpr size_t WS_WOUT = 26 * MiB;
constexpr size_t WS_WGU = 34 * MiB;
constexpr size_t WS_WDN = 78 * MiB;
constexpr size_t WS_H = 100 * MiB;
constexpr size_t WS_PROJ = 164 * MiB;
constexpr size_t WS_VT = 292 * MiB;
constexpr size_t WS_O = 324 * MiB;
constexpr size_t WS_GU = 164 * MiB;
constexpr size_t WS_END = 388 * MiB;
static_assert(WS_GU + (size_t)T * DFF * 2 <= WS_END, "ws map");

#define LAS __attribute__((address_space(3)))
typedef unsigned short bf16;
typedef unsigned v4u __attribute__((ext_vector_type(4)));
typedef unsigned v2u __attribute__((ext_vector_type(2)));
typedef float f32x4 __attribute__((ext_vector_type(4)));
typedef short bf16x8 __attribute__((ext_vector_type(8)));
typedef short bf16x4 __attribute__((ext_vector_type(4)));

__device__ __forceinline__ unsigned pk2(float lo, float hi) { return pg8::cvt_pk_bf16(lo, hi); }
__device__ __forceinline__ float bflo(unsigned w) { return __uint_as_float(w << 16); }
__device__ __forceinline__ float bfhi(unsigned w) { return __uint_as_float(w & 0xffff0000u); }
__device__ __forceinline__ float wave_sum(float v) {
#pragma unroll
    for (int o = 1; o < 64; o <<= 1) v += __shfl_xor(v, o);
    return v;
}

struct Params {
    const float *x, *c, *w_ada, *b_ada, *norm1_g, *w_in, *v_norm_g, *w_spatial, *b_spatial, *out_norm_g, *w_out, *norm2_g, *w_gate, *w_up, *w_down, *final_g;
    float* out; unsigned char* ws;
};

constexpr int TSCR = 16640;
__device__ __forceinline__ void transpose_item(const float* W, int K, int N, bf16* WT, int k0, int n0, int drow0, LAS float* scr, int lane) {
    const int lr = lane >> 4, lc = (lane & 15) * 4;
    const float* src = W + (size_t)(k0 + lr) * N + n0 + lc;
#pragma unroll 8
    for (int i = 0; i < 16; ++i) { const f32x4 v = *(const f32x4*)(src + (size_t)(4 * i) * N); LAS float* d = scr + (4 * i + lr) * 65 + lc; d[0] = v[0]; d[1] = v[1]; d[2] = v[2]; d[3] = v[3]; }
    asm volatile("s_waitcnt lgkmcnt(0)" ::: "memory");
    const int c = lane & 7;
#pragma unroll
    for (int j = 0; j < 8; ++j) { const int n = (lane >> 3) + 8 * j; const LAS float* q = scr + (8 * c) * 65 + n;
        v4u o; o.x = pk2(q[0 * 65], q[1 * 65]); o.y = pk2(q[2 * 65], q[3 * 65]); o.z = pk2(q[4 * 65], q[5 * 65]); o.w = pk2(q[6 * 65], q[7 * 65]);
        *(v4u*)(WT + (size_t)(drow0 + n) * K + k0 + 8 * c) = o; }
    asm volatile("s_waitcnt lgkmcnt(0)" ::: "memory");
}

__device__ __forceinline__ void phase_prep(const Params& p, LAS unsigned char* lds, int vcu, int G) {
    const int tid = fresh_tid(), lane = tid & 63, wave = __builtin_amdgcn_readfirstlane(tid >> 6);
    LAS float* scr = (LAS float*)(lds + wave * TSCR);
    const int gw = vcu * NWAVES + wave, NGW = G * NWAVES;
    unsigned char* ws = p.ws;
    bf16* Win = (bf16*)(ws + WS_WIN); bf16* Wout = (bf16*)(ws + WS_WOUT); bf16* Wgu = (bf16*)(ws + WS_WGU); bf16* Wdn = (bf16*)(ws + WS_WDN);
    for (int cb = vcu; cb < NMOD / 64; cb += G) {
        float* mod = (float*)(ws + WS_MOD);
        const int kbase = 256 * wave, col = cb * 64 + lane;
#pragma unroll
        for (int b = 0; b < 8; ++b) { f32x4 cv = *(const f32x4*)(p.c + b * DM + kbase + lane * 4);
#pragma unroll
            for (int j = 0; j < 4; ++j) cv[j] = cv[j] / (1.0f + __expf(-cv[j]));
            *(LAS f32x4*)(scr + b * 256 + lane * 4) = cv; }
        asm volatile("s_waitcnt lgkmcnt(0)" ::: "memory");
        float a[8];
#pragma unroll
        for (int b = 0; b < 8; ++b) a[b] = 0.f;
        const float* wp = p.w_ada + (size_t)kbase * NMOD + col;
#pragma unroll 4
        for (int k4 = 0; k4 < 64; ++k4) {
            float wv[4];
#pragma unroll
            for (int i = 0; i < 4; ++i) wv[i] = wp[(size_t)(4 * k4 + i) * NMOD];
#pragma unroll
            for (int b = 0; b < 8; ++b) { const f32x4 sv = *(const LAS f32x4*)(scr + b * 256 + 4 * k4); a[b] += (wv[0] * sv[0] + wv[1] * sv[1]) + (wv[2] * sv[2] + wv[3] * sv[3]); }
        }
        __syncthreads();
        LAS float* red = (LAS float*)lds;
#pragma unroll
        for (int b = 0; b < 8; ++b) red[(wave * 8 + b) * 64 + lane] = a[b];
        __syncthreads();
        { const int b = tid >> 6; float sacc = p.b_ada[col];
#pragma unroll
          for (int w2 = 0; w2 < 8; ++w2) sacc += red[(w2 * 8 + b) * 64 + lane];
          mod[(size_t)b * NMOD + col] = sacc; }
        __syncthreads();
    }
    constexpr int I_IN = (DM / 64) * (NIN / 64), I_OUT = (DM / 64) * (DM / 64), I_G = (DM / 64) * (DFF / 64), I_D = (DFF / 64) * (DM / 64);
    constexpr int NITEMS = I_IN + I_OUT + 2 * I_G + I_D;
    for (int it = gw; it < NITEMS; it += NGW) {
        int r = it;
        if (r < I_IN) { const int nb = NIN / 64, kb = r / nb, n0 = (r % nb) * 64; transpose_item(p.w_in, DM, NIN, Win, kb * 64, n0, n0, scr, lane); continue; } r -= I_IN;
        if (r < I_OUT) { const int nb = DM / 64, kb = r / nb, n0 = (r % nb) * 64; transpose_item(p.w_out, DM, DM, Wout, kb * 64, n0, n0, scr, lane); continue; } r -= I_OUT;
        if (r < I_G) { const int nb = DFF / 64, kb = r / nb, n0 = (r % nb) * 64; transpose_item(p.w_gate, DM, DFF, Wgu, kb * 64, n0, (n0 >> 7) * 256 + (n0 & 127), scr, lane); continue; } r -= I_G;
        if (r < I_G) { const int nb = DFF / 64, kb = r / nb, n0 = (r % nb) * 64; transpose_item(p.w_up, DM, DFF, Wgu, kb * 64, n0, (n0 >> 7) * 256 + 128 + (n0 & 127), scr, lane); continue; } r -= I_G;
        { const int nb = DM / 64, kb = r / nb, n0 = (r % nb) * 64; transpose_item(p.w_down, DFF, DM, Wdn, kb * 64, n0, n0, scr, lane); }
    }
}

template <int MODE>
__device__ __forceinline__ void phase_norm_mod(const Params& p, const float* src, const float* ssp, const float* ng, int shift_chunk, bf16* dst, int vcu, int G) {
    const int tid = fresh_tid(), lane = tid & 63, wave = __builtin_amdgcn_readfirstlane(tid >> 6);
    const int gw = vcu * NWAVES + wave, NGW = G * NWAVES;
    const float* mod = (const float*)(p.ws + WS_MOD);
    for (int rb = gw; rb < T / 8; rb += NGW) {
        const int b = (rb * 8) / SEQ;
        f32x4 A[8], B[8];
#pragma unroll
        for (int j = 0; j < 8; ++j) { const int cidx = lane * 4 + 256 * j;
            const f32x4 g = *(const f32x4*)(ng + cidx);
            const f32x4 sh = *(const f32x4*)(mod + (size_t)b * NMOD + shift_chunk * DM + cidx);
            const f32x4 sc = *(const f32x4*)(mod + (size_t)b * NMOD + (shift_chunk + 1) * DM + cidx);
            A[j] = g * (sc + 1.0f); B[j] = sh; }
        for (int rr = 0; rr < 8; ++rr) {
            const int row = rb * 8 + rr;
            const f32x4* xr = (const f32x4*)(src + (size_t)row * DM) + lane;
            f32x4 v[8]; float s = 0.f;
#pragma unroll
            for (int j = 0; j < 8; ++j) { v[j] = xr[64 * j]; s += (v[j][0] * v[j][0] + v[j][1] * v[j][1]) + (v[j][2] * v[j][2] + v[j][3] * v[j][3]); }
            float tot;
            if (MODE == 0) tot = wave_sum(s);
            else { float q = (lane < 32) ? ssp[(size_t)row * 32 + lane] : 0.f; tot = wave_sum(q); }
            const float rstd = 1.0f / sqrtf(tot * (1.0f / DM) + EPS);
            v2u* o8 = (v2u*)(dst + (size_t)row * DM) + lane;
#pragma unroll
            for (int j = 0; j < 8; ++j) { const f32x4 h = (v[j] * rstd) * A[j] + B[j]; v2u w; w.x = pk2(h[0], h[1]); w.y = pk2(h[2], h[3]); o8[64 * j] = w; }
        }
    }
}

__device__ __forceinline__ void phase_final(const Params& p, const float* ssp, int vcu, int G) {
    const int tid = fresh_tid(), lane = tid & 63, wave = __builtin_amdgcn_readfirstlane(tid >> 6);
    const int gw = vcu * NWAVES + wave, NGW = G * NWAVES;
    f32x4 g[8];
#pragma unroll
    for (int j = 0; j < 8; ++j) g[j] = *(const f32x4*)(p.final_g + lane * 4 + 256 * j);
    for (int row = gw; row < T; row += NGW) {
        f32x4* xr = (f32x4*)(p.out + (size_t)row * DM) + lane;
        f32x4 v[8];
#pragma unroll
        for (int j = 0; j < 8; ++j) v[j] = xr[64 * j];
        float q = (lane < 32) ? ssp[(size_t)row * 32 + lane] : 0.f; const float tot = wave_sum(q);
        const float rstd = 1.0f / sqrtf(tot * (1.0f / DM) + EPS);
#pragma unroll
        for (int j = 0; j < 8; ++j) xr[64 * j] = (v[j] * rstd) * g[j];
    }
}

constexpr int TP = 136;
__device__ __forceinline__ void gmlp_tile(const Params& p, LAS unsigned char* lds, int b, int n, int g) {
    const int tid = fresh_tid(), lane = tid & 63, w = __builtin_amdgcn_readfirstlane(tid >> 6), r = lane & 15, cgp = lane >> 4;
    const bf16* PROJ = (const bf16*)(p.ws + WS_PROJ); bf16* O = (bf16*)(p.ws + WS_O);
    LAS bf16* Vt = (LAS bf16*)lds;
    const int tok0 = b * SEQ + n * 128;
    {
        const int s = 16 * w + r;
        const bf16* src = PROJ + (size_t)(tok0 + s) * NPROJ + 1024 + g * 128;
        float xv[4][8]; float s1 = 0.f;
#pragma unroll
        for (int pp = 0; pp < 4; ++pp) { const v4u raw = *(const v4u*)(src + (cgp * 4 + pp) * 8);
            xv[pp][0] = bflo(raw.x); xv[pp][1] = bfhi(raw.x); xv[pp][2] = bflo(raw.y); xv[pp][3] = bfhi(raw.y); xv[pp][4] = bflo(raw.z); xv[pp][5] = bfhi(raw.z); xv[pp][6] = bflo(raw.w); xv[pp][7] = bfhi(raw.w);
#pragma unroll
            for (int j = 0; j < 8; ++j) s1 += xv[pp][j]; }
        s1 += __shfl_xor(s1, 16); s1 += __shfl_xor(s1, 32);
        const float mean = s1 * (1.0f / 128.0f); float s2 = 0.f;
#pragma unroll
        for (int pp = 0; pp < 4; ++pp)
#pragma unroll
            for (int j = 0; j < 8; ++j) { xv[pp][j] -= mean; s2 += xv[pp][j] * xv[pp][j]; }
        s2 += __shfl_xor(s2, 16); s2 += __shfl_xor(s2, 32);
        const float rstd = 1.0f / sqrtf(s2 * (1.0f / 128.0f) + EPS);
#pragma unroll
        for (int pp = 0; pp < 4; ++pp) { const int d0 = (cgp * 4 + pp) * 8;
            const f32x4 g0 = *(const f32x4*)(p.v_norm_g + g * 128 + d0), g1 = *(const f32x4*)(p.v_norm_g + g * 128 + d0 + 4);
#pragma unroll
            for (int j = 0; j < 8; ++j) { const float y = xv[pp][j] * rstd * (j < 4 ? g0[j & 3] : g1[j & 3]); Vt[(d0 + j) * TP + s] = (bf16)(pk2(y, 0.f) & 0xffffu); } }
    }
    __syncthreads();
    f32x4 acc[8];
#pragma unroll
    for (int nd = 0; nd < 8; ++nd) acc[nd] = (f32x4){0.f, 0.f, 0.f, 0.f};
    const int t = 16 * w + r;
    const float* wrow = p.w_spatial + (size_t)(g * 128 + t) * 128;
    for (int kk = 0; kk <= (w >> 1); ++kk) {
        const int s0 = kk * 32 + cgp * 8;
        const f32x4 w0 = *(const f32x4*)(wrow + s0), w1 = *(const f32x4*)(wrow + s0 + 4);
        float wv[8] = {w0[0], w0[1], w0[2], w0[3], w1[0], w1[1], w1[2], w1[3]};
#pragma unroll
        for (int j = 0; j < 8; ++j) wv[j] = (s0 + j <= t) ? wv[j] : 0.f;
        v4u wp; wp.x = pk2(wv[0], wv[1]); wp.y = pk2(wv[2], wv[3]); wp.z = pk2(wv[4], wv[5]); wp.w = pk2(wv[6], wv[7]);
        const bf16x8 wf = __builtin_bit_cast(bf16x8, wp);
#pragma unroll
        for (int nd = 0; nd < 8; ++nd) { const bf16x8 vf = *(const LAS bf16x8*)(Vt + (nd * 16 + r) * TP + s0);
            acc[nd] = __builtin_amdgcn_mfma_f32_16x16x32_bf16(vf, wf, acc[nd], 0, 0, 0); }
    }
    const float bsv = p.b_spatial[g * 128 + t];
    const bf16* urow = PROJ + (size_t)(tok0 + t) * NPROJ + g * 128 + cgp * 4;
    float ss = 0.f;
#pragma unroll
    for (int nd = 0; nd < 8; ++nd) { const v2u uw = *(const v2u*)(urow + nd * 16);
        f32x4 o; o[0] = bflo(uw.x) * (acc[nd][0] + bsv); o[1] = bfhi(uw.x) * (acc[nd][1] + bsv); o[2] = bflo(uw.y) * (acc[nd][2] + bsv); o[3] = bfhi(uw.y) * (acc[nd][3] + bsv);
        acc[nd] = o; ss += (o[0] * o[0] + o[1] * o[1]) + (o[2] * o[2] + o[3] * o[3]); }
    ss += __shfl_xor(ss, 16); ss += __shfl_xor(ss, 32);
    const float rs = 1.0f / sqrtf(ss * (1.0f / 128.0f) + EPS);
    bf16* orow = O + (size_t)(tok0 + t) * DM + g * 128 + cgp * 4;
#pragma unroll
    for (int nd = 0; nd < 8; ++nd) { const f32x4 og = *(const f32x4*)(p.out_norm_g + g * 128 + nd * 16 + cgp * 4);
        v2u wv2; wv2.x = pk2(acc[nd][0] * rs * og[0], acc[nd][1] * rs * og[1]); wv2.y = pk2(acc[nd][2] * rs * og[2], acc[nd][3] * rs * og[3]);
        *(v2u*)(orow + nd * 16) = wv2; }
    __syncthreads();
}

__device__ __forceinline__ void sb_unit(const Params& p, LAS unsigned char* lds, int b, int h, int i) {
    const int tid = fresh_tid(), lane = tid & 63, w = __builtin_amdgcn_readfirstlane(tid >> 6), r = lane & 15, cgp = lane >> 4;
    const bf16* PROJ = (const bf16*)(p.ws + WS_PROJ); const bf16* VT = (const bf16*)(p.ws + WS_VT); bf16* O = (bf16*)(p.ws + WS_O);
    LAS bf16* Ks = (LAS bf16*)lds;
    LAS bf16* Vs = (LAS bf16*)(lds + 2 * 128 * TP * 2);
    const int tok0 = b * SEQ;
    bf16x8 qf[4];
    { const bf16* qrow = PROJ + (size_t)(tok0 + i * 128 + 16 * w + r) * NPROJ + 2048 + h * 128 + cgp * 8;
#pragma unroll
      for (int kk = 0; kk < 4; ++kk) qf[kk] = *(const bf16x8*)(qrow + kk * 32); }
    const bf16* kbase = PROJ + (size_t)tok0 * NPROJ + 3072 + h * 128;
    const bf16* vbase = VT + (size_t)(h * 128) * T + tok0;
    v4u kr[4], vr[4];
#define SB_LOAD(jb) do { _Pragma("unroll") for (int pp = 0; pp < 4; ++pp) { const int c = tid + 512 * pp, rw = c >> 4, pc = c & 15; \
        kr[pp] = *(const v4u*)(kbase + (size_t)((jb) * 128 + rw) * NPROJ + pc * 8); vr[pp] = *(const v4u*)(vbase + (size_t)rw * T + (jb) * 128 + pc * 8); } } while (0)
#define SB_STORE(buf) do { _Pragma("unroll") for (int pp = 0; pp < 4; ++pp) { const int c = tid + 512 * pp, rw = c >> 4, pc = c & 15; \
        *(LAS v4u*)(Ks + ((buf) * 128 + rw) * TP + pc * 8) = kr[pp]; *(LAS v4u*)(Vs + ((buf) * 128 + rw) * TP + pc * 8) = vr[pp]; } } while (0)
    f32x4 oacc[8];
#pragma unroll
    for (int nd = 0; nd < 8; ++nd) oacc[nd] = (f32x4){0.f, 0.f, 0.f, 0.f};
    float carry = 0.f;
    SB_LOAD(i); SB_STORE(0);
    __syncthreads();
    for (int jb = i; jb >= 0; --jb) {
        const int cur = (i - jb) & 1;
        if (jb > 0) SB_LOAD(jb - 1);
        f32x4 z[8];
#pragma unroll
        for (int n = 0; n < 8; ++n) { z[n] = (f32x4){0.f, 0.f, 0.f, 0.f};
#pragma unroll
            for (int kk = 0; kk < 4; ++kk) { const bf16x8 kf = *(const LAS bf16x8*)(Ks + (cur * 128 + n * 16 + r) * TP + kk * 32 + cgp * 8);
                z[n] = __builtin_amdgcn_mfma_f32_16x16x32_bf16(kf, qf[kk], z[n], 0, 0, 0); } }
        const bool diag = (jb == i);
        float run = carry;
#pragma unroll
        for (int n = 7; n >= 0; --n) {
            float l[4], l1[4]; float ps = 0.f;
#pragma unroll
            for (int jj = 0; jj < 4; ++jj) { const float zz = z[n][jj];
                const float e = __builtin_amdgcn_exp2f(-fabsf(zz)); const float lg = __builtin_amdgcn_logf(1.0f + e);
                l[jj] = fminf(zz, 0.f) - lg; float t1 = l[jj] - zz;
                if (diag) { const bool valid = (16 * n + 4 * cgp + jj) < (16 * w + r); t1 = valid ? t1 : 0.f; }
                l1[jj] = t1; ps += t1; }
            const float x1 = __shfl_xor(ps, 16); const float pp2 = ps + x1; const float x2 = __shfl_xor(pp2, 32);
            const float sgt = ((cgp & 1) ? 0.f : x1) + ((cgp & 2) ? 0.f : x2);
            float tl = run + sgt; run += pp2 + x2;
            float a3 = __builtin_amdgcn_exp2f(l[3] + tl); tl += l1[3];
            float a2 = __builtin_amdgcn_exp2f(l[2] + tl); tl += l1[2];
            float a1 = __builtin_amdgcn_exp2f(l[1] + tl); tl += l1[1];
            float a0 = __builtin_amdgcn_exp2f(l[0] + tl);
            if (diag) { const int sb = 16 * n + 4 * cgp, tt = 16 * w + r;
                a0 = (sb + 0 < tt) ? a0 : 0.f; a1 = (sb + 1 < tt) ? a1 : 0.f; a2 = (sb + 2 < tt) ? a2 : 0.f; a3 = (sb + 3 < tt) ? a3 : 0.f; }
            z[n][0] = a0; z[n][1] = a1; z[n][2] = a2; z[n][3] = a3;
        }
        carry = run;
#pragma unroll
        for (int m = 0; m < 4; ++m) {
            v4u pw; pw.x = pk2(z[2 * m][0], z[2 * m][1]); pw.y = pk2(z[2 * m][2], z[2 * m][3]); pw.z = pk2(z[2 * m + 1][0], z[2 * m + 1][1]); pw.w = pk2(z[2 * m + 1][2], z[2 * m + 1][3]);
            const bf16x8 pf = __builtin_bit_cast(bf16x8, pw);
#pragma unroll
            for (int nd = 0; nd < 8; ++nd) { const LAS bf16* vp = Vs + (cur * 128 + nd * 16 + r) * TP + 32 * m + 4 * cgp;
                const v2u lo = *(const LAS v2u*)vp, hi = *(const LAS v2u*)(vp + 16);
                v4u vw; vw.x = lo.x; vw.y = lo.y; vw.z = hi.x; vw.w = hi.y;
                oacc[nd] = __builtin_amdgcn_mfma_f32_16x16x32_bf16(__builtin_bit_cast(bf16x8, vw), pf, oacc[nd], 0, 0, 0); }
        }
        if (jb > 0) SB_STORE(cur ^ 1);
        __syncthreads();
    }
#undef SB_LOAD
#undef SB_STORE
    float ss = 0.f;
#pragma unroll
    for (int nd = 0; nd < 8; ++nd) ss += (oacc[nd][0] * oacc[nd][0] + oacc[nd][1] * oacc[nd][1]) + (oacc[nd][2] * oacc[nd][2] + oacc[nd][3] * oacc[nd][3]);
    ss += __shfl_xor(ss, 16); ss += __shfl_xor(ss, 32);
    const float rs = 1.0f / sqrtf(ss * (1.0f / 128.0f) + EPS);
    bf16* orow = O + (size_t)(tok0 + i * 128 + 16 * w + r) * DM + 1024 + h * 128 + cgp * 4;
#pragma unroll
    for (int nd = 0; nd < 8; ++nd) { const f32x4 og = *(const f32x4*)(p.out_norm_g + 1024 + h * 128 + nd * 16 + cgp * 4);
        v2u wv2; wv2.x = pk2(oacc[nd][0] * rs * og[0], oacc[nd][1] * rs * og[1]); wv2.y = pk2(oacc[nd][2] * rs * og[2], oacc[nd][3] * rs * og[3]);
        *(v2u*)(orow + nd * 16) = wv2; }
}

__device__ __forceinline__ void phase_mixers(const Params& p, LAS unsigned char* lds, int vcu, int G) {
    for (int pr = vcu; pr < 512; pr += G) {
        const int bh = pr >> 3, ip = pr & 7, b = bh >> 3, h = bh & 7;
        sb_unit(p, lds, b, h, 15 - ip);
        sb_unit(p, lds, b, h, ip);
    }
    for (int tl = vcu; tl < 1024; tl += G) { const int g = tl & 7, n = (tl >> 3) & 15, b = tl >> 7; gmlp_tile(p, lds, b, n, g); }
}

#define XB_TMO      128
#define XB_XCNT(j)  (256  + 64 * (j))
#define XB_XSUB(j)  (1280 + 64 * (j))
#define XB_XGEN(j)  (2304 + 64 * (j))
#define XB_TOP      3328
#define XB_TOPGEN   3392
#define XCD_BAR_WORDS 3456
#define XB_SPIN_CAP (1u << 18)

__device__ __forceinline__ unsigned xb_ld(unsigned* p)              { return __hip_atomic_load(p, __ATOMIC_RELAXED, __HIP_MEMORY_SCOPE_AGENT); }
__device__ __forceinline__ unsigned xb_add(unsigned* p, unsigned v) { return __hip_atomic_fetch_add(p, v, __ATOMIC_RELAXED, __HIP_MEMORY_SCOPE_AGENT); }
__device__ __forceinline__ unsigned xb_xcc_id() { return (unsigned)__builtin_amdgcn_s_getreg((3 << 11) | 20) & 0xFu; }
#define XB_SPIN(cond, bar) do { unsigned _sp = 0; while (cond) { __builtin_amdgcn_s_sleep(1); \
    if ((++_sp & 255u) == 0u) { if (xb_ld(&(bar)[XB_TMO])) break; if (_sp > XB_SPIN_CAP) { atomicAdd(&(bar)[XB_TMO], 1u); break; } } } } while (0)

struct XcdBarrier {
    unsigned* bar; unsigned x;
    volatile LAS unsigned* st;
};

__device__ __forceinline__ XcdBarrier xcd_barrier_post(unsigned* bar, volatile LAS unsigned* st) {
    XcdBarrier b; b.bar = bar; b.x = xb_xcc_id(); b.st = st;
    if (threadIdx.x == 0) (void)xb_add(&bar[XB_XCNT(b.x)], 1u);
    return b;
}
__device__ __forceinline__ void xcd_barrier_complete(unsigned* bar, unsigned x, unsigned& nloc, unsigned& nx) {
    const unsigned G = gridDim.x * gridDim.y * gridDim.z;
    unsigned sum, cnt, mine, sp = 0u;
    for (;;) {
        sum = 0u; cnt = 0u; mine = 0u;
#pragma unroll
        for (unsigned j = 0; j < 16; ++j) { const unsigned c = xb_ld(&bar[XB_XCNT(j)]); sum += c; cnt += (c > 0u) ? 1u : 0u; mine = (j == x) ? c : mine; }
        if (sum == G) break;
        __builtin_amdgcn_s_sleep(1);
        if ((++sp & 255u) == 0u) { if (xb_ld(&bar[XB_TMO])) break; if (sp > XB_SPIN_CAP) { atomicAdd(&bar[XB_TMO], 1u); break; } }
    }
    nloc = mine > 0u ? mine : 1u; nx = cnt > 0u ? cnt : 1u;
}

__device__ __forceinline__ void xcd_barrier(const XcdBarrier& b) {
    asm volatile("s_waitcnt vmcnt(0)" ::: "memory");
    __syncthreads();
    if (threadIdx.x == 0) {
        unsigned* bar = b.bar;
        __builtin_amdgcn_s_waitcnt(0);
        unsigned nloc = b.st[0], nx = b.st[1];
        if (nloc == 0u) { xcd_barrier_complete(bar, b.x, nloc, nx); b.st[0] = nloc; b.st[1] = nx; }
        const unsigned old = xb_add(&bar[XB_XSUB(b.x)], 1u);
        const unsigned gen = old / nloc;
        if (old + 1u == (gen + 1u) * nloc) {
            __builtin_amdgcn_fence(__ATOMIC_RELEASE, "agent");
            asm volatile("s_waitcnt vmcnt(0)" ::: "memory");
            const unsigned og = xb_add(&bar[XB_TOP], 1u);
            const unsigned tg = og / nx;
            if (og + 1u == (tg + 1u) * nx) xb_add(&bar[XB_TOPGEN], 1u);
            else XB_SPIN(xb_ld(&bar[XB_TOPGEN]) == tg, bar);
            __builtin_amdgcn_fence(__ATOMIC_ACQUIRE, "agent");
            xb_add(&bar[XB_XGEN(b.x)], 1u);
            asm volatile("s_waitcnt vmcnt(0)" ::: "memory");
        } else {
            XB_SPIN(xb_ld(&bar[XB_XGEN(b.x)]) == gen, bar);
            __builtin_amdgcn_fence(__ATOMIC_ACQUIRE, "agent");
            asm volatile("s_waitcnt vmcnt(0)" ::: "memory");
        }
    }
    __syncthreads();
}

#ifndef PH_MASK
#define PH_MASK 0x3ff
#endif
#define PH(k) if constexpr ((PH_MASK >> (k)) & 1)
#ifndef DUP_MASK
#define DUP_MASK 0
#endif
#define DUP(k) _Pragma("unroll 1") for (int _r = 0; _r < ((((DUP_MASK) >> (k)) & 1) ? 2 : 1); ++_r)
__global__ void __launch_bounds__(NTHREADS, 2) fwd_megakernel(Params p) {
    extern __shared__ __attribute__((aligned(16))) unsigned char lds_raw[];
    LAS unsigned char* lds = (LAS unsigned char*)lds_raw;
    cg::grid_group grid = cg::this_grid();
    if (p.ws == nullptr) grid.sync();
    volatile LAS unsigned* bst = (volatile LAS unsigned*)(lds + LDS_BYTES - 64);
    if (threadIdx.x == 0) { bst[0] = 0u; bst[1] = 0u; }
    __syncthreads();
    const XcdBarrier bar = xcd_barrier_post((unsigned*)(p.ws + WS_BAR), bst);
    const int G = gridDim.x, bx = blockIdx.x;
    const int vcu = (G % 8 == 0) ? (bx % 8) * (G / 8) + bx / 8 : bx;
    unsigned char* ws = p.ws;
    bf16* Win = (bf16*)(ws + WS_WIN); bf16* Wout = (bf16*)(ws + WS_WOUT); bf16* Wgu = (bf16*)(ws + WS_WGU); bf16* Wdn = (bf16*)(ws + WS_WDN);
    bf16* H = (bf16*)(ws + WS_H); bf16* PROJ = (bf16*)(ws + WS_PROJ); bf16* VT = (bf16*)(ws + WS_VT); bf16* O = (bf16*)(ws + WS_O); bf16* GU = (bf16*)(ws + WS_GU);
    float* mod = (float*)(ws + WS_MOD); float* SS1 = (float*)(ws + WS_SS1); float* SS2 = (float*)(ws + WS_SS2);

    PH(0) DUP(0) phase_prep(p, lds, vcu, G);
    xcd_barrier(bar);
    PH(1) DUP(1) phase_norm_mod<0>(p, p.x, nullptr, p.norm1_g, 0, H, vcu, G);
    xcd_barrier(bar);
    PH(2) DUP(2) {
        pg8::Gemm g{H, Win, T, NPROJ, DM}; pg8::StaticOrder S; S.init(T, NPROJ, G, bx);
        pg8::EpiProj E{PROJ, NPROJ, 8, 8, 12, QSCALE};
        pg8::gemm_phase<pg8::EpiProj, pg8::StaticOrder, true, true>(lds, g, S, E);
    }
    PH(9) DUP(2) {
        pg8::Gemm g{Win + (size_t)NPROJ * DM, H, 1024, T, DM}; pg8::StaticOrder S; S.init(1024, T, G, bx);
        pg8::EpiProj E{VT, T, 0, 0, 0, 1.f};
        pg8::gemm_phase<pg8::EpiProj, pg8::StaticOrder, true, true>(lds, g, S, E);
    }
    xcd_barrier(bar);
    PH(3) DUP(3) phase_mixers(p, lds, vcu, G);
    xcd_barrier(bar);
    PH(4) DUP(4) {
        pg8::Gemm g{O, Wout, T, DM, DM}; pg8::StaticOrder S; S.init(T, DM, G, bx);
        pg8::EpiRes E{p.x, p.out, DM, mod + 2 * DM, SS1};
        pg8::gemm_phase<pg8::EpiRes, pg8::StaticOrder, true, true>(lds, g, S, E);
    }
    xcd_barrier(bar);
    PH(5) DUP(5) phase_norm_mod<1>(p, p.out, SS1, p.norm2_g, 3, H, vcu, G);
    xcd_barrier(bar);
    PH(6) DUP(6) {
        pg8::Gemm g{H, Wgu, T, 2 * DFF, DM}; pg8::StaticOrder S; S.init(T, 2 * DFF, G, bx);
        pg8::EpiGU E{GU, DFF};
        pg8::gemm_phase<pg8::EpiGU, pg8::StaticOrder, true, true>(lds, g, S, E);
    }
    xcd_barrier(bar);
    PH(7) {
        pg8::Gemm g{GU, Wdn, T, DM, DFF}; pg8::StaticOrder S; S.init(T, DM, G, bx);
        pg8::EpiRes E{p.out, p.out, DM, mod + 5 * DM, SS2};
        pg8::gemm_phase<pg8::EpiRes, pg8::StaticOrder, true, true>(lds, g, S, E);
    }
    xcd_barrier(bar);
    PH(8) phase_final(p, SS2, vcu, G);
}

extern "C" void kernel_launch(void* const* d_in, const int* in_sizes, int n_in, void* d_out, int out_size, void* d_ws, size_t ws_size, hipStream_t stream) {
    static int grid_blocks = 0;
    if (grid_blocks == 0) {
        if (n_in != 16 || ws_size < WS_END) { fprintf(stderr, "kernel_launch: unexpected n_in %d / ws_size %zu (need %zu)\n", n_in, ws_size, (size_t)WS_END); grid_blocks = -1; return; }
        int dev = 0, cus = 0, per_cu = 0;
        (void)hipGetDevice(&dev);
        (void)hipDeviceGetAttribute(&cus, hipDeviceAttributeMultiprocessorCount, dev);
        if (hipFuncSetAttribute((const void*)fwd_megakernel, hipFuncAttributeMaxDynamicSharedMemorySize, LDS_BYTES) != hipSuccess) { fprintf(stderr, "kernel_launch: hipFuncSetAttribute failed\n"); grid_blocks = -1; return; }
        if (hipOccupancyMaxActiveBlocksPerMultiprocessor(&per_cu, (const void*)fwd_megakernel, NTHREADS, LDS_BYTES) != hipSuccess || per_cu < 1) { fprintf(stderr, "kernel_launch: occupancy query says %d\n", per_cu); per_cu = 1; }
        (void)hipGetLastError();
        grid_blocks = cus * 1;
    }
    if (grid_blocks < 0) return;
    if (hipMemsetAsync((char*)d_ws + WS_BAR, 0, 16384, stream) != hipSuccess) { fprintf(stderr, "kernel_launch: memset failed\n"); return; }
    Params p{};
    p.x = (const float*)d_in[0]; p.c = (const float*)d_in[1]; p.w_ada = (const float*)d_in[2]; p.b_ada = (const float*)d_in[3]; p.norm1_g = (const float*)d_in[4];
    p.w_in = (const float*)d_in[5]; p.v_norm_g = (const float*)d_in[6]; p.w_spatial = (const float*)d_in[7]; p.b_spatial = (const float*)d_in[8]; p.out_norm_g = (const float*)d_in[9];
    p.w_out = (const float*)d_in[10]; p.norm2_g = (const float*)d_in[11]; p.w_gate = (const float*)d_in[12]; p.w_up = (const float*)d_in[13]; p.w_down = (const float*)d_in[14]; p.final_g = (const float*)d_in[15];
    p.out = (float*)d_out; p.ws = (unsigned char*)d_ws;
    void* args[] = {&p};
    hipError_t e = hipLaunchCooperativeKernel((const void*)fwd_megakernel, dim3(grid_blocks), dim3(NTHREADS), args, LDS_BYTES, stream);
    if (e != hipSuccess) fprintf(stderr, "cooperative launch failed: %s (grid %d)\n", hipGetErrorString(e), grid_blocks);
}
```

```cpp
#define DUP_MASK 0x0
#include <hip/hip_runtime.h>
#include <hip/hip_cooperative_groups.h>
#include <cstdio>
#include <cstdint>
namespace cg = cooperative_groups;
__device__ __forceinline__ int fresh_tid() { int t = threadIdx.x; asm volatile("" : "+v"(t)); return t; }
namespace pg8 {
#define PG8_LAS __attribute__((address_space(3)))
typedef unsigned short bf16_t;
typedef short bf16x8 __attribute__((ext_vector_type(8)));
typedef float f32x4 __attribute__((ext_vector_type(4)));
typedef unsigned u32x4 __attribute__((ext_vector_type(4)));
constexpr int BM = 256, BK = 64, HALF = 128, HTB = HALF * BK * 2  , STAGE_BYTES = 8 * HTB, NXCD = 8, WGM = 8;

__host__ __device__ __forceinline__ int lds_byte(int r, int c) { const int st = (r >> 4) * 2 + (c >> 5), rr = r & 15, cc = c & 31, ob = rr * 64 + cc * 2; return st * 1024 + (ob ^ (((ob >> 9) & 1) << 5)); }
__host__ __device__ __forceinline__ void stage_rc(int b, int& R, int& C) { const int st = b / 1024, sb = b % 1024, swz = sb ^ (((sb >> 9) & 1) << 5); R = (st >> 1) * 16 + swz / 64; C = (st & 1) * 32 + (swz % 64) / 2; }
__host__ __device__ __forceinline__ int perm32(int rho) { const int n = rho >> 4, i = rho & 15; return 8 * (i >> 2) + 4 * n + (i & 3); }

struct Unit { int pm, pn; };
struct Gemm { const bf16_t* A; const bf16_t* Bt; int M, N, K; };

struct StaticOrder {
    int nM, nN, nwg, G, c;
    __host__ __device__ void init(int M, int N, int G_, int c_) { nM = M / BM; nN = N / BM; nwg = nM * nN; G = G_; c = c_; }
    __host__ __device__ bool next(int i, Unit& u) const {
        const long L = (long)i * G + c; if (L >= nwg) return false;
        int wgid = (int)L; { const int q = nwg / NXCD, r = nwg % NXCD, xcd = wgid % NXCD, off = wgid / NXCD; wgid = (xcd < r ? xcd * (q + 1) : r * (q + 1) + (xcd - r) * q) + off; }
        const int nig = WGM * nN, gid = wgid / nig, fm = gid * WGM, gsz = (nM - fm) < WGM ? (nM - fm) : WGM;
        u.pm = fm + ((wgid % nig) % gsz); u.pn = (wgid % nig) / gsz; return true;
    }
    __device__ __forceinline__ void a_ready(const Unit&) const {}
    __device__ __forceinline__ void done(const Unit&) const {}
};

__device__ __forceinline__ unsigned cvt_pk_bf16(float lo, float hi) { unsigned r; asm volatile("v_cvt_pk_bf16_f32 %0, %1, %2" : "=v"(r) : "v"(lo), "v"(hi)); return r; }
typedef float f32x2 __attribute__((ext_vector_type(2)));
__device__ __forceinline__ f32x2 gelu_pk(f32x2 v) {
    const f32x2 av = __builtin_elementwise_abs(v), d = av * 0.2316418882f + 1.0f;
    f32x2 t; t.x = __builtin_amdgcn_rcpf(d.x); t.y = __builtin_amdgcn_rcpf(d.y);
    f32x2 q = t * 0.5307027145f + (-0.7265760135f); q = q * t + 0.7107068705f; q = q * t + (-0.142248368f); q = q * t + 0.127414796f; q = q * t;
    const f32x2 s = (v * v) * (-0.72134752044f);
    f32x2 e; e.x = __builtin_amdgcn_exp2f(s.x); e.y = __builtin_amdgcn_exp2f(s.y);
    const f32x2 m = v * (q * e), r = v - m;
    f32x2 o; o.x = v.x < 0.f ? m.x : r.x; o.y = v.y < 0.f ? m.y : r.y; return o;
}

struct EpiProj {
    static constexpr bool PERM = true, AFTER_DRAIN = false;
    bf16_t* O; int ldc; int gelu_tiles; int sc_lo, sc_hi; float sc;
    __device__ __forceinline__ void operator()(const f32x4 (&acc)[2][2][4][2], const Unit& u, int wr, int wc, int fr, int fq) const {
        const int row0 = u.pm * BM + wr * 64 + fr, col0 = u.pn * BM + wc * 32 + 8 * fq;
        const bool g = u.pn < gelu_tiles; const float s = (u.pn >= sc_lo && u.pn < sc_hi) ? sc : 1.f;
#pragma unroll
        for (int ai = 0; ai < 2; ++ai)
#pragma unroll
            for (int m = 0; m < 4; ++m) { bf16_t* rowp = O + (size_t)(row0 + ai * HALF + m * 16) * ldc + col0;
#pragma unroll
                for (int bj = 0; bj < 2; ++bj) { f32x4 v0 = acc[ai][bj][m][0], v1 = acc[ai][bj][m][1];
                    if (g) { f32x2 a = gelu_pk((f32x2){v0[0], v0[1]}), b = gelu_pk((f32x2){v0[2], v0[3]}), c = gelu_pk((f32x2){v1[0], v1[1]}), d = gelu_pk((f32x2){v1[2], v1[3]});
                        v0 = (f32x4){a.x, a.y, b.x, b.y}; v1 = (f32x4){c.x, c.y, d.x, d.y}; }
                    v0 = v0 * s; v1 = v1 * s; u32x4 w; w.x = cvt_pk_bf16(v0[0], v0[1]); w.y = cvt_pk_bf16(v0[2], v0[3]); w.z = cvt_pk_bf16(v1[0], v1[1]); w.w = cvt_pk_bf16(v1[2], v1[3]);
                    *(u32x4*)(rowp + bj * HALF) = w; } }
    }
};
struct EpiRes {
    static constexpr bool PERM = false, AFTER_DRAIN = false;
    const float* base; float* out; int ldc; const float* gacc; float* ssp;
    __device__ __forceinline__ void operator()(const f32x4 (&acc)[2][2][4][2], const Unit& u, int wr, int wc, int fr, int fq) const {
        const int row0 = u.pm * BM + wr * 64 + fr, col0 = u.pn * BM + wc * 32 + 4 * fq;
        const int b = u.pm >> 3;
        f32x4 gv[2][2];
#pragma unroll
        for (int bj = 0; bj < 2; ++bj)
#pragma unroll
            for (int n = 0; n < 2; ++n) gv[bj][n] = *(const f32x4*)(gacc + (size_t)b * 12288 + col0 + bj * HALF + n * 16);
#pragma unroll
        for (int ai = 0; ai < 2; ++ai)
#pragma unroll
            for (int m = 0; m < 4; ++m) { const int r = row0 + ai * HALF + m * 16; const size_t off = (size_t)r * ldc + col0; float ss = 0.f;
#pragma unroll
                for (int bj = 0; bj < 2; ++bj)
#pragma unroll
                    for (int n = 0; n < 2; ++n) { const f32x4 bs = *(const f32x4*)(base + off + bj * HALF + n * 16); const f32x4 o = bs + gv[bj][n] * acc[ai][bj][m][n];
                        *(f32x4*)(out + off + bj * HALF + n * 16) = o; ss += (o[0] * o[0] + o[1] * o[1]) + (o[2] * o[2] + o[3] * o[3]); }
                ss += __shfl_xor(ss, 16); ss += __shfl_xor(ss, 32);
                if (fq == 0) ssp[(size_t)r * 32 + u.pn * 4 + wc] = ss;
                asm volatile("" ::: "memory"); }
    }
};
struct EpiGU {
    static constexpr bool PERM = true, AFTER_DRAIN = false;
    bf16_t* O; int ldc;
    __device__ __forceinline__ void operator()(const f32x4 (&acc)[2][2][4][2], const Unit& u, int wr, int wc, int fr, int fq) const {
        const int row0 = u.pm * BM + wr * 64 + fr, col0 = u.pn * HALF + wc * 32 + 8 * fq;
#pragma unroll
        for (int ai = 0; ai < 2; ++ai)
#pragma unroll
            for (int m = 0; m < 4; ++m) { bf16_t* rowp = O + (size_t)(row0 + ai * HALF + m * 16) * ldc + col0; float v[8];
#pragma unroll
                for (int n = 0; n < 2; ++n)
#pragma unroll
                    for (int j = 0; j < 4; ++j) { const float g = acc[ai][0][m][n][j], up = acc[ai][1][m][n][j];
                        const float e = __builtin_amdgcn_exp2f(g * (-1.44269504089f)); v[n * 4 + j] = g * __builtin_amdgcn_rcpf(1.0f + e) * up; }
                u32x4 w; w.x = cvt_pk_bf16(v[0], v[1]); w.y = cvt_pk_bf16(v[2], v[3]); w.z = cvt_pk_bf16(v[4], v[5]); w.w = cvt_pk_bf16(v[6], v[7]);
                *(u32x4*)rowp = w; }
    }
};
template <class Epi, class Sched, bool ALIGN_EPI = false, bool SP2 = false>
__device__ __forceinline__ void gemm_phase(PG8_LAS unsigned char* lds, const Gemm g, const Sched& S, const Epi& E) {
    const int tid = fresh_tid(), wid = __builtin_amdgcn_readfirstlane(tid >> 6), lane = tid & 63, wr = wid >> 2, wc = wid & 3, fr = lane & 15, fq = lane >> 4;
    const int K = g.K, nt = K / BK;
    unsigned voffA[2], voffB[2];
#pragma unroll
    for (int i = 0; i < 2; ++i) { int R, C; stage_rc(tid * 16 + i * 8192, R, C); const int Rb = Epi::PERM ? ((R & ~31) + perm32(R & 31)) : R;
        voffA[i] = (unsigned)(R * K + C) * 2u; voffB[i] = (unsigned)(Rb * K + C) * 2u; }
    const size_t kstep = (size_t)(BK * 2);
    const size_t hstep = (size_t)HALF * K * 2;
    const size_t tstep = 2 * hstep;
    const unsigned ldsw = (unsigned)wid * 1024u;
    const int aoff = lds_byte(wr * 64 + fr, fq * 8), boff = lds_byte(wc * 32 + fr, fq * 8);
#define PG8_SA(b, h) (((b) * 2 + (h)) * HTB)
#define PG8_SB(b, h) ((4 + (b) * 2 + (h)) * HTB)
#define PG8_STAGE(bufoff, gbase, voff) do { _Pragma("unroll") for (int _i = 0; _i < 2; ++_i) \
        __builtin_amdgcn_global_load_lds((const unsigned*)((const char*)(gbase) + (voff)[_i]), (PG8_LAS unsigned*)(lds + (bufoff) + ldsw + _i * 8192), 16, 0, 0); } while (0)
#define PG8_LDA(dst, b, h) do { _Pragma("unroll") for (int m = 0; m < 4; ++m) _Pragma("unroll") for (int k = 0; k < 2; ++k) dst[m][k] = *(const PG8_LAS bf16x8*)(lds + PG8_SA(b, h) + aoff + m * 2048 + k * 1024); } while (0)
#define PG8_LDB(dst, b, h) do { _Pragma("unroll") for (int n = 0; n < 2; ++n) _Pragma("unroll") for (int k = 0; k < 2; ++k) dst[n][k] = *(const PG8_LAS bf16x8*)(lds + PG8_SB(b, h) + boff + n * 2048 + k * 1024); } while (0)
#define PG8_MMA(ai, bj, At, Bt) do { __builtin_amdgcn_s_setprio(1); _Pragma("unroll") for (int m = 0; m < 4; ++m) _Pragma("unroll") for (int n = 0; n < 2; ++n) _Pragma("unroll") for (int k = 0; k < 2; ++k) \
        acc[ai][bj][m][n] = __builtin_amdgcn_mfma_f32_16x16x32_bf16(Bt[n][k], At[m][k], acc[ai][bj][m][n], 0, 0, 0); __builtin_amdgcn_s_setprio(0); } while (0)
#define PG8_WAIT_V(n) asm volatile("s_waitcnt vmcnt(" #n ")" ::: "memory")
#define PG8_WAIT_L(n) asm volatile("s_waitcnt lgkmcnt(" #n ")" ::: "memory")
#define PG8_BAR __builtin_amdgcn_s_barrier()
#define PG8_SCHED __builtin_amdgcn_sched_barrier(0)
    Unit cur, nxt; int ui = 0;
    if (!S.next(0, cur)) return;
    f32x4 acc[2][2][4][2];
#pragma unroll
    for (int a = 0; a < 2; ++a)
#pragma unroll
        for (int b = 0; b < 2; ++b)
#pragma unroll
            for (int m = 0; m < 4; ++m)
#pragma unroll
                for (int n = 0; n < 2; ++n) acc[a][b][m][n] = (f32x4){0.f, 0.f, 0.f, 0.f};
    bf16x8 At[4][2], B0[2][2], B1[2][2];
    const char* cA = (const char*)g.A + (size_t)cur.pm * tstep; const char* cB = (const char*)g.Bt + (size_t)cur.pn * tstep;
    S.a_ready(cur);
    if constexpr (SP2) {
        PG8_STAGE(PG8_SB(0, 0), cB, voffB); PG8_STAGE(PG8_SB(0, 1), cB + hstep, voffB); PG8_STAGE(PG8_SA(0, 0), cA, voffA); PG8_STAGE(PG8_SA(0, 1), cA + hstep, voffA);
        if (wr == 1) PG8_BAR;
        PG8_WAIT_V(2); PG8_BAR;
        PG8_STAGE(PG8_SB(1, 0), cB + kstep, voffB); PG8_STAGE(PG8_SA(1, 0), cA + kstep, voffA); PG8_STAGE(PG8_SB(1, 1), cB + hstep + kstep, voffB);
        PG8_WAIT_V(6); PG8_BAR;
    } else {
        PG8_STAGE(PG8_SB(0, 0), cB, voffB); PG8_STAGE(PG8_SA(0, 0), cA, voffA); PG8_STAGE(PG8_SB(0, 1), cB + hstep, voffB); PG8_STAGE(PG8_SA(0, 1), cA + hstep, voffA);
        if (wr == 1) PG8_BAR;
        PG8_WAIT_V(4); PG8_BAR;
        PG8_STAGE(PG8_SB(1, 0), cB + kstep, voffB); PG8_STAGE(PG8_SA(1, 0), cA + kstep, voffA); PG8_STAGE(PG8_SB(1, 1), cB + hstep + kstep, voffB);
        PG8_WAIT_V(6); PG8_BAR;
    }
    for (;;) {
        const bool has_next = S.next(ui + 1, nxt);
        const char* nA = has_next ? (const char*)g.A + (size_t)nxt.pm * tstep : cA; const char* nB = has_next ? (const char*)g.Bt + (size_t)nxt.pn * tstep : cB;
        for (int t = 0; t < nt; t += 2) {
            const bool last = (t == nt - 2);
            const char* a1 = cA + (size_t)(t + 1) * kstep;
            const char* a2 = last ? nA : cA + (size_t)(t + 2) * kstep; const char* b2 = last ? nB : cB + (size_t)(t + 2) * kstep;
            const char* a3 = a2 + kstep; const char* b3 = b2 + kstep;
            if (last && has_next) S.a_ready(nxt);
            if constexpr (SP2) {
            PG8_LDB(B0, 0, 0); PG8_LDB(B1, 0, 1); PG8_SCHED; PG8_LDA(At, 0, 0); PG8_STAGE(PG8_SA(1, 1), a1 + hstep, voffA);
            PG8_WAIT_V(8); PG8_WAIT_L(0); PG8_BAR; PG8_MMA(0, 0, At, B0); PG8_MMA(0, 1, At, B1); PG8_BAR; PG8_SCHED;
            PG8_LDA(At, 0, 1); PG8_STAGE(PG8_SB(0, 0), b2, voffB); PG8_STAGE(PG8_SB(0, 1), b2 + hstep, voffB); PG8_STAGE(PG8_SA(0, 0), a2, voffA);
            PG8_WAIT_V(8); PG8_WAIT_L(0); PG8_BAR; PG8_MMA(1, 0, At, B0); PG8_MMA(1, 1, At, B1); PG8_BAR; PG8_SCHED;
            PG8_LDB(B0, 1, 0); PG8_LDB(B1, 1, 1); PG8_SCHED; PG8_LDA(At, 1, 0); PG8_STAGE(PG8_SA(0, 1), a2 + hstep, voffA);
            PG8_WAIT_V(8); PG8_WAIT_L(0); PG8_BAR; PG8_MMA(0, 0, At, B0); PG8_MMA(0, 1, At, B1); PG8_BAR; PG8_SCHED;
            PG8_LDA(At, 1, 1); PG8_STAGE(PG8_SB(1, 0), b3, voffB); PG8_STAGE(PG8_SB(1, 1), b3 + hstep, voffB); PG8_STAGE(PG8_SA(1, 0), a3, voffA);
            PG8_WAIT_V(8); PG8_WAIT_L(0); PG8_BAR; PG8_MMA(1, 0, At, B0); PG8_MMA(1, 1, At, B1); PG8_BAR; PG8_SCHED;
            } else {
            PG8_LDB(B0, 0, 0); PG8_SCHED; PG8_LDA(At, 0, 0); PG8_STAGE(PG8_SA(1, 1), a1 + hstep, voffA);
            PG8_WAIT_L(8); PG8_BAR; PG8_WAIT_L(0); PG8_MMA(0, 0, At, B0); PG8_BAR; PG8_SCHED;
            PG8_LDB(B1, 0, 1); PG8_STAGE(PG8_SB(0, 0), b2, voffB);
            PG8_BAR; PG8_WAIT_L(0); PG8_MMA(0, 1, At, B1); PG8_BAR;
            PG8_LDA(At, 0, 1); PG8_STAGE(PG8_SA(0, 0), a2, voffA);
            PG8_BAR; PG8_WAIT_L(0); PG8_MMA(1, 0, At, B0); PG8_BAR; PG8_SCHED;
            PG8_STAGE(PG8_SB(0, 1), b2 + hstep, voffB);
            PG8_WAIT_V(6); PG8_BAR; PG8_MMA(1, 1, At, B1); PG8_BAR;
            PG8_LDB(B0, 1, 0); PG8_SCHED; PG8_LDA(At, 1, 0); PG8_STAGE(PG8_SA(0, 1), a2 + hstep, voffA);
            PG8_WAIT_L(8); PG8_BAR; PG8_WAIT_L(0); PG8_MMA(0, 0, At, B0); PG8_BAR; PG8_SCHED;
            PG8_LDB(B1, 1, 1); PG8_STAGE(PG8_SB(1, 0), b3, voffB);
            PG8_BAR; PG8_WAIT_L(0); PG8_MMA(0, 1, At, B1); PG8_BAR;
            PG8_LDA(At, 1, 1); PG8_STAGE(PG8_SA(1, 0), a3, voffA);
            PG8_BAR; PG8_WAIT_L(0); PG8_MMA(1, 0, At, B0); PG8_BAR; PG8_SCHED;
            PG8_STAGE(PG8_SB(1, 1), b3 + hstep, voffB);
            PG8_WAIT_V(6); PG8_BAR; PG8_MMA(1, 1, At, B1); PG8_BAR;
            }
        }
        if constexpr (ALIGN_EPI) { if (wr == 0) PG8_BAR; }
        if constexpr (!Epi::AFTER_DRAIN) { E(acc, cur, wr, wc, fr, fq); S.done(cur); }
        if (!has_next) break;
#pragma unroll
        for (int a = 0; a < 2; ++a)
#pragma unroll
            for (int b = 0; b < 2; ++b)
#pragma unroll
                for (int m = 0; m < 4; ++m)
#pragma unroll
                    for (int n = 0; n < 2; ++n) acc[a][b][m][n] = (f32x4){0.f, 0.f, 0.f, 0.f};
        cur = nxt; cA = nA; cB = nB; ++ui;
        if constexpr (ALIGN_EPI) { if (wr == 1) PG8_BAR; }
    }
    PG8_WAIT_V(0);
    if constexpr (!ALIGN_EPI) { if (wr == 0) PG8_BAR; }
    PG8_BAR;
    if constexpr (Epi::AFTER_DRAIN) { E.fused(acc, cur, wr, wc, fr, fq, lds, wid, lane); S.done(cur); }
#undef PG8_SA
#undef PG8_SB
#undef PG8_STAGE
#undef PG8_LDA
#undef PG8_LDB
#undef PG8_MMA
#undef PG8_WAIT_V
#undef PG8_WAIT_L
#undef PG8_BAR
#undef PG8_SCHED
}
}

constexpr int NB = 8, SEQ = 2048, DM = 2048, T = NB * SEQ;
constexpr int DFF = 5632, NIN = 5120, NMOD = 6 * DM;
constexpr int NPROJ = 4096;
constexpr float EPS = 1e-6f;
constexpr int NTHREADS = 512, NWAVES = 8;
constexpr int LDS_BYTES = 147456;
constexpr float QSCALE = 0.08838834764831845f * 1.4426950408889634f;

constexpr size_t MiB = 1u << 20;
constexpr size_t WS_BAR = 0;
constexpr size_t WS_MOD = 512 * 1024;
constexpr size_t WS_SS1 = 1 * MiB;
constexpr size_t WS_SS2 = 3 * MiB;
constexpr size_t WS_WIN = 6 * MiB;
constexpr size_t WS_WOUT = 26 * MiB;
constexpr size_t WS_WGU = 34 * MiB;
constexpr size_t WS_WDN = 78 * MiB;
constexpr size_t WS_H = 100 * MiB;
constexpr size_t WS_PROJ = 164 * MiB;
constexpr size_t WS_VT = 292 * MiB;
constexpr size_t WS_O = 324 * MiB;
constexpr size_t WS_GU = 164 * MiB;
constexpr size_t WS_END = 388 * MiB;
static_assert(WS_GU + (size_t)T * DFF * 2 <= WS_END, "ws map");

#define LAS __attribute__((address_space(3)))
typedef unsigned short bf16;
typedef unsigned v4u __attribute__((ext_vector_type(4)));
typedef unsigned v2u __attribute__((ext_vector_type(2)));
typedef float f32x4 __attribute__((ext_vector_type(4)));
typedef short bf16x8 __attribute__((ext_vector_type(8)));
typedef short bf16x4 __attribute__((ext_vector_type(4)));

__device__ __forceinline__ unsigned pk2(float lo, float hi) { return pg8::cvt_pk_bf16(lo, hi); }
__device__ __forceinline__ float bflo(unsigned w) { return __uint_as_float(w << 16); }
__device__ __forceinline__ float bfhi(unsigned w) { return __uint_as_float(w & 0xffff0000u); }
__device__ __forceinline__ float wave_sum(float v) {
#pragma unroll
    for (int o = 1; o < 64; o <<= 1) v += __shfl_xor(v, o);
    return v;
}

struct Params {
    const float *x, *c, *w_ada, *b_ada, *norm1_g, *w_in, *v_norm_g, *w_spatial, *b_spatial, *out_norm_g, *w_out, *norm2_g, *w_gate, *w_up, *w_down, *final_g;
    float* out; unsigned char* ws;
};

constexpr int TSCR = 16640;
__device__ __forceinline__ void transpose_item(const float* W, int K, int N, bf16* WT, int k0, int n0, int drow0, LAS float* scr, int lane) {
    const int lr = lane >> 4, lc = (lane & 15) * 4;
    const float* src = W + (size_t)(k0 + lr) * N + n0 + lc;
#pragma unroll 8
    for (int i = 0; i < 16; ++i) { const f32x4 v = *(const f32x4*)(src + (size_t)(4 * i) * N); LAS float* d = scr + (4 * i + lr) * 65 + lc; d[0] = v[0]; d[1] = v[1]; d[2] = v[2]; d[3] = v[3]; }
    asm volatile("s_waitcnt lgkmcnt(0)" ::: "memory");
    const int c = lane & 7;
#pragma unroll
    for (int j = 0; j < 8; ++j) { const int n = (lane >> 3) + 8 * j; const LAS float* q = scr + (8 * c) * 65 + n;
        v4u o; o.x = pk2(q[0 * 65], q[1 * 65]); o.y = pk2(q[2 * 65], q[3 * 65]); o.z = pk2(q[4 * 65], q[5 * 65]); o.w = pk2(q[6 * 65], q[7 * 65]);
        *(v4u*)(WT + (size_t)(drow0 + n) * K + k0 + 8 * c) = o; }
    asm volatile("s_waitcnt lgkmcnt(0)" ::: "memory");
}

__device__ __forceinline__ void phase_prep(const Params& p, LAS unsigned char* lds, int vcu, int G) {
    const int tid = fresh_tid(), lane = tid & 63, wave = __builtin_amdgcn_readfirstlane(tid >> 6);
    LAS float* scr = (LAS float*)(lds + wave * TSCR);
    const int gw = vcu * NWAVES + wave, NGW = G * NWAVES;
    unsigned char* ws = p.ws;
    bf16* Win = (bf16*)(ws + WS_WIN); bf16* Wout = (bf16*)(ws + WS_WOUT); bf16* Wgu = (bf16*)(ws + WS_WGU); bf16* Wdn = (bf16*)(ws + WS_WDN);
    for (int cb = vcu; cb < NMOD / 64; cb += G) {
        float* mod = (float*)(ws + WS_MOD);
        const int kbase = 256 * wave, col = cb * 64 + lane;
#pragma unroll
        for (int b = 0; b < 8; ++b) { f32x4 cv = *(const f32x4*)(p.c + b * DM + kbase + lane * 4);
#pragma unroll
            for (int j = 0; j < 4; ++j) cv[j] = cv[j] / (1.0f + __expf(-cv[j]));
            *(LAS f32x4*)(scr + b * 256 + lane * 4) = cv; }
        asm volatile("s_waitcnt lgkmcnt(0)" ::: "memory");
        float a[8];
#pragma unroll
        for (int b = 0; b < 8; ++b) a[b] = 0.f;
        const float* wp = p.w_ada + (size_t)kbase * NMOD + col;
#pragma unroll 4
        for (int k4 = 0; k4 < 64; ++k4) {
            float wv[4];
#pragma unroll
            for (int i = 0; i < 4; ++i) wv[i] = wp[(size_t)(4 * k4 + i) * NMOD];
#pragma unroll
            for (int b = 0; b < 8; ++b) { const f32x4 sv = *(const LAS f32x4*)(scr + b * 256 + 4 * k4); a[b] += (wv[0] * sv[0] + wv[1] * sv[1]) + (wv[2] * sv[2] + wv[3] * sv[3]); }
        }
        __syncthreads();
        LAS float* red = (LAS float*)lds;
#pragma unroll
        for (int b = 0; b < 8; ++b) red[(wave * 8 + b) * 64 + lane] = a[b];
        __syncthreads();
        { const int b = tid >> 6; float sacc = p.b_ada[col];
#pragma unroll
          for (int w2 = 0; w2 < 8; ++w2) sacc += red[(w2 * 8 + b) * 64 + lane];
          mod[(size_t)b * NMOD + col] = sacc; }
        __syncthreads();
    }
    constexpr int I_IN = (DM / 64) * (NIN / 64), I_OUT = (DM / 64) * (DM / 64), I_G = (DM / 64) * (DFF / 64), I_D = (DFF / 64) * (DM / 64);
    constexpr int NITEMS = I_IN + I_OUT + 2 * I_G + I_D;
    for (int it = gw; it < NITEMS; it += NGW) {
        int r = it;
        if (r < I_IN) { const int nb = NIN / 64, kb = r / nb, n0 = (r % nb) * 64; transpose_item(p.w_in, DM, NIN, Win, kb * 64, n0, n0, scr, lane); continue; } r -= I_IN;
        if (r < I_OUT) { const int nb = DM / 64, kb = r / nb, n0 = (r % nb) * 64; transpose_item(p.w_out, DM, DM, Wout, kb * 64, n0, n0, scr, lane); continue; } r -= I_OUT;
        if (r < I_G) { const int nb = DFF / 64, kb = r / nb, n0 = (r % nb) * 64; transpose_item(p.w_gate, DM, DFF, Wgu, kb * 64, n0, (n0 >> 7) * 256 + (n0 & 127), scr, lane); continue; } r -= I_G;
        if (r < I_G) { const int nb = DFF / 64, kb = r / nb, n0 = (r % nb) * 64; transpose_item(p.w_up, DM, DFF, Wgu, kb * 64, n0, (n0 >> 7) * 256 + 128 + (n0 & 127), scr, lane); continue; } r -= I_G;
        { const int nb = DM / 64, kb = r / nb, n0 = (r % nb) * 64; transpose_item(p.w_down, DFF, DM, Wdn, kb * 64, n0, n0, scr, lane); }
    }
}

template <int MODE>
__device__ __forceinline__ void phase_norm_mod(const Params& p, const float* src, const float* ssp, const float* ng, int shift_chunk, bf16* dst, int vcu, int G) {
    const int tid = fresh_tid(), lane = tid & 63, wave = __builtin_amdgcn_readfirstlane(tid >> 6);
    const int gw = vcu * NWAVES + wave, NGW = G * NWAVES;
    const float* mod = (const float*)(p.ws + WS_MOD);
    for (int rb = gw; rb < T / 8; rb += NGW) {
        const int b = (rb * 8) / SEQ;
        f32x4 A[8], B[8];
#pragma unroll
        for (int j = 0; j < 8; ++j) { const int cidx = lane * 4 + 256 * j;
            const f32x4 g = *(const f32x4*)(ng + cidx);
            const f32x4 sh = *(const f32x4*)(mod + (size_t)b * NMOD + shift_chunk * DM + cidx);
            const f32x4 sc = *(const f32x4*)(mod + (size_t)b * NMOD + (shift_chunk + 1) * DM + cidx);
            A[j] = g * (sc + 1.0f); B[j] = sh; }
        for (int rr = 0; rr < 8; ++rr) {
            const int row = rb * 8 + rr;
            const f32x4* xr = (const f32x4*)(src + (size_t)row * DM) + lane;
            f32x4 v[8]; float s = 0.f;
#pragma unroll
            for (int j = 0; j < 8; ++j) { v[j] = xr[64 * j]; s += (v[j][0] * v[j][0] + v[j][1] * v[j][1]) + (v[j][2] * v[j][2] + v[j][3] * v[j][3]); }
            float tot;
            if (MODE == 0) tot = wave_sum(s);
            else { float q = (lane < 32) ? ssp[(size_t)row * 32 + lane] : 0.f; tot = wave_sum(q); }
            const float rstd = 1.0f / sqrtf(tot * (1.0f / DM) + EPS);
            v2u* o8 = (v2u*)(dst + (size_t)row * DM) + lane;
#pragma unroll
            for (int j = 0; j < 8; ++j) { const f32x4 h = (v[j] * rstd) * A[j] + B[j]; v2u w; w.x = pk2(h[0], h[1]); w.y = pk2(h[2], h[3]); o8[64 * j] = w; }
        }
    }
}

__device__ __forceinline__ void phase_final(const Params& p, const float* ssp, int vcu, int G) {
    const int tid = fresh_tid(), lane = tid & 63, wave = __builtin_amdgcn_readfirstlane(tid >> 6);
    const int gw = vcu * NWAVES + wave, NGW = G * NWAVES;
    f32x4 g[8];
#pragma unroll
    for (int j = 0; j < 8; ++j) g[j] = *(const f32x4*)(p.final_g + lane * 4 + 256 * j);
    for (int row = gw; row < T; row += NGW) {
        f32x4* xr = (f32x4*)(p.out + (size_t)row * DM) + lane;
        f32x4 v[8];
#pragma unroll
        for (int j = 0; j < 8; ++j) v[j] = xr[64 * j];
        float q = (lane < 32) ? ssp[(size_t)row * 32 + lane] : 0.f; const float tot = wave_sum(q);
        const float rstd = 1.0f / sqrtf(tot * (1.0f / DM) + EPS);
#pragma unroll
        for (int j = 0; j < 8; ++j) xr[64 * j] = (v[j] * rstd) * g[j];
    }
}

constexpr int TP = 136;
__device__ __forceinline__ void gmlp_tile(const Params& p, LAS unsigned char* lds, int b, int n, int g) {
    const int tid = fresh_tid(), lane = tid & 63, w = __builtin_amdgcn_readfirstlane(tid >> 6), r = lane & 15, cgp = lane >> 4;
    const bf16* PROJ = (const bf16*)(p.ws + WS_PROJ); bf16* O = (bf16*)(p.ws + WS_O);
    LAS bf16* Vt = (LAS bf16*)lds;
    const int tok0 = b * SEQ + n * 128;
    {
        const int s = 16 * w + r;
        const bf16* src = PROJ + (size_t)(tok0 + s) * NPROJ + 1024 + g * 128;
        float xv[4][8]; float s1 = 0.f;
#pragma unroll
        for (int pp = 0; pp < 4; ++pp) { const v4u raw = *(const v4u*)(src + (cgp * 4 + pp) * 8);
            xv[pp][0] = bflo(raw.x); xv[pp][1] = bfhi(raw.x); xv[pp][2] = bflo(raw.y); xv[pp][3] = bfhi(raw.y); xv[pp][4] = bflo(raw.z); xv[pp][5] = bfhi(raw.z); xv[pp][6] = bflo(raw.w); xv[pp][7] = bfhi(raw.w);
#pragma unroll
            for (int j = 0; j < 8; ++j) s1 += xv[pp][j]; }
        s1 += __shfl_xor(s1, 16); s1 += __shfl_xor(s1, 32);
        const float mean = s1 * (1.0f / 128.0f); float s2 = 0.f;
#pragma unroll
        for (int pp = 0; pp < 4; ++pp)
#pragma unroll
            for (int j = 0; j < 8; ++j) { xv[pp][j] -= mean; s2 += xv[pp][j] * xv[pp][j]; }
        s2 += __shfl_xor(s2, 16); s2 += __shfl_xor(s2, 32);
        const float rstd = 1.0f / sqrtf(s2 * (1.0f / 128.0f) + EPS);
#pragma unroll
        for (int pp = 0; pp < 4; ++pp) { const int d0 = (cgp * 4 + pp) * 8;
            const f32x4 g0 = *(const f32x4*)(p.v_norm_g + g * 128 + d0), g1 = *(const f32x4*)(p.v_norm_g + g * 128 + d0 + 4);
#pragma unroll
            for (int j = 0; j < 8; ++j) { const float y = xv[pp][j] * rstd * (j < 4 ? g0[j & 3] : g1[j & 3]); Vt[(d0 + j) * TP + s] = (bf16)(pk2(y, 0.f) & 0xffffu); } }
    }
    __syncthreads();
    f32x4 acc[8];
#pragma unroll
    for (int nd = 0; nd < 8; ++nd) acc[nd] = (f32x4){0.f, 0.f, 0.f, 0.f};
    const int t = 16 * w + r;
    const float* wrow = p.w_spatial + (size_t)(g * 128 + t) * 128;
    for (int kk = 0; kk <= (w >> 1); ++kk) {
        const int s0 = kk * 32 + cgp * 8;
        const f32x4 w0 = *(const f32x4*)(wrow + s0), w1 = *(const f32x4*)(wrow + s0 + 4);
        float wv[8] = {w0[0], w0[1], w0[2], w0[3], w1[0], w1[1], w1[2], w1[3]};
#pragma unroll
        for (int j = 0; j < 8; ++j) wv[j] = (s0 + j <= t) ? wv[j] : 0.f;
        v4u wp; wp.x = pk2(wv[0], wv[1]); wp.y = pk2(wv[2], wv[3]); wp.z = pk2(wv[4], wv[5]); wp.w = pk2(wv[6], wv[7]);
        const bf16x8 wf = __builtin_bit_cast(bf16x8, wp);
#pragma unroll
        for (int nd = 0; nd < 8; ++nd) { const bf16x8 vf = *(const LAS bf16x8*)(Vt + (nd * 16 + r) * TP + s0);
            acc[nd] = __builtin_amdgcn_mfma_f32_16x16x32_bf16(vf, wf, acc[nd], 0, 0, 0); }
    }
    const float bsv = p.b_spatial[g * 128 + t];
    const bf16* urow = PROJ + (size_t)(tok0 + t) * NPROJ + g * 128 + cgp * 4;
    float ss = 0.f;
#pragma unroll
    for (int nd = 0; nd < 8; ++nd) { const v2u uw = *(const v2u*)(urow + nd * 16);
        f32x4 o; o[0] = bflo(uw.x) * (acc[nd][0] + bsv); o[1] = bfhi(uw.x) * (acc[nd][1] + bsv); o[2] = bflo(uw.y) * (acc[nd][2] + bsv); o[3] = bfhi(uw.y) * (acc[nd][3] + bsv);
        acc[nd] = o; ss += (o[0] * o[0] + o[1] * o[1]) + (o[2] * o[2] + o[3] * o[3]); }
    ss += __shfl_xor(ss, 16); ss += __shfl_xor(ss, 32);
    const float rs = 1.0f / sqrtf(ss * (1.0f / 128.0f) + EPS);
    bf16* orow = O + (size_t)(tok0 + t) * DM + g * 128 + cgp * 4;
#pragma unroll
    for (int nd = 0; nd < 8; ++nd) { const f32x4 og = *(const f32x4*)(p.out_norm_g + g * 128 + nd * 16 + cgp * 4);
        v2u wv2; wv2.x = pk2(acc[nd][0] * rs * og[0], acc[nd][1] * rs * og[1]); wv2.y = pk2(acc[nd][2] * rs * og[2], acc[nd][3] * rs * og[3]);
        *(v2u*)(orow + nd * 16) = wv2; }
    __syncthreads();
}

typedef float f32x16 __attribute__((ext_vector_type(16)));
constexpr int TPK = 136, TPV = 132;
template <bool DIAG>
__device__ __forceinline__ void sb_tile(f32x16& z, float& run, int r, int hi) {
    float be[16], om[16];
#pragma unroll
    for (int i = 0; i < 16; ++i) { const float zc = fmaxf(z[i], -126.0f); const float e = __builtin_amdgcn_exp2f(-zc);
        be[i] = __builtin_amdgcn_rcpf(1.0f + e); om[i] = e * be[i];
        if (DIAG) { const bool valid = (8 * (i >> 2) + 4 * hi + (i & 3)) < r; be[i] = valid ? be[i] : 0.f; om[i] = valid ? om[i] : 1.0f; } }
    float P[4], xo[4], Tt[4];
#pragma unroll
    for (int g = 0; g < 4; ++g) P[g] = (om[4 * g] * om[4 * g + 1]) * (om[4 * g + 2] * om[4 * g + 3]);
#pragma unroll
    for (int g = 0; g < 4; ++g) { const unsigned u = __float_as_uint(P[g]); const auto sw = __builtin_amdgcn_permlane32_swap(u, u, false, false);
        xo[g] = __uint_as_float(sw[1]); Tt[g] = __uint_as_float(sw[0]) * __uint_as_float(sw[1]); }
#pragma unroll
    for (int g = 3; g >= 0; --g) {
        float tl = run * (hi ? 1.0f : xo[g]); run *= Tt[g];
        z[4 * g + 3] = be[4 * g + 3] * tl; tl *= om[4 * g + 3];
        z[4 * g + 2] = be[4 * g + 2] * tl; tl *= om[4 * g + 2];
        z[4 * g + 1] = be[4 * g + 1] * tl; tl *= om[4 * g + 1];
        z[4 * g + 0] = be[4 * g + 0] * tl;
    }
}
__device__ __forceinline__ void sb_unit(const Params& p, LAS unsigned char* lds, int b, int h, int qb) {
    const int tid = fresh_tid(), lane = tid & 63, w = __builtin_amdgcn_readfirstlane(tid >> 6), r = lane & 31, hi = lane >> 5;
    const bf16* PROJ = (const bf16*)(p.ws + WS_PROJ); const bf16* VT = (const bf16*)(p.ws + WS_VT); bf16* O = (bf16*)(p.ws + WS_O);
    LAS bf16* Ks = (LAS bf16*)lds;
    LAS bf16* Vs = (LAS bf16*)(lds + 2 * 128 * TPK * 2);
    const int tok0 = b * SEQ;
    const int qt = 8 * qb + w;
    bf16x8 qf[8];
    { const bf16* qrow = PROJ + (size_t)(tok0 + 32 * qt + r) * NPROJ + 2048 + h * 128 + 8 * hi;
#pragma unroll
      for (int st = 0; st < 8; ++st) qf[st] = *(const bf16x8*)(qrow + 16 * st);
#pragma unroll
      for (int st = 0; st < 8; ++st) asm volatile("" : "+v"(qf[st])); }
    const bf16* kbase = PROJ + (size_t)tok0 * NPROJ + 3072 + h * 128;
    const bf16* vbase = VT + (size_t)(h * 128) * T + tok0;
    v4u kr[4], vr[4];
#define SB_LOAD(jb) do { _Pragma("unroll") for (int pp = 0; pp < 4; ++pp) { const int c = tid + 512 * pp, rw = c >> 4, pc = c & 15; \
        kr[pp] = *(const v4u*)(kbase + (size_t)((jb) * 128 + rw) * NPROJ + pc * 8); vr[pp] = *(const v4u*)(vbase + (size_t)rw * T + (jb) * 128 + pc * 8); } } while (0)
#define SB_STORE(buf) do { _Pragma("unroll") for (int pp = 0; pp < 4; ++pp) { const int c = tid + 512 * pp, rw = c >> 4, pc = c & 15; \
        *(LAS v4u*)(Ks + ((buf) * 128 + rw) * TPK + pc * 8) = kr[pp]; \
        LAS v2u* vd = (LAS v2u*)(Vs + ((buf) * 128 + rw) * TPV + pc * 8); v2u lo2, hi2; lo2.x = vr[pp].x; lo2.y = vr[pp].y; hi2.x = vr[pp].z; hi2.y = vr[pp].w; vd[0] = lo2; vd[1] = hi2; } } while (0)
    f32x16 oacc[4];
#pragma unroll
    for (int dt = 0; dt < 4; ++dt)
#pragma unroll
        for (int i = 0; i < 16; ++i) oacc[dt][i] = 0.f;
    float run = 1.0f;
    const int jtop = 2 * qb + 1;
    SB_LOAD(jtop); SB_STORE(0);
    __syncthreads();
    for (int jb = jtop; jb >= 0; --jb) {
        const int cur = (jtop - jb) & 1;
        if (jb > 0) SB_LOAD(jb - 1);
#pragma unroll 1
        for (int c = 3; c >= 0; --c) {
            const int kt = 4 * jb + c;
            if (kt > qt) continue;
            const bool diag = (kt == qt);
            const LAS bf16* kp = Ks + (cur * 128 + 32 * c + r) * TPK + 8 * hi;
            bf16x8 kf[8];
#pragma unroll
            for (int st = 0; st < 8; ++st) kf[st] = *(const LAS bf16x8*)(kp + 16 * st);
            __builtin_amdgcn_sched_barrier(0);
            f32x16 z;
#pragma unroll
            for (int i = 0; i < 16; ++i) z[i] = 0.f;
#pragma unroll
            for (int st = 0; st < 8; ++st) z = __builtin_amdgcn_mfma_f32_32x32x16_bf16(kf[st], qf[st], z, 0, 0, 0);
            __builtin_amdgcn_sched_barrier(0);
            v2u vlo[2][4], vhh[2][4];
#pragma unroll
            for (int s2 = 0; s2 < 2; ++s2)
#pragma unroll
                for (int dt = 0; dt < 4; ++dt) { const LAS bf16* vp = Vs + (cur * 128 + 32 * dt + r) * TPV + 32 * c + 16 * s2 + 4 * hi;
                    vlo[s2][dt] = *(const LAS v2u*)vp; vhh[s2][dt] = *(const LAS v2u*)(vp + 8); }
            __builtin_amdgcn_sched_barrier(0);
            if (diag) sb_tile<true>(z, run, r, hi); else sb_tile<false>(z, run, r, hi);
            __builtin_amdgcn_sched_barrier(0);
#pragma unroll
            for (int s2 = 0; s2 < 2; ++s2) {
                v4u pw; pw.x = pk2(z[8 * s2 + 0], z[8 * s2 + 1]); pw.y = pk2(z[8 * s2 + 2], z[8 * s2 + 3]); pw.z = pk2(z[8 * s2 + 4], z[8 * s2 + 5]); pw.w = pk2(z[8 * s2 + 6], z[8 * s2 + 7]);
                const bf16x8 pf = __builtin_bit_cast(bf16x8, pw);
#pragma unroll
                for (int dt = 0; dt < 4; ++dt) { v4u vw; vw.x = vlo[s2][dt].x; vw.y = vlo[s2][dt].y; vw.z = vhh[s2][dt].x; vw.w = vhh[s2][dt].y;
                    oacc[dt] = __builtin_amdgcn_mfma_f32_32x32x16_bf16(__builtin_bit_cast(bf16x8, vw), pf, oacc[dt], 0, 0, 0); }
            }
        }
        if (jb > 0) SB_STORE(cur ^ 1);
        __syncthreads();
    }
#undef SB_LOAD
#undef SB_STORE
    float ss = 0.f;
#pragma unroll
    for (int dt = 0; dt < 4; ++dt)
#pragma unroll
        for (int i = 0; i < 16; ++i) ss += oacc[dt][i] * oacc[dt][i];
    ss += __shfl_xor(ss, 32);
    const float rs = 1.0f / sqrtf(ss * (1.0f / 128.0f) + EPS);
    bf16* orow = O + (size_t)(tok0 + 32 * qt + r) * DM + 1024 + h * 128 + 4 * hi;
    const float* ogp = p.out_norm_g + 1024 + h * 128 + 4 * hi;
#pragma unroll
    for (int dt = 0; dt < 4; ++dt)
#pragma unroll
        for (int g = 0; g < 4; ++g) { const f32x4 og = *(const f32x4*)(ogp + 32 * dt + 8 * g);
            v2u wv2; wv2.x = pk2(oacc[dt][4 * g + 0] * rs * og[0], oacc[dt][4 * g + 1] * rs * og[1]); wv2.y = pk2(oacc[dt][4 * g + 2] * rs * og[2], oacc[dt][4 * g + 3] * rs * og[3]);
            *(v2u*)(orow + 32 * dt + 8 * g) = wv2; }
}

__device__ __forceinline__ void phase_mixers(const Params& p, LAS unsigned char* lds, int vcu, int G) {
    for (int pr = vcu; pr < 256; pr += G) {
        const int bh = pr >> 2, ip = pr & 3, b = bh >> 3, h = bh & 7;
        sb_unit(p, lds, b, h, 7 - ip);
        sb_unit(p, lds, b, h, ip);
    }
    for (int tl = vcu; tl < 1024; tl += G) { const int g = tl & 7, n = (tl >> 3) & 15, b = tl >> 7; gmlp_tile(p, lds, b, n, g); }
}

#define XB_TMO      128
#define XB_XCNT(j)  (256  + 64 * (j))
#define XB_XSUB(j)  (1280 + 64 * (j))
#define XB_XGEN(j)  (2304 + 64 * (j))
#define XB_TOP      3328
#define XB_TOPGEN   3392
#define XCD_BAR_WORDS 3456
#define XB_SPIN_CAP (1u << 18)

__device__ __forceinline__ unsigned xb_ld(unsigned* p)              { return __hip_atomic_load(p, __ATOMIC_RELAXED, __HIP_MEMORY_SCOPE_AGENT); }
__device__ __forceinline__ unsigned xb_add(unsigned* p, unsigned v) { return __hip_atomic_fetch_add(p, v, __ATOMIC_RELAXED, __HIP_MEMORY_SCOPE_AGENT); }
__device__ __forceinline__ unsigned xb_xcc_id() { return (unsigned)__builtin_amdgcn_s_getreg((3 << 11) | 20) & 0xFu; }
#define XB_SPIN(cond, bar) do { unsigned _sp = 0; while (cond) { __builtin_amdgcn_s_sleep(1); \
    if ((++_sp & 255u) == 0u) { if (xb_ld(&(bar)[XB_TMO])) break; if (_sp > XB_SPIN_CAP) { atomicAdd(&(bar)[XB_TMO], 1u); break; } } } } while (0)

struct XcdBarrier {
    unsigned* bar; unsigned x;
    volatile LAS unsigned* st;
};

__device__ __forceinline__ XcdBarrier xcd_barrier_post(unsigned* bar, volatile LAS unsigned* st) {
    XcdBarrier b; b.bar = bar; b.x = xb_xcc_id(); b.st = st;
    if (threadIdx.x == 0) (void)xb_add(&bar[XB_XCNT(b.x)], 1u);
    return b;
}
__device__ __forceinline__ void xcd_barrier_complete(unsigned* bar, unsigned x, unsigned& nloc, unsigned& nx) {
    const unsigned G = gridDim.x * gridDim.y * gridDim.z;
    unsigned sum, cnt, mine, sp = 0u;
    for (;;) {
        sum = 0u; cnt = 0u; mine = 0u;
#pragma unroll
        for (unsigned j = 0; j < 16; ++j) { const unsigned c = xb_ld(&bar[XB_XCNT(j)]); sum += c; cnt += (c > 0u) ? 1u : 0u; mine = (j == x) ? c : mine; }
        if (sum == G) break;
        __builtin_amdgcn_s_sleep(1);
        if ((++sp & 255u) == 0u) { if (xb_ld(&bar[XB_TMO])) break; if (sp > XB_SPIN_CAP) { atomicAdd(&bar[XB_TMO], 1u); break; } }
    }
    nloc = mine > 0u ? mine : 1u; nx = cnt > 0u ? cnt : 1u;
}

__device__ __forceinline__ void xcd_barrier(const XcdBarrier& b) {
    asm volatile("s_waitcnt vmcnt(0)" ::: "memory");
    __syncthreads();
    if (threadIdx.x == 0) {
        unsigned* bar = b.bar;
        __builtin_amdgcn_s_waitcnt(0);
        unsigned nloc = b.st[0], nx = b.st[1];
        if (nloc == 0u) { xcd_barrier_complete(bar, b.x, nloc, nx); b.st[0] = nloc; b.st[1] = nx; }
        const unsigned old = xb_add(&bar[XB_XSUB(b.x)], 1u);
        const unsigned gen = old / nloc;
        if (old + 1u == (gen + 1u) * nloc) {
            __builtin_amdgcn_fence(__ATOMIC_RELEASE, "agent");
            asm volatile("s_waitcnt vmcnt(0)" ::: "memory");
            const unsigned og = xb_add(&bar[XB_TOP], 1u);
            const unsigned tg = og / nx;
            if (og + 1u == (tg + 1u) * nx) xb_add(&bar[XB_TOPGEN], 1u);
            else XB_SPIN(xb_ld(&bar[XB_TOPGEN]) == tg, bar);
            __builtin_amdgcn_fence(__ATOMIC_ACQUIRE, "agent");
            xb_add(&bar[XB_XGEN(b.x)], 1u);
            asm volatile("s_waitcnt vmcnt(0)" ::: "memory");
        } else {
            XB_SPIN(xb_ld(&bar[XB_XGEN(b.x)]) == gen, bar);
            __builtin_amdgcn_fence(__ATOMIC_ACQUIRE, "agent");
            asm volatile("s_waitcnt vmcnt(0)" ::: "memory");
        }
    }
    __syncthreads();
}

#ifndef PH_MASK
#define PH_MASK 0x3ff
#endif
#define PH(k) if constexpr ((PH_MASK >> (k)) & 1)
#ifndef DUP_MASK
#define DUP_MASK 0
#endif
#define DUP(k) _Pragma("unroll 1") for (int _r = 0; _r < ((((DUP_MASK) >> (k)) & 1) ? 2 : 1); ++_r)
__global__ void __launch_bounds__(NTHREADS, 2) fwd_megakernel(Params p) {
    extern __shared__ __attribute__((aligned(16))) unsigned char lds_raw[];
    LAS unsigned char* lds = (LAS unsigned char*)lds_raw;
    cg::grid_group grid = cg::this_grid();
    if (p.ws == nullptr) grid.sync();
    volatile LAS unsigned* bst = (volatile LAS unsigned*)(lds + LDS_BYTES - 64);
    if (threadIdx.x == 0) { bst[0] = 0u; bst[1] = 0u; }
    __syncthreads();
    const XcdBarrier bar = xcd_barrier_post((unsigned*)(p.ws + WS_BAR), bst);
    const int G = gridDim.x, bx = blockIdx.x;
    const int vcu = (G % 8 == 0) ? (bx % 8) * (G / 8) + bx / 8 : bx;
    unsigned char* ws = p.ws;
    bf16* Win = (bf16*)(ws + WS_WIN); bf16* Wout = (bf16*)(ws + WS_WOUT); bf16* Wgu = (bf16*)(ws + WS_WGU); bf16* Wdn = (bf16*)(ws + WS_WDN);
    bf16* H = (bf16*)(ws + WS_H); bf16* PROJ = (bf16*)(ws + WS_PROJ); bf16* VT = (bf16*)(ws + WS_VT); bf16* O = (bf16*)(ws + WS_O); bf16* GU = (bf16*)(ws + WS_GU);
    float* mod = (float*)(ws + WS_MOD); float* SS1 = (float*)(ws + WS_SS1); float* SS2 = (float*)(ws + WS_SS2);

    PH(0) DUP(0) phase_prep(p, lds, vcu, G);
    xcd_barrier(bar);
    PH(1) DUP(1) phase_norm_mod<0>(p, p.x, nullptr, p.norm1_g, 0, H, vcu, G);
    xcd_barrier(bar);
    PH(2) DUP(2) {
        pg8::Gemm g{H, Win, T, NPROJ, DM}; pg8::StaticOrder S; S.init(T, NPROJ, G, bx);
        pg8::EpiProj E{PROJ, NPROJ, 8, 8, 12, QSCALE};
        pg8::gemm_phase<pg8::EpiProj, pg8::StaticOrder, true, true>(lds, g, S, E);
    }
    PH(9) DUP(2) {
        pg8::Gemm g{Win + (size_t)NPROJ * DM, H, 1024, T, DM}; pg8::StaticOrder S; S.init(1024, T, G, bx);
        pg8::EpiProj E{VT, T, 0, 0, 0, 1.f};
        pg8::gemm_phase<pg8::EpiProj, pg8::StaticOrder, true, true>(lds, g, S, E);
    }
    xcd_barrier(bar);
    PH(3) DUP(3) phase_mixers(p, lds, vcu, G);
    xcd_barrier(bar);
    PH(4) DUP(4) {
        pg8::Gemm g{O, Wout, T, DM, DM}; pg8::StaticOrder S; S.init(T, DM, G, bx);
        pg8::EpiRes E{p.x, p.out, DM, mod + 2 * DM, SS1};
        pg8::gemm_phase<pg8::EpiRes, pg8::StaticOrder, true, true>(lds, g, S, E);
    }
    xcd_barrier(bar);
    PH(5) DUP(5) phase_norm_mod<1>(p, p.out, SS1, p.norm2_g, 3, H, vcu, G);
    xcd_barrier(bar);
    PH(6) DUP(6) {
        pg8::Gemm g{H, Wgu, T, 2 * DFF, DM}; pg8::StaticOrder S; S.init(T, 2 * DFF, G, bx);
        pg8::EpiGU E{GU, DFF};
        pg8::gemm_phase<pg8::EpiGU, pg8::StaticOrder, true, true>(lds, g, S, E);
    }
    xcd_barrier(bar);
    PH(7) {
        pg8::Gemm g{GU, Wdn, T, DM, DFF}; pg8::StaticOrder S; S.init(T, DM, G, bx);
        pg8::EpiRes E{p.out, p.out, DM, mod + 5 * DM, SS2};
        pg8::gemm_phase<pg8::EpiRes, pg8::StaticOrder, true, true>(lds, g, S, E);
    }
    xcd_barrier(bar);
    PH(8) phase_final(p, SS2, vcu, G);
}

extern "C" void kernel_launch(void* const* d_in, const int* in_sizes, int n_in, void* d_out, int out_size, void* d_ws, size_t ws_size, hipStream_t stream) {
    static int grid_blocks = 0;
    if (grid_blocks == 0) {
        if (n_in != 16 || ws_size < WS_END) { fprintf(stderr, "kernel_launch: unexpected n_in %d / ws_size %zu (need %zu)\n", n_in, ws_size, (size_t)WS_END); grid_blocks = -1; return; }
        int dev = 0, cus = 0, per_cu = 0;
        (void)hipGetDevice(&dev);
        (void)hipDeviceGetAttribute(&cus, hipDeviceAttributeMultiprocessorCount, dev);
        if (hipFuncSetAttribute((const void*)fwd_megakernel, hipFuncAttributeMaxDynamicSharedMemorySize, LDS_BYTES) != hipSuccess) { fprintf(stderr, "kernel_launch: hipFuncSetAttribute failed\n"); grid_blocks = -1; return; }
        if (hipOccupancyMaxActiveBlocksPerMultiprocessor(&per_cu, (const void*)fwd_megakernel, NTHREADS, LDS_BYTES) != hipSuccess || per_cu < 1) { fprintf(stderr, "kernel_launch: occupancy query says %d\n", per_cu); per_cu = 1; }
        (void)hipGetLastError();
        grid_blocks = cus * 1;
    }
    if (grid_blocks < 0) return;
    if (hipMemsetAsync((char*)d_ws + WS_BAR, 0, 16384, stream) != hipSuccess) { fprintf(stderr, "kernel_launch: memset failed\n"); return; }
    Params p{};
    p.x = (const float*)d_in[0]; p.c = (const float*)d_in[1]; p.w_ada = (const float*)d_in[2]; p.b_ada = (const float*)d_in[3]; p.norm1_g = (const float*)d_in[4];
    p.w_in = (const float*)d_in[5]; p.v_norm_g = (const float*)d_in[6]; p.w_spatial = (const float*)d_in[7]; p.b_spatial = (const float*)d_in[8]; p.out_norm_g = (const float*)d_in[9];
    p.w_out = (const float*)d_in[10]; p.norm2_g = (const float*)d_in[11]; p.w_gate = (const float*)d_in[12]; p.w_up = (const float*)d_in[13]; p.w_down = (const float*)d_in[14]; p.final_g = (const float*)d_in[15];
    p.out = (float*)d_out; p.ws = (unsigned char*)d_ws;
    void* args[] = {&p};
    hipError_t e = hipLaunchCooperativeKernel((const void*)fwd_megakernel, dim3(grid_blocks), dim3(NTHREADS), args, LDS_BYTES, stream);
    if (e != hipSuccess) fprintf(stderr, "cooperative launch failed: %s (grid %d)\n", hipGetErrorString(e), grid_blocks);
}
```

```cpp
#define DUP_MASK 0x0
#include <hip/hip_runtime.h>
#include <hip/hip_cooperative_groups.h>
#include <cstdio>
#include <cstdint>
namespace cg = cooperative_groups;
__device__ __forceinline__ int fresh_tid() { int t = threadIdx.x; asm volatile("" : "+v"(t)); return t; }
namespace pg8 {
#define PG8_LAS __attribute__((address_space(3)))
typedef unsigned short bf16_t;
typedef short bf16x8 __attribute__((ext_vector_type(8)));
typedef float f32x4 __attribute__((ext_vector_type(4)));
typedef unsigned u32x4 __attribute__((ext_vector_type(4)));
constexpr int BM = 256, BK = 64, HALF = 128, HTB = HALF * BK * 2  , STAGE_BYTES = 8 * HTB, NXCD = 8, WGM = 8;

__host__ __device__ __forceinline__ int lds_byte(int r, int c) { const int st = (r >> 4) * 2 + (c >> 5), rr = r & 15, cc = c & 31, ob = rr * 64 + cc * 2; return st * 1024 + (ob ^ (((ob >> 9) & 1) << 5)); }
__host__ __device__ __forceinline__ void stage_rc(int b, int& R, int& C) { const int st = b / 1024, sb = b % 1024, swz = sb ^ (((sb >> 9) & 1) << 5); R = (st >> 1) * 16 + swz / 64; C = (st & 1) * 32 + (swz % 64) / 2; }
__host__ __device__ __forceinline__ int perm32(int rho) { const int n = rho >> 4, i = rho & 15; return 8 * (i >> 2) + 4 * n + (i & 3); }

struct Unit { int pm, pn; };
struct Gemm { const bf16_t* A; const bf16_t* Bt; int M, N, K; };

struct StaticOrder {
    int nM, nN, nwg, G, c;
    __host__ __device__ void init(int M, int N, int G_, int c_) { nM = M / BM; nN = N / BM; nwg = nM * nN; G = G_; c = c_; }
    __host__ __device__ bool next(int i, Unit& u) const {
        const long L = (long)i * G + c; if (L >= nwg) return false;
        int wgid = (int)L; { const int q = nwg / NXCD, r = nwg % NXCD, xcd = wgid % NXCD, off = wgid / NXCD; wgid = (xcd < r ? xcd * (q + 1) : r * (q + 1) + (xcd - r) * q) + off; }
        const int nig = WGM * nN, gid = wgid / nig, fm = gid * WGM, gsz = (nM - fm) < WGM ? (nM - fm) : WGM;
        u.pm = fm + ((wgid % nig) % gsz); u.pn = (wgid % nig) / gsz; return true;
    }
    __device__ __forceinline__ void a_ready(const Unit&) const {}
    __device__ __forceinline__ void done(const Unit&) const {}
};

__device__ __forceinline__ unsigned cvt_pk_bf16(float lo, float hi) { unsigned r; asm volatile("v_cvt_pk_bf16_f32 %0, %1, %2" : "=v"(r) : "v"(lo), "v"(hi)); return r; }
typedef float f32x2 __attribute__((ext_vector_type(2)));
__device__ __forceinline__ f32x2 gelu_pk(f32x2 v) {
    const f32x2 av = __builtin_elementwise_abs(v), d = av * 0.2316418882f + 1.0f;
    f32x2 t; t.x = __builtin_amdgcn_rcpf(d.x); t.y = __builtin_amdgcn_rcpf(d.y);
    f32x2 q = t * 0.5307027145f + (-0.7265760135f); q = q * t + 0.7107068705f; q = q * t + (-0.142248368f); q = q * t + 0.127414796f; q = q * t;
    const f32x2 s = (v * v) * (-0.72134752044f);
    f32x2 e; e.x = __builtin_amdgcn_exp2f(s.x); e.y = __builtin_amdgcn_exp2f(s.y);
    const f32x2 m = v * (q * e), r = v - m;
    f32x2 o; o.x = v.x < 0.f ? m.x : r.x; o.y = v.y < 0.f ? m.y : r.y; return o;
}

struct EpiProj {
    static constexpr bool PERM = true, AFTER_DRAIN = false;
    bf16_t* O; int ldc; int gelu_tiles; int sc_lo, sc_hi; float sc;
    __device__ __forceinline__ void operator()(const f32x4 (&acc)[2][2][4][2], const Unit& u, int wr, int wc, int fr, int fq) const {
        const int row0 = u.pm * BM + wr * 64 + fr, col0 = u.pn * BM + wc * 32 + 8 * fq;
        const bool g = u.pn < gelu_tiles; const float s = (u.pn >= sc_lo && u.pn < sc_hi) ? sc : 1.f;
#pragma unroll
        for (int ai = 0; ai < 2; ++ai)
#pragma unroll
            for (int m = 0; m < 4; ++m) { bf16_t* rowp = O + (size_t)(row0 + ai * HALF + m * 16) * ldc + col0;
#pragma unroll
                for (int bj = 0; bj < 2; ++bj) { f32x4 v0 = acc[ai][bj][m][0], v1 = acc[ai][bj][m][1];
                    if (g) { f32x2 a = gelu_pk((f32x2){v0[0], v0[1]}), b = gelu_pk((f32x2){v0[2], v0[3]}), c = gelu_pk((f32x2){v1[0], v1[1]}), d = gelu_pk((f32x2){v1[2], v1[3]});
                        v0 = (f32x4){a.x, a.y, b.x, b.y}; v1 = (f32x4){c.x, c.y, d.x, d.y}; }
                    v0 = v0 * s; v1 = v1 * s; u32x4 w; w.x = cvt_pk_bf16(v0[0], v0[1]); w.y = cvt_pk_bf16(v0[2], v0[3]); w.z = cvt_pk_bf16(v1[0], v1[1]); w.w = cvt_pk_bf16(v1[2], v1[3]);
                    *(u32x4*)(rowp + bj * HALF) = w; } }
    }
};
template <bool BASE_BF16> struct EpiRes {
    static constexpr bool PERM = true, AFTER_DRAIN = false;
    const void* base; bf16_t* out; int ldc; const float* gacc; float* ssp;
    __device__ __forceinline__ void operator()(const f32x4 (&acc)[2][2][4][2], const Unit& u, int wr, int wc, int fr, int fq) const {
        const int row0 = u.pm * BM + wr * 64 + fr, col0 = u.pn * BM + wc * 32 + 8 * fq;
        const int b = u.pm >> 3;
        f32x4 gv[2][2];
#pragma unroll
        for (int bj = 0; bj < 2; ++bj)
#pragma unroll
            for (int n = 0; n < 2; ++n) gv[bj][n] = *(const f32x4*)(gacc + (size_t)b * 12288 + col0 + bj * HALF + n * 4);
#pragma unroll
        for (int ai = 0; ai < 2; ++ai)
#pragma unroll
            for (int m = 0; m < 4; ++m) { const int r = row0 + ai * HALF + m * 16; const size_t off = (size_t)r * ldc + col0; float ss = 0.f;
#pragma unroll
                for (int bj = 0; bj < 2; ++bj) { f32x4 b0, b1;
                    if (BASE_BF16) { const u32x4 raw = *(const u32x4*)((const bf16_t*)base + off + bj * HALF);
                        b0 = (f32x4){__uint_as_float(raw.x << 16), __uint_as_float(raw.x & 0xffff0000u), __uint_as_float(raw.y << 16), __uint_as_float(raw.y & 0xffff0000u)};
                        b1 = (f32x4){__uint_as_float(raw.z << 16), __uint_as_float(raw.z & 0xffff0000u), __uint_as_float(raw.w << 16), __uint_as_float(raw.w & 0xffff0000u)}; }
                    else { b0 = *(const f32x4*)((const float*)base + off + bj * HALF); b1 = *(const f32x4*)((const float*)base + off + bj * HALF + 4); }
                    const f32x4 o0 = b0 + gv[bj][0] * acc[ai][bj][m][0], o1 = b1 + gv[bj][1] * acc[ai][bj][m][1];
                    ss += ((o0[0] * o0[0] + o0[1] * o0[1]) + (o0[2] * o0[2] + o0[3] * o0[3])) + ((o1[0] * o1[0] + o1[1] * o1[1]) + (o1[2] * o1[2] + o1[3] * o1[3]));
                    u32x4 w; w.x = cvt_pk_bf16(o0[0], o0[1]); w.y = cvt_pk_bf16(o0[2], o0[3]); w.z = cvt_pk_bf16(o1[0], o1[1]); w.w = cvt_pk_bf16(o1[2], o1[3]);
                    *(u32x4*)(out + off + bj * HALF) = w; }
                ss += __shfl_xor(ss, 16); ss += __shfl_xor(ss, 32);
                if (fq == 0) ssp[(size_t)r * 32 + u.pn * 4 + wc] = ss;
                if (m & 1) asm volatile("" ::: "memory"); }
    }
};
struct EpiGU {
    static constexpr bool PERM = true, AFTER_DRAIN = false;
    bf16_t* O; int ldc;
    __device__ __forceinline__ void operator()(const f32x4 (&acc)[2][2][4][2], const Unit& u, int wr, int wc, int fr, int fq) const {
        const int row0 = u.pm * BM + wr * 64 + fr, col0 = u.pn * HALF + wc * 32 + 8 * fq;
#pragma unroll
        for (int ai = 0; ai < 2; ++ai)
#pragma unroll
            for (int m = 0; m < 4; ++m) { bf16_t* rowp = O + (size_t)(row0 + ai * HALF + m * 16) * ldc + col0; float v[8];
#pragma unroll
                for (int n = 0; n < 2; ++n)
#pragma unroll
                    for (int j = 0; j < 4; ++j) { const float g = acc[ai][0][m][n][j], up = acc[ai][1][m][n][j];
                        const float e = __builtin_amdgcn_exp2f(g * (-1.44269504089f)); v[n * 4 + j] = g * __builtin_amdgcn_rcpf(1.0f + e) * up; }
                u32x4 w; w.x = cvt_pk_bf16(v[0], v[1]); w.y = cvt_pk_bf16(v[2], v[3]); w.z = cvt_pk_bf16(v[4], v[5]); w.w = cvt_pk_bf16(v[6], v[7]);
                *(u32x4*)rowp = w; }
    }
};
template <class Epi, class Sched, bool ALIGN_EPI = false, bool SP2 = false>
__device__ __forceinline__ void gemm_phase(PG8_LAS unsigned char* lds, const Gemm g, const Sched& S, const Epi& E) {
    const int tid = fresh_tid(), wid = __builtin_amdgcn_readfirstlane(tid >> 6), lane = tid & 63, wr = wid >> 2, wc = wid & 3, fr = lane & 15, fq = lane >> 4;
    const int K = g.K, nt = K / BK;
    unsigned voffA[2], voffB[2];
#pragma unroll
    for (int i = 0; i < 2; ++i) { int R, C; stage_rc(tid * 16 + i * 8192, R, C); const int Rb = Epi::PERM ? ((R & ~31) + perm32(R & 31)) : R;
        voffA[i] = (unsigned)(R * K + C) * 2u; voffB[i] = (unsigned)(Rb * K + C) * 2u; }
    const size_t kstep = (size_t)(BK * 2);
    const size_t hstep = (size_t)HALF * K * 2;
    const size_t tstep = 2 * hstep;
    const unsigned ldsw = (unsigned)wid * 1024u;
    const int aoff = lds_byte(wr * 64 + fr, fq * 8), boff = lds_byte(wc * 32 + fr, fq * 8);
#define PG8_SA(b, h) (((b) * 2 + (h)) * HTB)
#define PG8_SB(b, h) ((4 + (b) * 2 + (h)) * HTB)
#define PG8_STAGE(bufoff, gbase, voff) do { _Pragma("unroll") for (int _i = 0; _i < 2; ++_i) \
        __builtin_amdgcn_global_load_lds((const unsigned*)((const char*)(gbase) + (voff)[_i]), (PG8_LAS unsigned*)(lds + (bufoff) + ldsw + _i * 8192), 16, 0, 0); } while (0)
#define PG8_LDA(dst, b, h) do { _Pragma("unroll") for (int m = 0; m < 4; ++m) _Pragma("unroll") for (int k = 0; k < 2; ++k) dst[m][k] = *(const PG8_LAS bf16x8*)(lds + PG8_SA(b, h) + aoff + m * 2048 + k * 1024); } while (0)
#define PG8_LDB(dst, b, h) do { _Pragma("unroll") for (int n = 0; n < 2; ++n) _Pragma("unroll") for (int k = 0; k < 2; ++k) dst[n][k] = *(const PG8_LAS bf16x8*)(lds + PG8_SB(b, h) + boff + n * 2048 + k * 1024); } while (0)
#define PG8_MMA(ai, bj, At, Bt) do { __builtin_amdgcn_s_setprio(1); _Pragma("unroll") for (int m = 0; m < 4; ++m) _Pragma("unroll") for (int n = 0; n < 2; ++n) _Pragma("unroll") for (int k = 0; k < 2; ++k) \
        acc[ai][bj][m][n] = __builtin_amdgcn_mfma_f32_16x16x32_bf16(Bt[n][k], At[m][k], acc[ai][bj][m][n], 0, 0, 0); __builtin_amdgcn_s_setprio(0); } while (0)
#define PG8_WAIT_V(n) asm volatile("s_waitcnt vmcnt(" #n ")" ::: "memory")
#define PG8_WAIT_L(n) asm volatile("s_waitcnt lgkmcnt(" #n ")" ::: "memory")
#define PG8_BAR __builtin_amdgcn_s_barrier()
#define PG8_SCHED __builtin_amdgcn_sched_barrier(0)
    Unit cur, nxt; int ui = 0;
    if (!S.next(0, cur)) return;
    f32x4 acc[2][2][4][2];
#pragma unroll
    for (int a = 0; a < 2; ++a)
#pragma unroll
        for (int b = 0; b < 2; ++b)
#pragma unroll
            for (int m = 0; m < 4; ++m)
#pragma unroll
                for (int n = 0; n < 2; ++n) acc[a][b][m][n] = (f32x4){0.f, 0.f, 0.f, 0.f};
    bf16x8 At[4][2], B0[2][2], B1[2][2];
    const char* cA = (const char*)g.A + (size_t)cur.pm * tstep; const char* cB = (const char*)g.Bt + (size_t)cur.pn * tstep;
    S.a_ready(cur);
    if constexpr (SP2) {
        PG8_STAGE(PG8_SB(0, 0), cB, voffB); PG8_STAGE(PG8_SB(0, 1), cB + hstep, voffB); PG8_STAGE(PG8_SA(0, 0), cA, voffA); PG8_STAGE(PG8_SA(0, 1), cA + hstep, voffA);
        if (wr == 1) PG8_BAR;
        PG8_WAIT_V(2); PG8_BAR;
        PG8_STAGE(PG8_SB(1, 0), cB + kstep, voffB); PG8_STAGE(PG8_SA(1, 0), cA + kstep, voffA); PG8_STAGE(PG8_SB(1, 1), cB + hstep + kstep, voffB);
        PG8_WAIT_V(6); PG8_BAR;
    } else {
        PG8_STAGE(PG8_SB(0, 0), cB, voffB); PG8_STAGE(PG8_SA(0, 0), cA, voffA); PG8_STAGE(PG8_SB(0, 1), cB + hstep, voffB); PG8_STAGE(PG8_SA(0, 1), cA + hstep, voffA);
        if (wr == 1) PG8_BAR;
        PG8_WAIT_V(4); PG8_BAR;
        PG8_STAGE(PG8_SB(1, 0), cB + kstep, voffB); PG8_STAGE(PG8_SA(1, 0), cA + kstep, voffA); PG8_STAGE(PG8_SB(1, 1), cB + hstep + kstep, voffB);
        PG8_WAIT_V(6); PG8_BAR;
    }
    for (;;) {
        const bool has_next = S.next(ui + 1, nxt);
        const char* nA = has_next ? (const char*)g.A + (size_t)nxt.pm * tstep : cA; const char* nB = has_next ? (const char*)g.Bt + (size_t)nxt.pn * tstep : cB;
        for (int t = 0; t < nt; t += 2) {
            const bool last = (t == nt - 2);
            const char* a1 = cA + (size_t)(t + 1) * kstep;
            const char* a2 = last ? nA : cA + (size_t)(t + 2) * kstep; const char* b2 = last ? nB : cB + (size_t)(t + 2) * kstep;
            const char* a3 = a2 + kstep; const char* b3 = b2 + kstep;
            if (last && has_next) S.a_ready(nxt);
            if constexpr (SP2) {
            PG8_LDB(B0, 0, 0); PG8_LDB(B1, 0, 1); PG8_SCHED; PG8_LDA(At, 0, 0); PG8_STAGE(PG8_SA(1, 1), a1 + hstep, voffA);
            PG8_WAIT_V(8); PG8_WAIT_L(0); PG8_BAR; PG8_MMA(0, 0, At, B0); PG8_MMA(0, 1, At, B1); PG8_BAR; PG8_SCHED;
            PG8_LDA(At, 0, 1); PG8_STAGE(PG8_SB(0, 0), b2, voffB); PG8_STAGE(PG8_SB(0, 1), b2 + hstep, voffB); PG8_STAGE(PG8_SA(0, 0), a2, voffA);
            PG8_WAIT_V(8); PG8_WAIT_L(0); PG8_BAR; PG8_MMA(1, 0, At, B0); PG8_MMA(1, 1, At, B1); PG8_BAR; PG8_SCHED;
            PG8_LDB(B0, 1, 0); PG8_LDB(B1, 1, 1); PG8_SCHED; PG8_LDA(At, 1, 0); PG8_STAGE(PG8_SA(0, 1), a2 + hstep, voffA);
            PG8_WAIT_V(8); PG8_WAIT_L(0); PG8_BAR; PG8_MMA(0, 0, At, B0); PG8_MMA(0, 1, At, B1); PG8_BAR; PG8_SCHED;
            PG8_LDA(At, 1, 1); PG8_STAGE(PG8_SB(1, 0), b3, voffB); PG8_STAGE(PG8_SB(1, 1), b3 + hstep, voffB); PG8_STAGE(PG8_SA(1, 0), a3, voffA);
            PG8_WAIT_V(8); PG8_WAIT_L(0); PG8_BAR; PG8_MMA(1, 0, At, B0); PG8_MMA(1, 1, At, B1); PG8_BAR; PG8_SCHED;
            } else {
            PG8_LDB(B0, 0, 0); PG8_SCHED; PG8_LDA(At, 0, 0); PG8_STAGE(PG8_SA(1, 1), a1 + hstep, voffA);
            PG8_WAIT_L(8); PG8_BAR; PG8_WAIT_L(0); PG8_MMA(0, 0, At, B0); PG8_BAR; PG8_SCHED;
            PG8_LDB(B1, 0, 1); PG8_STAGE(PG8_SB(0, 0), b2, voffB);
            PG8_BAR; PG8_WAIT_L(0); PG8_MMA(0, 1, At, B1); PG8_BAR;
            PG8_LDA(At, 0, 1); PG8_STAGE(PG8_SA(0, 0), a2, voffA);
            PG8_BAR; PG8_WAIT_L(0); PG8_MMA(1, 0, At, B0); PG8_BAR; PG8_SCHED;
            PG8_STAGE(PG8_SB(0, 1), b2 + hstep, voffB);
            PG8_WAIT_V(6); PG8_BAR; PG8_MMA(1, 1, At, B1); PG8_BAR;
            PG8_LDB(B0, 1, 0); PG8_SCHED; PG8_LDA(At, 1, 0); PG8_STAGE(PG8_SA(0, 1), a2 + hstep, voffA);
            PG8_WAIT_L(8); PG8_BAR; PG8_WAIT_L(0); PG8_MMA(0, 0, At, B0); PG8_BAR; PG8_SCHED;
            PG8_LDB(B1, 1, 1); PG8_STAGE(PG8_SB(1, 0), b3, voffB);
            PG8_BAR; PG8_WAIT_L(0); PG8_MMA(0, 1, At, B1); PG8_BAR;
            PG8_LDA(At, 1, 1); PG8_STAGE(PG8_SA(1, 0), a3, voffA);
            PG8_BAR; PG8_WAIT_L(0); PG8_MMA(1, 0, At, B0); PG8_BAR; PG8_SCHED;
            PG8_STAGE(PG8_SB(1, 1), b3 + hstep, voffB);
            PG8_WAIT_V(6); PG8_BAR; PG8_MMA(1, 1, At, B1); PG8_BAR;
            }
        }
        if constexpr (ALIGN_EPI) { if (wr == 0) PG8_BAR; }
        if constexpr (!Epi::AFTER_DRAIN) { E(acc, cur, wr, wc, fr, fq); S.done(cur); }
        if (!has_next) break;
#pragma unroll
        for (int a = 0; a < 2; ++a)
#pragma unroll
            for (int b = 0; b < 2; ++b)
#pragma unroll
                for (int m = 0; m < 4; ++m)
#pragma unroll
                    for (int n = 0; n < 2; ++n) acc[a][b][m][n] = (f32x4){0.f, 0.f, 0.f, 0.f};
        cur = nxt; cA = nA; cB = nB; ++ui;
        if constexpr (ALIGN_EPI) { if (wr == 1) PG8_BAR; }
    }
    PG8_WAIT_V(0);
    if constexpr (!ALIGN_EPI) { if (wr == 0) PG8_BAR; }
    PG8_BAR;
    if constexpr (Epi::AFTER_DRAIN) { E.fused(acc, cur, wr, wc, fr, fq, lds, wid, lane); S.done(cur); }
#undef PG8_SA
#undef PG8_SB
#undef PG8_STAGE
#undef PG8_LDA
#undef PG8_LDB
#undef PG8_MMA
#undef PG8_WAIT_V
#undef PG8_WAIT_L
#undef PG8_BAR
#undef PG8_SCHED
}
}

constexpr int NB = 8, SEQ = 2048, DM = 2048, T = NB * SEQ;
constexpr int DFF = 5632, NIN = 5120, NMOD = 6 * DM;
constexpr int NPROJ = 4096;
constexpr float EPS = 1e-6f;
constexpr int NTHREADS = 512, NWAVES = 8;
constexpr int LDS_BYTES = 147456;
constexpr float QSCALE = 0.08838834764831845f * 1.4426950408889634f;

constexpr size_t MiB = 1u << 20;
constexpr size_t WS_BAR = 0;
constexpr size_t WS_MOD = 512 * 1024;
constexpr size_t WS_SS1 = 1 * MiB;
constexpr size_t WS_SS2 = 3 * MiB;
constexpr size_t WS_WIN = 6 * MiB;
constexpr size_t WS_WOUT = 26 * MiB;
constexpr size_t WS_WGU = 34 * MiB;
constexpr size_t WS_WDN = 78 * MiB;
constexpr size_t WS_H = 100 * MiB;
constexpr size_t WS_PROJ = 164 * MiB;
constexpr size_t WS_VT = 292 * MiB;
constexpr size_t WS_O = 324 * MiB;
constexpr size_t WS_GU = 164 * MiB;
constexpr size_t WS_X1 = 388 * MiB;
constexpr size_t WS_END = 452 * MiB;
static_assert(WS_GU + (size_t)T * DFF * 2 <= WS_END, "ws map");

#define LAS __attribute__((address_space(3)))
typedef unsigned short bf16;
typedef unsigned v4u __attribute__((ext_vector_type(4)));
typedef unsigned v2u __attribute__((ext_vector_type(2)));
typedef float f32x4 __attribute__((ext_vector_type(4)));
typedef short bf16x8 __attribute__((ext_vector_type(8)));
typedef short bf16x4 __attribute__((ext_vector_type(4)));

__device__ __forceinline__ unsigned pk2(float lo, float hi) { return pg8::cvt_pk_bf16(lo, hi); }
__device__ __forceinline__ float bflo(unsigned w) { return __uint_as_float(w << 16); }
__device__ __forceinline__ float bfhi(unsigned w) { return __uint_as_float(w & 0xffff0000u); }
__device__ __forceinline__ float wave_sum(float v) {
#pragma unroll
    for (int o = 1; o < 64; o <<= 1) v += __shfl_xor(v, o);
    return v;
}

struct Params {
    const float *x, *c, *w_ada, *b_ada, *norm1_g, *w_in, *v_norm_g, *w_spatial, *b_spatial, *out_norm_g, *w_out, *norm2_g, *w_gate, *w_up, *w_down, *final_g;
    float* out; unsigned char* ws;
};

constexpr int TSCR = 16640;
__device__ __forceinline__ void transpose_item(const float* W, int K, int N, bf16* WT, int k0, int n0, int drow0, LAS float* scr, int lane) {
    const int lr = lane >> 4, lc = (lane & 15) * 4;
    const float* src = W + (size_t)(k0 + lr) * N + n0 + lc;
#pragma unroll 8
    for (int i = 0; i < 16; ++i) { const f32x4 v = *(const f32x4*)(src + (size_t)(4 * i) * N); LAS float* d = scr + (4 * i + lr) * 65 + lc; d[0] = v[0]; d[1] = v[1]; d[2] = v[2]; d[3] = v[3]; }
    asm volatile("s_waitcnt lgkmcnt(0)" ::: "memory");
    const int c = lane & 7;
#pragma unroll
    for (int j = 0; j < 8; ++j) { const int n = (lane >> 3) + 8 * j; const LAS float* q = scr + (8 * c) * 65 + n;
        v4u o; o.x = pk2(q[0 * 65], q[1 * 65]); o.y = pk2(q[2 * 65], q[3 * 65]); o.z = pk2(q[4 * 65], q[5 * 65]); o.w = pk2(q[6 * 65], q[7 * 65]);
        *(v4u*)(WT + (size_t)(drow0 + n) * K + k0 + 8 * c) = o; }
    asm volatile("s_waitcnt lgkmcnt(0)" ::: "memory");
}

__device__ __forceinline__ void phase_prep(const Params& p, LAS unsigned char* lds, int vcu, int G) {
    const int tid = fresh_tid(), lane = tid & 63, wave = __builtin_amdgcn_readfirstlane(tid >> 6);
    LAS float* scr = (LAS float*)(lds + wave * TSCR);
    const int gw = vcu * NWAVES + wave, NGW = G * NWAVES;
    unsigned char* ws = p.ws;
    bf16* Win = (bf16*)(ws + WS_WIN); bf16* Wout = (bf16*)(ws + WS_WOUT); bf16* Wgu = (bf16*)(ws + WS_WGU); bf16* Wdn = (bf16*)(ws + WS_WDN);
    for (int cb = vcu; cb < NMOD / 64; cb += G) {
        float* mod = (float*)(ws + WS_MOD);
        const int kbase = 256 * wave, col = cb * 64 + lane;
#pragma unroll
        for (int b = 0; b < 8; ++b) { f32x4 cv = *(const f32x4*)(p.c + b * DM + kbase + lane * 4);
#pragma unroll
            for (int j = 0; j < 4; ++j) cv[j] = cv[j] / (1.0f + __expf(-cv[j]));
            *(LAS f32x4*)(scr + b * 256 + lane * 4) = cv; }
        asm volatile("s_waitcnt lgkmcnt(0)" ::: "memory");
        float a[8];
#pragma unroll
        for (int b = 0; b < 8; ++b) a[b] = 0.f;
        const float* wp = p.w_ada + (size_t)kbase * NMOD + col;
#pragma unroll 4
        for (int k4 = 0; k4 < 64; ++k4) {
            float wv[4];
#pragma unroll
            for (int i = 0; i < 4; ++i) wv[i] = wp[(size_t)(4 * k4 + i) * NMOD];
#pragma unroll
            for (int b = 0; b < 8; ++b) { const f32x4 sv = *(const LAS f32x4*)(scr + b * 256 + 4 * k4); a[b] += (wv[0] * sv[0] + wv[1] * sv[1]) + (wv[2] * sv[2] + wv[3] * sv[3]); }
        }
        __syncthreads();
        LAS float* red = (LAS float*)lds;
#pragma unroll
        for (int b = 0; b < 8; ++b) red[(wave * 8 + b) * 64 + lane] = a[b];
        __syncthreads();
        { const int b = tid >> 6; float sacc = p.b_ada[col];
#pragma unroll
          for (int w2 = 0; w2 < 8; ++w2) sacc += red[(w2 * 8 + b) * 64 + lane];
          mod[(size_t)b * NMOD + col] = sacc; }
        __syncthreads();
    }
    constexpr int I_IN = (DM / 64) * (NIN / 64), I_OUT = (DM / 64) * (DM / 64), I_G = (DM / 64) * (DFF / 64), I_D = (DFF / 64) * (DM / 64);
    constexpr int NITEMS = I_IN + I_OUT + 2 * I_G + I_D;
    for (int it = gw; it < NITEMS; it += NGW) {
        int r = it;
        if (r < I_IN) { const int nb = NIN / 64, kb = r / nb, n0 = (r % nb) * 64; transpose_item(p.w_in, DM, NIN, Win, kb * 64, n0, n0, scr, lane); continue; } r -= I_IN;
        if (r < I_OUT) { const int nb = DM / 64, kb = r / nb, n0 = (r % nb) * 64; transpose_item(p.w_out, DM, DM, Wout, kb * 64, n0, n0, scr, lane); continue; } r -= I_OUT;
        if (r < I_G) { const int nb = DFF / 64, kb = r / nb, n0 = (r % nb) * 64; transpose_item(p.w_gate, DM, DFF, Wgu, kb * 64, n0, (n0 >> 7) * 256 + (n0 & 127), scr, lane); continue; } r -= I_G;
        if (r < I_G) { const int nb = DFF / 64, kb = r / nb, n0 = (r % nb) * 64; transpose_item(p.w_up, DM, DFF, Wgu, kb * 64, n0, (n0 >> 7) * 256 + 128 + (n0 & 127), scr, lane); continue; } r -= I_G;
        { const int nb = DM / 64, kb = r / nb, n0 = (r % nb) * 64; transpose_item(p.w_down, DFF, DM, Wdn, kb * 64, n0, n0, scr, lane); }
    }
}

template <int MODE>
__device__ __forceinline__ void phase_norm_mod(const Params& p, const void* srcv, const float* ssp, const float* ng, int shift_chunk, bf16* dst, int vcu, int G) {
    const int tid = fresh_tid(), lane = tid & 63, wave = __builtin_amdgcn_readfirstlane(tid >> 6);
    const int gw = vcu * NWAVES + wave, NGW = G * NWAVES;
    const float* mod = (const float*)(p.ws + WS_MOD);
    for (int rb = gw; rb < T / 8; rb += NGW) {
        const int b = (rb * 8) / SEQ;
        f32x4 A[8], B[8];
#pragma unroll
        for (int j = 0; j < 8; ++j) { const int cidx = lane * 4 + 256 * j;
            const f32x4 g = *(const f32x4*)(ng + cidx);
            const f32x4 sh = *(const f32x4*)(mod + (size_t)b * NMOD + shift_chunk * DM + cidx);
            const f32x4 sc = *(const f32x4*)(mod + (size_t)b * NMOD + (shift_chunk + 1) * DM + cidx);
            A[j] = g * (sc + 1.0f); B[j] = sh; }
        for (int rr = 0; rr < 8; ++rr) {
            const int row = rb * 8 + rr;
            f32x4 v[8]; float s = 0.f;
            if (MODE == 0) { const f32x4* xr = (const f32x4*)((const float*)srcv + (size_t)row * DM) + lane;
#pragma unroll
                for (int j = 0; j < 8; ++j) { v[j] = xr[64 * j]; s += (v[j][0] * v[j][0] + v[j][1] * v[j][1]) + (v[j][2] * v[j][2] + v[j][3] * v[j][3]); } }
            else { const v2u* xr = (const v2u*)((const bf16*)srcv + (size_t)row * DM) + lane;
#pragma unroll
                for (int j = 0; j < 8; ++j) { const v2u raw = xr[64 * j]; v[j] = (f32x4){bflo(raw.x), bfhi(raw.x), bflo(raw.y), bfhi(raw.y)}; } }
            float tot;
            if (MODE == 0) tot = wave_sum(s);
            else { float q = (lane < 32) ? ssp[(size_t)row * 32 + lane] : 0.f; tot = wave_sum(q); }
            const float rstd = 1.0f / sqrtf(tot * (1.0f / DM) + EPS);
            v2u* o8 = (v2u*)(dst + (size_t)row * DM) + lane;
#pragma unroll
            for (int j = 0; j < 8; ++j) { const f32x4 h = (v[j] * rstd) * A[j] + B[j]; v2u w; w.x = pk2(h[0], h[1]); w.y = pk2(h[2], h[3]); o8[64 * j] = w; }
        }
    }
}

__device__ __forceinline__ void phase_final(const Params& p, const float* ssp, int vcu, int G) {
    const int tid = fresh_tid(), lane = tid & 63, wave = __builtin_amdgcn_readfirstlane(tid >> 6);
    const int gw = vcu * NWAVES + wave, NGW = G * NWAVES;
    f32x4 g[8];
#pragma unroll
    for (int j = 0; j < 8; ++j) g[j] = *(const f32x4*)(p.final_g + lane * 4 + 256 * j);
    for (int row = gw; row < T; row += NGW) {
        f32x4* xr = (f32x4*)(p.out + (size_t)row * DM) + lane;
        const v2u* xs = (const v2u*)((const bf16*)(p.ws + WS_X1) + (size_t)row * DM) + lane;
        f32x4 v[8];
#pragma unroll
        for (int j = 0; j < 8; ++j) { const v2u raw = xs[64 * j]; v[j] = (f32x4){bflo(raw.x), bfhi(raw.x), bflo(raw.y), bfhi(raw.y)}; }
        float q = (lane < 32) ? ssp[(size_t)row * 32 + lane] : 0.f; const float tot = wave_sum(q);
        const float rstd = 1.0f / sqrtf(tot * (1.0f / DM) + EPS);
#pragma unroll
        for (int j = 0; j < 8; ++j) xr[64 * j] = (v[j] * rstd) * g[j];
    }
}

constexpr int TP = 136;
__device__ __forceinline__ void gmlp_tile(const Params& p, LAS unsigned char* lds, int b, int n, int g) {
    const int tid = fresh_tid(), lane = tid & 63, w = __builtin_amdgcn_readfirstlane(tid >> 6), r = lane & 15, cgp = lane >> 4;
    const bf16* PROJ = (const bf16*)(p.ws + WS_PROJ); bf16* O = (bf16*)(p.ws + WS_O);
    LAS bf16* Vt = (LAS bf16*)lds;
    const int tok0 = b * SEQ + n * 128;
    {
        const int s = 16 * w + r;
        const bf16* src = PROJ + (size_t)(tok0 + s) * NPROJ + 1024 + g * 128;
        float xv[4][8]; float s1 = 0.f;
#pragma unroll
        for (int pp = 0; pp < 4; ++pp) { const v4u raw = *(const v4u*)(src + (cgp * 4 + pp) * 8);
            xv[pp][0] = bflo(raw.x); xv[pp][1] = bfhi(raw.x); xv[pp][2] = bflo(raw.y); xv[pp][3] = bfhi(raw.y); xv[pp][4] = bflo(raw.z); xv[pp][5] = bfhi(raw.z); xv[pp][6] = bflo(raw.w); xv[pp][7] = bfhi(raw.w);
#pragma unroll
            for (int j = 0; j < 8; ++j) s1 += xv[pp][j]; }
        s1 += __shfl_xor(s1, 16); s1 += __shfl_xor(s1, 32);
        const float mean = s1 * (1.0f / 128.0f); float s2 = 0.f;
#pragma unroll
        for (int pp = 0; pp < 4; ++pp)
#pragma unroll
            for (int j = 0; j < 8; ++j) { xv[pp][j] -= mean; s2 += xv[pp][j] * xv[pp][j]; }
        s2 += __shfl_xor(s2, 16); s2 += __shfl_xor(s2, 32);
        const float rstd = 1.0f / sqrtf(s2 * (1.0f / 128.0f) + EPS);
#pragma unroll
        for (int pp = 0; pp < 4; ++pp) { const int d0 = (cgp * 4 + pp) * 8;
            const f32x4 g0 = *(const f32x4*)(p.v_norm_g + g * 128 + d0), g1 = *(const f32x4*)(p.v_norm_g + g * 128 + d0 + 4);
#pragma unroll
            for (int j = 0; j < 8; ++j) { const float y = xv[pp][j] * rstd * (j < 4 ? g0[j & 3] : g1[j & 3]); Vt[(d0 + j) * TP + s] = (bf16)(pk2(y, 0.f) & 0xffffu); } }
    }
    __syncthreads();
    f32x4 acc[8];
#pragma unroll
    for (int nd = 0; nd < 8; ++nd) acc[nd] = (f32x4){0.f, 0.f, 0.f, 0.f};
    const int t = 16 * w + r;
    const float* wrow = p.w_spatial + (size_t)(g * 128 + t) * 128;
    for (int kk = 0; kk <= (w >> 1); ++kk) {
        const int s0 = kk * 32 + cgp * 8;
        const f32x4 w0 = *(const f32x4*)(wrow + s0), w1 = *(const f32x4*)(wrow + s0 + 4);
        float wv[8] = {w0[0], w0[1], w0[2], w0[3], w1[0], w1[1], w1[2], w1[3]};
#pragma unroll
        for (int j = 0; j < 8; ++j) wv[j] = (s0 + j <= t) ? wv[j] : 0.f;
        v4u wp; wp.x = pk2(wv[0], wv[1]); wp.y = pk2(wv[2], wv[3]); wp.z = pk2(wv[4], wv[5]); wp.w = pk2(wv[6], wv[7]);
        const bf16x8 wf = __builtin_bit_cast(bf16x8, wp);
#pragma unroll
        for (int nd = 0; nd < 8; ++nd) { const bf16x8 vf = *(const LAS bf16x8*)(Vt + (nd * 16 + r) * TP + s0);
            acc[nd] = __builtin_amdgcn_mfma_f32_16x16x32_bf16(vf, wf, acc[nd], 0, 0, 0); }
    }
    const float bsv = p.b_spatial[g * 128 + t];
    const bf16* urow = PROJ + (size_t)(tok0 + t) * NPROJ + g * 128 + cgp * 4;
    float ss = 0.f;
#pragma unroll
    for (int nd = 0; nd < 8; ++nd) { const v2u uw = *(const v2u*)(urow + nd * 16);
        f32x4 o; o[0] = bflo(uw.x) * (acc[nd][0] + bsv); o[1] = bfhi(uw.x) * (acc[nd][1] + bsv); o[2] = bflo(uw.y) * (acc[nd][2] + bsv); o[3] = bfhi(uw.y) * (acc[nd][3] + bsv);
        acc[nd] = o; ss += (o[0] * o[0] + o[1] * o[1]) + (o[2] * o[2] + o[3] * o[3]); }
    ss += __shfl_xor(ss, 16); ss += __shfl_xor(ss, 32);
    const float rs = 1.0f / sqrtf(ss * (1.0f / 128.0f) + EPS);
    bf16* orow = O + (size_t)(tok0 + t) * DM + g * 128 + cgp * 4;
#pragma unroll
    for (int nd = 0; nd < 8; ++nd) { const f32x4 og = *(const f32x4*)(p.out_norm_g + g * 128 + nd * 16 + cgp * 4);
        v2u wv2; wv2.x = pk2(acc[nd][0] * rs * og[0], acc[nd][1] * rs * og[1]); wv2.y = pk2(acc[nd][2] * rs * og[2], acc[nd][3] * rs * og[3]);
        *(v2u*)(orow + nd * 16) = wv2; }
    __syncthreads();
}

typedef float f32x16 __attribute__((ext_vector_type(16)));
constexpr int TPK = 136, TPV = 132;
template <bool DIAG>
__device__ __forceinline__ void sb_tile(f32x16& z, float& run, int r, int hi) {
    float be[16], om[16];
#pragma unroll
    for (int i = 0; i < 16; ++i) { const float zc = fmaxf(z[i], -126.0f); const float e = __builtin_amdgcn_exp2f(-zc);
        be[i] = __builtin_amdgcn_rcpf(1.0f + e); om[i] = e * be[i];
        if (DIAG) { const bool valid = (8 * (i >> 2) + 4 * hi + (i & 3)) < r; be[i] = valid ? be[i] : 0.f; om[i] = valid ? om[i] : 1.0f; } }
    float P[4], xo[4], Tt[4];
#pragma unroll
    for (int g = 0; g < 4; ++g) P[g] = (om[4 * g] * om[4 * g + 1]) * (om[4 * g + 2] * om[4 * g + 3]);
#pragma unroll
    for (int g = 0; g < 4; ++g) { const unsigned u = __float_as_uint(P[g]); const auto sw = __builtin_amdgcn_permlane32_swap(u, u, false, false);
        xo[g] = __uint_as_float(sw[1]); Tt[g] = __uint_as_float(sw[0]) * __uint_as_float(sw[1]); }
#pragma unroll
    for (int g = 3; g >= 0; --g) {
        float tl = run * (hi ? 1.0f : xo[g]); run *= Tt[g];
        z[4 * g + 3] = be[4 * g + 3] * tl; tl *= om[4 * g + 3];
        z[4 * g + 2] = be[4 * g + 2] * tl; tl *= om[4 * g + 2];
        z[4 * g + 1] = be[4 * g + 1] * tl; tl *= om[4 * g + 1];
        z[4 * g + 0] = be[4 * g + 0] * tl;
    }
}
__device__ __forceinline__ void sb_unit(const Params& p, LAS unsigned char* lds, int b, int h, int qb) {
    const int tid = fresh_tid(), lane = tid & 63, w = __builtin_amdgcn_readfirstlane(tid >> 6), r = lane & 31, hi = lane >> 5;
    const bf16* PROJ = (const bf16*)(p.ws + WS_PROJ); const bf16* VT = (const bf16*)(p.ws + WS_VT); bf16* O = (bf16*)(p.ws + WS_O);
    LAS bf16* Ks = (LAS bf16*)lds;
    LAS bf16* Vs = (LAS bf16*)(lds + 2 * 128 * TPK * 2);
    const int tok0 = b * SEQ;
    const int qt = 8 * qb + w;
    bf16x8 qf[8];
    { const bf16* qrow = PROJ + (size_t)(tok0 + 32 * qt + r) * NPROJ + 2048 + h * 128 + 8 * hi;
#pragma unroll
      for (int st = 0; st < 8; ++st) qf[st] = *(const bf16x8*)(qrow + 16 * st);
#pragma unroll
      for (int st = 0; st < 8; ++st) asm volatile("" : "+v"(qf[st])); }
    const bf16* kbase = PROJ + (size_t)tok0 * NPROJ + 3072 + h * 128;
    const bf16* vbase = VT + (size_t)(h * 128) * T + tok0;
    v4u kr[4], vr[4];
#define SB_LOAD(jb) do { _Pragma("unroll") for (int pp = 0; pp < 4; ++pp) { const int c = tid + 512 * pp, rw = c >> 4, pc = c & 15; \
        kr[pp] = *(const v4u*)(kbase + (size_t)((jb) * 128 + rw) * NPROJ + pc * 8); vr[pp] = *(const v4u*)(vbase + (size_t)rw * T + (jb) * 128 + pc * 8); } } while (0)
#define SB_STORE(buf) do { _Pragma("unroll") for (int pp = 0; pp < 4; ++pp) { const int c = tid + 512 * pp, rw = c >> 4, pc = c & 15; \
        *(LAS v4u*)(Ks + ((buf) * 128 + rw) * TPK + pc * 8) = kr[pp]; \
        LAS v2u* vd = (LAS v2u*)(Vs + ((buf) * 128 + rw) * TPV + pc * 8); v2u lo2, hi2; lo2.x = vr[pp].x; lo2.y = vr[pp].y; hi2.x = vr[pp].z; hi2.y = vr[pp].w; vd[0] = lo2; vd[1] = hi2; } } while (0)
    f32x16 oacc[4];
#pragma unroll
    for (int dt = 0; dt < 4; ++dt)
#pragma unroll
        for (int i = 0; i < 16; ++i) oacc[dt][i] = 0.f;
    float run = 1.0f;
    const int jtop = 2 * qb + 1;
    SB_LOAD(jtop); SB_STORE(0);
    __syncthreads();
    for (int jb = jtop; jb >= 0; --jb) {
        const int cur = (jtop - jb) & 1;
        if (jb > 0) SB_LOAD(jb - 1);
#pragma unroll 1
        for (int c = 3; c >= 0; --c) {
            const int kt = 4 * jb + c;
            if (kt > qt) continue;
            const bool diag = (kt == qt);
            const LAS bf16* kp = Ks + (cur * 128 + 32 * c + r) * TPK + 8 * hi;
            bf16x8 kf[8];
#pragma unroll
            for (int st = 0; st < 8; ++st) kf[st] = *(const LAS bf16x8*)(kp + 16 * st);
            __builtin_amdgcn_sched_barrier(0);
            f32x16 z;
#pragma unroll
            for (int i = 0; i < 16; ++i) z[i] = 0.f;
#pragma unroll
            for (int st = 0; st < 8; ++st) z = __builtin_amdgcn_mfma_f32_32x32x16_bf16(kf[st], qf[st], z, 0, 0, 0);
            __builtin_amdgcn_sched_barrier(0);
            v2u vlo[2][4], vhh[2][4];
#pragma unroll
            for (int s2 = 0; s2 < 2; ++s2)
#pragma unroll
                for (int dt = 0; dt < 4; ++dt) { const LAS bf16* vp = Vs + (cur * 128 + 32 * dt + r) * TPV + 32 * c + 16 * s2 + 4 * hi;
                    vlo[s2][dt] = *(const LAS v2u*)vp; vhh[s2][dt] = *(const LAS v2u*)(vp + 8); }
            __builtin_amdgcn_sched_barrier(0);
            if (diag) sb_tile<true>(z, run, r, hi); else sb_tile<false>(z, run, r, hi);
            __builtin_amdgcn_sched_barrier(0);
#pragma unroll
            for (int s2 = 0; s2 < 2; ++s2) {
                v4u pw; pw.x = pk2(z[8 * s2 + 0], z[8 * s2 + 1]); pw.y = pk2(z[8 * s2 + 2], z[8 * s2 + 3]); pw.z = pk2(z[8 * s2 + 4], z[8 * s2 + 5]); pw.w = pk2(z[8 * s2 + 6], z[8 * s2 + 7]);
                const bf16x8 pf = __builtin_bit_cast(bf16x8, pw);
#pragma unroll
                for (int dt = 0; dt < 4; ++dt) { v4u vw; vw.x = vlo[s2][dt].x; vw.y = vlo[s2][dt].y; vw.z = vhh[s2][dt].x; vw.w = vhh[s2][dt].y;
                    oacc[dt] = __builtin_amdgcn_mfma_f32_32x32x16_bf16(__builtin_bit_cast(bf16x8, vw), pf, oacc[dt], 0, 0, 0); }
            }
        }
        if (jb > 0) SB_STORE(cur ^ 1);
        __syncthreads();
    }
#undef SB_LOAD
#undef SB_STORE
    float ss = 0.f;
#pragma unroll
    for (int dt = 0; dt < 4; ++dt)
#pragma unroll
        for (int i = 0; i < 16; ++i) ss += oacc[dt][i] * oacc[dt][i];
    ss += __shfl_xor(ss, 32);
    const float rs = 1.0f / sqrtf(ss * (1.0f / 128.0f) + EPS);
    bf16* orow = O + (size_t)(tok0 + 32 * qt + r) * DM + 1024 + h * 128 + 4 * hi;
    const float* ogp = p.out_norm_g + 1024 + h * 128 + 4 * hi;
#pragma unroll
    for (int dt = 0; dt < 4; ++dt)
#pragma unroll
        for (int g = 0; g < 4; ++g) { const f32x4 og = *(const f32x4*)(ogp + 32 * dt + 8 * g);
            v2u wv2; wv2.x = pk2(oacc[dt][4 * g + 0] * rs * og[0], oacc[dt][4 * g + 1] * rs * og[1]); wv2.y = pk2(oacc[dt][4 * g + 2] * rs * og[2], oacc[dt][4 * g + 3] * rs * og[3]);
            *(v2u*)(orow + 32 * dt + 8 * g) = wv2; }
}

__device__ __forceinline__ void phase_mixers(const Params& p, LAS unsigned char* lds, int vcu, int G) {
    for (int pr = vcu; pr < 256; pr += G) {
        const int bh = pr >> 2, ip = pr & 3, b = bh >> 3, h = bh & 7;
        sb_unit(p, lds, b, h, 7 - ip);
        sb_unit(p, lds, b, h, ip);
    }
    for (int tl = vcu; tl < 1024; tl += G) { const int g = tl & 7, n = (tl >> 3) & 15, b = tl >> 7; gmlp_tile(p, lds, b, n, g); }
}

#define XB_TMO      128
#define XB_XCNT(j)  (256  + 64 * (j))
#define XB_XSUB(j)  (1280 + 64 * (j))
#define XB_XGEN(j)  (2304 + 64 * (j))
#define XB_TOP      3328
#define XB_TOPGEN   3392
#define XCD_BAR_WORDS 3456
#define XB_SPIN_CAP (1u << 18)

__device__ __forceinline__ unsigned xb_ld(unsigned* p)              { return __hip_atomic_load(p, __ATOMIC_RELAXED, __HIP_MEMORY_SCOPE_AGENT); }
__device__ __forceinline__ unsigned xb_add(unsigned* p, unsigned v) { return __hip_atomic_fetch_add(p, v, __ATOMIC_RELAXED, __HIP_MEMORY_SCOPE_AGENT); }
__device__ __forceinline__ unsigned xb_xcc_id() { return (unsigned)__builtin_amdgcn_s_getreg((3 << 11) | 20) & 0xFu; }
#define XB_SPIN(cond, bar) do { unsigned _sp = 0; while (cond) { __builtin_amdgcn_s_sleep(1); \
    if ((++_sp & 255u) == 0u) { if (xb_ld(&(bar)[XB_TMO])) break; if (_sp > XB_SPIN_CAP) { atomicAdd(&(bar)[XB_TMO], 1u); break; } } } } while (0)

struct XcdBarrier {
    unsigned* bar; unsigned x;
    volatile LAS unsigned* st;
};

__device__ __forceinline__ XcdBarrier xcd_barrier_post(unsigned* bar, volatile LAS unsigned* st) {
    XcdBarrier b; b.bar = bar; b.x = xb_xcc_id(); b.st = st;
    if (threadIdx.x == 0) (void)xb_add(&bar[XB_XCNT(b.x)], 1u);
    return b;
}
__device__ __forceinline__ void xcd_barrier_complete(unsigned* bar, unsigned x, unsigned& nloc, unsigned& nx) {
    const unsigned G = gridDim.x * gridDim.y * gridDim.z;
    unsigned sum, cnt, mine, sp = 0u;
    for (;;) {
        sum = 0u; cnt = 0u; mine = 0u;
#pragma unroll
        for (unsigned j = 0; j < 16; ++j) { const unsigned c = xb_ld(&bar[XB_XCNT(j)]); sum += c; cnt += (c > 0u) ? 1u : 0u; mine = (j == x) ? c : mine; }
        if (sum == G) break;
        __builtin_amdgcn_s_sleep(1);
        if ((++sp & 255u) == 0u) { if (xb_ld(&bar[XB_TMO])) break; if (sp > XB_SPIN_CAP) { atomicAdd(&bar[XB_TMO], 1u); break; } }
    }
    nloc = mine > 0u ? mine : 1u; nx = cnt > 0u ? cnt : 1u;
}

__device__ __forceinline__ void xcd_barrier(const XcdBarrier& b) {
    asm volatile("s_waitcnt vmcnt(0)" ::: "memory");
    __syncthreads();
    if (threadIdx.x == 0) {
        unsigned* bar = b.bar;
        __builtin_amdgcn_s_waitcnt(0);
        unsigned nloc = b.st[0], nx = b.st[1];
        if (nloc == 0u) { xcd_barrier_complete(bar, b.x, nloc, nx); b.st[0] = nloc; b.st[1] = nx; }
        const unsigned old = xb_add(&bar[XB_XSUB(b.x)], 1u);
        const unsigned gen = old / nloc;
        if (old + 1u == (gen + 1u) * nloc) {
            __builtin_amdgcn_fence(__ATOMIC_RELEASE, "agent");
            asm volatile("s_waitcnt vmcnt(0)" ::: "memory");
            const unsigned og = xb_add(&bar[XB_TOP], 1u);
            const unsigned tg = og / nx;
            if (og + 1u == (tg + 1u) * nx) xb_add(&bar[XB_TOPGEN], 1u);
            else XB_SPIN(xb_ld(&bar[XB_TOPGEN]) == tg, bar);
            __builtin_amdgcn_fence(__ATOMIC_ACQUIRE, "agent");
            xb_add(&bar[XB_XGEN(b.x)], 1u);
            asm volatile("s_waitcnt vmcnt(0)" ::: "memory");
        } else {
            XB_SPIN(xb_ld(&bar[XB_XGEN(b.x)]) == gen, bar);
            __builtin_amdgcn_fence(__ATOMIC_ACQUIRE, "agent");
            asm volatile("s_waitcnt vmcnt(0)" ::: "memory");
        }
    }
    __syncthreads();
}

#ifndef PH_MASK
#define PH_MASK 0x3ff
#endif
#define PH(k) if constexpr ((PH_MASK >> (k)) & 1)
#ifndef DUP_MASK
#define DUP_MASK 0
#endif
#define DUP(k) _Pragma("unroll 1") for (int _r = 0; _r < ((((DUP_MASK) >> (k)) & 1) ? 2 : 1); ++_r)
__global__ void __launch_bounds__(NTHREADS, 2) fwd_megakernel(Params p) {
    extern __shared__ __attribute__((aligned(16))) unsigned char lds_raw[];
    LAS unsigned char* lds = (LAS unsigned char*)lds_raw;
    cg::grid_group grid = cg::this_grid();
    if (p.ws == nullptr) grid.sync();
    volatile LAS unsigned* bst = (volatile LAS unsigned*)(lds + LDS_BYTES - 64);
    if (threadIdx.x == 0) { bst[0] = 0u; bst[1] = 0u; }
    __syncthreads();
    const XcdBarrier bar = xcd_barrier_post((unsigned*)(p.ws + WS_BAR), bst);
    const int G = gridDim.x, bx = blockIdx.x;
    const int vcu = (G % 8 == 0) ? (bx % 8) * (G / 8) + bx / 8 : bx;
    unsigned char* ws = p.ws;
    bf16* Win = (bf16*)(ws + WS_WIN); bf16* Wout = (bf16*)(ws + WS_WOUT); bf16* Wgu = (bf16*)(ws + WS_WGU); bf16* Wdn = (bf16*)(ws + WS_WDN);
    bf16* H = (bf16*)(ws + WS_H); bf16* PROJ = (bf16*)(ws + WS_PROJ); bf16* VT = (bf16*)(ws + WS_VT); bf16* O = (bf16*)(ws + WS_O); bf16* GU = (bf16*)(ws + WS_GU); bf16* X1 = (bf16*)(ws + WS_X1);
    float* mod = (float*)(ws + WS_MOD); float* SS1 = (float*)(ws + WS_SS1); float* SS2 = (float*)(ws + WS_SS2);

    PH(0) DUP(0) phase_prep(p, lds, vcu, G);
    xcd_barrier(bar);
    PH(1) DUP(1) phase_norm_mod<0>(p, p.x, nullptr, p.norm1_g, 0, H, vcu, G);
    xcd_barrier(bar);
    PH(2) DUP(2) {
        pg8::Gemm g{H, Win, T, NPROJ, DM}; pg8::StaticOrder S; S.init(T, NPROJ, G, bx);
        pg8::EpiProj E{PROJ, NPROJ, 8, 8, 12, QSCALE};
        pg8::gemm_phase<pg8::EpiProj, pg8::StaticOrder, true, true>(lds, g, S, E);
    }
    PH(9) DUP(2) {
        pg8::Gemm g{Win + (size_t)NPROJ * DM, H, 1024, T, DM}; pg8::StaticOrder S; S.init(1024, T, G, bx);
        pg8::EpiProj E{VT, T, 0, 0, 0, 1.f};
        pg8::gemm_phase<pg8::EpiProj, pg8::StaticOrder, true, true>(lds, g, S, E);
    }
    xcd_barrier(bar);
    PH(3) DUP(3) phase_mixers(p, lds, vcu, G);
    xcd_barrier(bar);
    PH(4) DUP(4) {
        pg8::Gemm g{O, Wout, T, DM, DM}; pg8::StaticOrder S; S.init(T, DM, G, bx);
        pg8::EpiRes<false> E{p.x, X1, DM, mod + 2 * DM, SS1};
        pg8::gemm_phase<pg8::EpiRes<false>, pg8::StaticOrder, true, true>(lds, g, S, E);
    }
    xcd_barrier(bar);
    PH(5) DUP(5) phase_norm_mod<1>(p, X1, SS1, p.norm2_g, 3, H, vcu, G);
    xcd_barrier(bar);
    PH(6) DUP(6) {
        pg8::Gemm g{H, Wgu, T, 2 * DFF, DM}; pg8::StaticOrder S; S.init(T, 2 * DFF, G, bx);
        pg8::EpiGU E{GU, DFF};
        pg8::gemm_phase<pg8::EpiGU, pg8::StaticOrder, true, true>(lds, g, S, E);
    }
    xcd_barrier(bar);
    PH(7) {
        pg8::Gemm g{GU, Wdn, T, DM, DFF}; pg8::StaticOrder S; S.init(T, DM, G, bx);
        pg8::EpiRes<true> E{X1, X1, DM, mod + 5 * DM, SS2};
        pg8::gemm_phase<pg8::EpiRes<true>, pg8::StaticOrder, true, true>(lds, g, S, E);
    }
    xcd_barrier(bar);
    PH(8) phase_final(p, SS2, vcu, G);
}

extern "C" void kernel_launch(void* const* d_in, const int* in_sizes, int n_in, void* d_out, int out_size, void* d_ws, size_t ws_size, hipStream_t stream) {
    static int grid_blocks = 0;
    if (grid_blocks == 0) {
        if (n_in != 16 || ws_size < WS_END) { fprintf(stderr, "kernel_launch: unexpected n_in %d / ws_size %zu (need %zu)\n", n_in, ws_size, (size_t)WS_END); grid_blocks = -1; return; }
        int dev = 0, cus = 0, per_cu = 0;
        (void)hipGetDevice(&dev);
        (void)hipDeviceGetAttribute(&cus, hipDeviceAttributeMultiprocessorCount, dev);
        if (hipFuncSetAttribute((const void*)fwd_megakernel, hipFuncAttributeMaxDynamicSharedMemorySize, LDS_BYTES) != hipSuccess) { fprintf(stderr, "kernel_launch: hipFuncSetAttribute failed\n"); grid_blocks = -1; return; }
        if (hipOccupancyMaxActiveBlocksPerMultiprocessor(&per_cu, (const void*)fwd_megakernel, NTHREADS, LDS_BYTES) != hipSuccess || per_cu < 1) { fprintf(stderr, "kernel_launch: occupancy query says %d\n", per_cu); per_cu = 1; }
        (void)hipGetLastError();
        grid_blocks = cus * 1;
    }
    if (grid_blocks < 0) return;
    if (hipMemsetAsync((char*)d_ws + WS_BAR, 0, 16384, stream) != hipSuccess) { fprintf(stderr, "kernel_launch: memset failed\n"); return; }
    Params p{};
    p.x = (const float*)d_in[0]; p.c = (const float*)d_in[1]; p.w_ada = (const float*)d_in[2]; p.b_ada = (const float*)d_in[3]; p.norm1_g = (const float*)d_in[4];
    p.w_in = (const float*)d_in[5]; p.v_norm_g = (const float*)d_in[6]; p.w_spatial = (const float*)d_in[7]; p.b_spatial = (const float*)d_in[8]; p.out_norm_g = (const float*)d_in[9];
    p.w_out = (const float*)d_in[10]; p.norm2_g = (const float*)d_in[11]; p.w_gate = (const float*)d_in[12]; p.w_up = (const float*)d_in[13]; p.w_down = (const float*)d_in[14]; p.final_g = (const float*)d_in[15];
    p.out = (float*)d_out; p.ws = (unsigned char*)d_ws;
    void* args[] = {&p};
    hipError_t e = hipLaunchCooperativeKernel((const void*)fwd_megakernel, dim3(grid_blocks), dim3(NTHREADS), args, LDS_BYTES, stream);
    if (e != hipSuccess) fprintf(stderr, "cooperative launch failed: %s (grid %d)\n", hipGetErrorString(e), grid_blocks);
}
```

```cpp
#include <hip/hip_runtime.h>
#include <hip/hip_cooperative_groups.h>
#include <cstdio>
#include <cstdint>
namespace cg = cooperative_groups;
__device__ __forceinline__ int lane_id() { int l; asm volatile("v_mbcnt_lo_u32_b32 %0, -1, 0\n\tv_mbcnt_hi_u32_b32 %0, -1, %0" : "=&v"(l)); return l; }
__device__ __forceinline__ int fresh_tid(int wave_s) { int t = (wave_s << 6) | lane_id(); asm volatile("" : "+v"(t)); return t; }
#ifndef TS_SEL
#define TS_SEL -1
#endif
#ifndef TS_SCALE
#define TS_SCALE 1.0f
#endif
namespace pg8 {
#define PG8_LAS __attribute__((address_space(3)))
typedef unsigned short bf16_t;
typedef short bf16x8 __attribute__((ext_vector_type(8)));
typedef float f32x4 __attribute__((ext_vector_type(4)));
typedef unsigned u32x4 __attribute__((ext_vector_type(4)));
constexpr int BM = 256, BK = 64, HALF = 128, HTB = HALF * BK * 2  , STAGE_BYTES = 8 * HTB, NXCD = 8, WGM = 8;

__host__ __device__ __forceinline__ int lds_byte(int r, int c) { const int st = (r >> 4) * 2 + (c >> 5), rr = r & 15, cc = c & 31, ob = rr * 64 + cc * 2; return st * 1024 + (ob ^ (((ob >> 9) & 1) << 5)); }
__host__ __device__ __forceinline__ void stage_rc(int b, int& R, int& C) { const int st = b / 1024, sb = b % 1024, swz = sb ^ (((sb >> 9) & 1) << 5); R = (st >> 1) * 16 + swz / 64; C = (st & 1) * 32 + (swz % 64) / 2; }
__host__ __device__ __forceinline__ int perm32(int rho) { const int n = rho >> 4, i = rho & 15; return 8 * (i >> 2) + 4 * n + (i & 3); }

struct Unit { int pm, pn; };
struct Gemm { const bf16_t* A; const bf16_t* Bt; int M, N, K; };

struct StaticOrder {
    int nM, nN, nwg, G, c;
    __host__ __device__ void init(int M, int N, int G_, int c_) { nM = M / BM; nN = N / BM; nwg = nM * nN; G = G_; c = c_; }
    __host__ __device__ bool next(int i, Unit& u) const {
        const long L = (long)i * G + c; if (L >= nwg) return false;
        int wgid = (int)L; { const int q = nwg / NXCD, r = nwg % NXCD, xcd = wgid % NXCD, off = wgid / NXCD; wgid = (xcd < r ? xcd * (q + 1) : r * (q + 1) + (xcd - r) * q) + off; }
        const int nig = WGM * nN, gid = wgid / nig, fm = gid * WGM, gsz = (nM - fm) < WGM ? (nM - fm) : WGM;
        u.pm = fm + ((wgid % nig) % gsz); u.pn = (wgid % nig) / gsz; return true;
    }
    __device__ __forceinline__ void a_ready(const Unit&) const {}
    __device__ __forceinline__ void done(const Unit&) const {}
};

__device__ __forceinline__ unsigned cvt_pk_bf16(float lo, float hi) { unsigned r; asm("v_cvt_pk_bf16_f32 %0, %1, %2" : "=v"(r) : "v"(lo), "v"(hi)); return r; }
typedef float f32x2 __attribute__((ext_vector_type(2)));
__device__ __forceinline__ f32x2 gelu_pk(f32x2 v) {
    const f32x2 av = __builtin_elementwise_abs(v), d = av * 0.2316418882f + 1.0f;
    f32x2 t; t.x = __builtin_amdgcn_rcpf(d.x); t.y = __builtin_amdgcn_rcpf(d.y);
    f32x2 q = t * 0.5307027145f + (-0.7265760135f); q = q * t + 0.7107068705f; q = q * t + (-0.142248368f); q = q * t + 0.127414796f; q = q * t;
    const f32x2 s = (v * v) * (-0.72134752044f);
    f32x2 e; e.x = __builtin_amdgcn_exp2f(s.x); e.y = __builtin_amdgcn_exp2f(s.y);
    const f32x2 m = v * (q * e), r = v - m;
    f32x2 o; o.x = v.x < 0.f ? m.x : r.x; o.y = v.y < 0.f ? m.y : r.y; return o;
}

struct EpiProj {
    static constexpr bool PERM = true, AFTER_DRAIN = false;
    bf16_t* O; int ldc; int gelu_tiles; int sc_lo, sc_hi; float sc;
    __device__ __forceinline__ void operator()(f32x4 (&acc)[2][2][4][2], const Unit& u, int wr, int wc, int fr, int fq, bool last) const {
        const int row0 = u.pm * BM + wr * 64 + fr, col0 = u.pn * BM + wc * 32 + 8 * fq;
        const bool g = u.pn < gelu_tiles; const float s = (u.pn >= sc_lo && u.pn < sc_hi) ? sc : 1.f;
#pragma unroll
        for (int ai = 0; ai < 2; ++ai)
#pragma unroll
            for (int m = 0; m < 4; ++m) { bf16_t* rowp = O + (size_t)(row0 + ai * HALF + m * 16) * ldc + col0;
#pragma unroll
                for (int bj = 0; bj < 2; ++bj) { f32x4 v0 = acc[ai][bj][m][0], v1 = acc[ai][bj][m][1];
                    if (g) { f32x2 a = gelu_pk((f32x2){v0[0], v0[1]}), b = gelu_pk((f32x2){v0[2], v0[3]}), c = gelu_pk((f32x2){v1[0], v1[1]}), d = gelu_pk((f32x2){v1[2], v1[3]});
                        v0 = (f32x4){a.x, a.y, b.x, b.y}; v1 = (f32x4){c.x, c.y, d.x, d.y}; }
                    v0 = v0 * s; v1 = v1 * s; u32x4 w; w.x = cvt_pk_bf16(v0[0], v0[1]); w.y = cvt_pk_bf16(v0[2], v0[3]); w.z = cvt_pk_bf16(v1[0], v1[1]); w.w = cvt_pk_bf16(v1[2], v1[3]);
                    *(u32x4*)(rowp + bj * HALF) = w; } }
    }
};
template <int MODE> struct EpiResNorm {
    static constexpr bool PERM = true, AFTER_DRAIN = false;
    static constexpr int MB = (MODE == 1) ? 4 : 2;
    const void* base; bf16_t* xres; const float* gate; float* ssq; unsigned* cnt;
    bf16_t* H; const float* ng; const float* modp; int shift_chunk;
    float* outf; const float* fg;
    PG8_LAS unsigned char* lx;
    __device__ __forceinline__ static void unpack8(const u32x4 raw, f32x4& a, f32x4& b) {
        a = (f32x4){__uint_as_float(raw.x << 16), __uint_as_float(raw.x & 0xffff0000u), __uint_as_float(raw.y << 16), __uint_as_float(raw.y & 0xffff0000u)};
        b = (f32x4){__uint_as_float(raw.z << 16), __uint_as_float(raw.z & 0xffff0000u), __uint_as_float(raw.w << 16), __uint_as_float(raw.w & 0xffff0000u)}; }
    __device__ __forceinline__ static u32x4 pack8(const f32x4 a, const f32x4 b) { u32x4 w; w.x = cvt_pk_bf16(a[0], a[1]); w.y = cvt_pk_bf16(a[2], a[3]); w.z = cvt_pk_bf16(b[0], b[1]); w.w = cvt_pk_bf16(b[2], b[3]); return w; }
    __device__ __forceinline__ void operator()(f32x4 (&acc)[2][2][4][2], const Unit& u, int wr, int wc, int fr, int fq, bool last) const {
        const int lane = fr + 16 * fq, wid = wr * 4 + wc;
        const int rl0 = wr * 64 + fr, row0 = u.pm * BM + rl0, col0 = u.pn * BM + wc * 32 + 8 * fq;
        const int b = u.pm >> 3;
        PG8_LAS float* P = (PG8_LAS float*)lx;
        PG8_LAS float* S = (PG8_LAS float*)(lx + 4096);
        {
            f32x4 gv[2][2];
#pragma unroll
            for (int bj = 0; bj < 2; ++bj)
#pragma unroll
                for (int n = 0; n < 2; ++n) gv[bj][n] = *(const f32x4*)(gate + (size_t)b * 12288 + col0 + bj * HALF + n * 4);
            constexpr int EB = (MODE == 1) ? 2 : 4;
            const char* bp = (const char*)base + ((size_t)(u.pm * BM + rl0) * 2048 + col0) * EB;
            char* xp = (char*)xres + ((size_t)(u.pm * BM + rl0) * 2048 + col0) * 2;
            constexpr size_t RS = (size_t)16 * 2048;
#pragma unroll
            for (int ai = 0; ai < 2; ++ai)
#pragma unroll
                for (int mp = 0; mp < 4 / MB; ++mp) {
                    asm volatile("" : "+v"(bp), "+v"(xp));
                    f32x4 b0[MODE == 1 ? 1 : MB][2], b1[MODE == 1 ? 1 : MB][2]; u32x4 rawb[MODE == 1 ? MB : 1][2];
#pragma unroll
                    for (int mi = 0; mi < MB; ++mi)
#pragma unroll
                        for (int bj = 0; bj < 2; ++bj) {
                            if (MODE == 1) rawb[mi][bj] = *(const u32x4*)(bp + (mi * RS + bj * HALF) * EB);
                            else { b0[mi][bj] = *(const f32x4*)(bp + (mi * RS + bj * HALF) * EB); b1[mi][bj] = *(const f32x4*)(bp + (mi * RS + bj * HALF) * EB + 16); } }
#pragma unroll
                    for (int mi = 0; mi < MB; ++mi) { const int m = MB * mp + mi; const int rl = rl0 + ai * HALF + m * 16; float ss = 0.f;
#pragma unroll
                        for (int bj = 0; bj < 2; ++bj) {
                            f32x4 bb0, bb1;
                            if (MODE == 1) unpack8(rawb[mi][bj], bb0, bb1); else { bb0 = b0[MODE == 1 ? 0 : mi][bj]; bb1 = b1[MODE == 1 ? 0 : mi][bj]; }
                            const f32x4 o0 = bb0 + gv[bj][0] * acc[ai][bj][m][0], o1 = bb1 + gv[bj][1] * acc[ai][bj][m][1];
                            ss += ((o0[0] * o0[0] + o0[1] * o0[1]) + (o0[2] * o0[2] + o0[3] * o0[3])) + ((o1[0] * o1[0] + o1[1] * o1[1]) + (o1[2] * o1[2] + o1[3] * o1[3]));
                            acc[ai][bj][m][0] = o0; acc[ai][bj][m][1] = o1;
                            if (MODE == 0) *(u32x4*)(xp + (mi * RS + bj * HALF) * 2) = pack8(o0, o1); }
                        ss += __shfl_xor(ss, 16); ss += __shfl_xor(ss, 32);
                        if (fq == 0) P[rl * 4 + wc] = ss; }
                    const size_t rstep = (size_t)((mp == 4 / MB - 1) ? (HALF - 48 + (MB - 1) * 16) : 16 * MB) * 2048;
                    bp += rstep * EB; xp += rstep * 2;
                    asm volatile("" ::: "memory"); }
        }
        asm volatile("s_waitcnt lgkmcnt(0)" ::: "memory"); __builtin_amdgcn_s_barrier(); asm volatile("" ::: "memory");
        if (lane < 32) { const int rl = wid * 32 + lane; const f32x4 pv = *(const PG8_LAS f32x4*)(P + rl * 4);
            __hip_atomic_store(ssq + (size_t)(u.pm * BM + rl) * 8 + u.pn, (pv[0] + pv[1]) + (pv[2] + pv[3]), __ATOMIC_RELAXED, __HIP_MEMORY_SCOPE_AGENT); }
        asm volatile("s_waitcnt vmcnt(0)" ::: "memory");
        if (lane == 0) __hip_atomic_fetch_add(cnt + 64 * u.pm, 1u, __ATOMIC_RELAXED, __HIP_MEMORY_SCOPE_AGENT);
        if (wid == 0) { unsigned sp = 0;
            while ((unsigned)__builtin_amdgcn_readfirstlane(__hip_atomic_load(cnt + 64 * u.pm, __ATOMIC_RELAXED, __HIP_MEMORY_SCOPE_AGENT)) < 64u) { __builtin_amdgcn_s_sleep(2); if (++sp > (1u << 20)) break; }
            __builtin_amdgcn_fence(__ATOMIC_ACQUIRE, "agent");
            asm volatile("s_waitcnt vmcnt(0)" ::: "memory"); }
        asm volatile("s_waitcnt vmcnt(0) lgkmcnt(0)" ::: "memory"); __builtin_amdgcn_s_barrier(); asm volatile("" ::: "memory");
        { const int t = wid * 64 + lane;
          if (t < 256) { const unsigned long long* sp8 = (const unsigned long long*)(ssq + (size_t)(u.pm * BM + t) * 8); float s = 0.f;
#pragma unroll
              for (int q = 0; q < 4; ++q) { const unsigned long long w = __hip_atomic_load(sp8 + q, __ATOMIC_RELAXED, __HIP_MEMORY_SCOPE_AGENT); s += __uint_as_float((unsigned)w) + __uint_as_float((unsigned)(w >> 32)); }
              S[t] = 1.0f / sqrtf(s * (1.0f / 2048.0f) + 1e-6f); } }
        asm volatile("s_waitcnt lgkmcnt(0)" ::: "memory"); __builtin_amdgcn_s_barrier(); asm volatile("" ::: "memory");
        {
            const int cbase = col0;
            f32x4 A[2][2], B[2][2];
#pragma unroll
            for (int bj = 0; bj < 2; ++bj)
#pragma unroll
                for (int n = 0; n < 2; ++n) { const int c = cbase + bj * HALF + n * 4;
                    if (MODE == 0) { A[bj][n] = *(const f32x4*)(ng + c) * (*(const f32x4*)(modp + (size_t)b * 12288 + (shift_chunk + 1) * 2048 + c) + 1.0f); B[bj][n] = *(const f32x4*)(modp + (size_t)b * 12288 + shift_chunk * 2048 + c); }
                    else { A[bj][n] = *(const f32x4*)(fg + c); B[bj][n] = (f32x4){0.f, 0.f, 0.f, 0.f}; } }
#pragma unroll
            for (int ai = 0; ai < 2; ++ai)
#pragma unroll
                for (int m = 0; m < 4; ++m) { const int rl = rl0 + ai * HALF + m * 16; const float rs = S[rl]; const size_t off = (size_t)(u.pm * BM + rl) * 2048 + cbase;
#pragma unroll
                    for (int bj = 0; bj < 2; ++bj) {
                        const f32x4 o0 = (acc[ai][bj][m][0] * rs) * A[bj][0] + B[bj][0], o1 = (acc[ai][bj][m][1] * rs) * A[bj][1] + B[bj][1];
                        if (MODE == 0) *(u32x4*)(H + off + bj * HALF) = pack8(o0, o1);
                        else { *(f32x4*)(outf + off + bj * HALF) = o0; *(f32x4*)(outf + off + bj * HALF + 4) = o1; } } }
        }
    }
};
struct EpiGU {
    static constexpr bool PERM = true, AFTER_DRAIN = false;
    bf16_t* O; int ldc;
    __device__ __forceinline__ void operator()(f32x4 (&acc)[2][2][4][2], const Unit& u, int wr, int wc, int fr, int fq, bool last) const {
        const int row0 = u.pm * BM + wr * 64 + fr, col0 = u.pn * HALF + wc * 32 + 8 * fq;
#pragma unroll
        for (int ai = 0; ai < 2; ++ai)
#pragma unroll
            for (int m = 0; m < 4; ++m) { bf16_t* rowp = O + (size_t)(row0 + ai * HALF + m * 16) * ldc + col0; float v[8];
#pragma unroll
                for (int n = 0; n < 2; ++n)
#pragma unroll
                    for (int j = 0; j < 4; ++j) { const float g = acc[ai][0][m][n][j], up = acc[ai][1][m][n][j];
                        const float e = __builtin_amdgcn_exp2f(g * (-1.44269504089f)); v[n * 4 + j] = g * __builtin_amdgcn_rcpf(1.0f + e) * up; }
                u32x4 w; w.x = cvt_pk_bf16(v[0], v[1]); w.y = cvt_pk_bf16(v[2], v[3]); w.z = cvt_pk_bf16(v[4], v[5]); w.w = cvt_pk_bf16(v[6], v[7]);
                *(u32x4*)rowp = w; }
    }
};

struct PanelOrder {
    int c;
    __host__ __device__ void init(int, int, int, int c_) { c = c_; }
    __host__ __device__ bool next(int i, Unit& u) const { if (i >= 2) return false; const int o = c >> 3; u.pm = 8 * (c & 7) + 4 * i + (o & 3); u.pn = o >> 2; return true; }
    __device__ __forceinline__ void a_ready(const Unit&) const {}
    __device__ __forceinline__ void done(const Unit&) const {}
};
template <class Epi, class Sched, bool ALIGN_EPI = false, bool SP2 = false>
__device__ __forceinline__ void gemm_phase(PG8_LAS unsigned char* lds, const Gemm g, const Sched& S, const Epi& E, const int wave_s) {
    const int tid = fresh_tid(wave_s), wid = wave_s, lane = tid & 63, wr = wid >> 2, wc = wid & 3, fr = lane & 15, fq = lane >> 4;
    const int K = g.K, nt = K / BK;
    unsigned voffA[2], voffB[2];
#pragma unroll
    for (int i = 0; i < 2; ++i) { int R, C; stage_rc(tid * 16 + i * 8192, R, C); const int Rb = Epi::PERM ? ((R & ~31) + perm32(R & 31)) : R;
        voffA[i] = (unsigned)(R * K + C) * 2u; voffB[i] = (unsigned)(Rb * K + C) * 2u; }
    const size_t kstep = (size_t)(BK * 2);
    const size_t hstep = (size_t)HALF * K * 2;
    const size_t tstep = 2 * hstep;
    const unsigned ldsw = (unsigned)wid * 1024u;
    const int aoff = lds_byte(wr * 64 + fr, fq * 8), boff = lds_byte(wc * 32 + fr, fq * 8);
#define PG8_SA(b, h) (((b) * 2 + (h)) * HTB)
#define PG8_SB(b, h) ((4 + (b) * 2 + (h)) * HTB)
#define PG8_STAGE(bufoff, gbase, voff) do { _Pragma("unroll") for (int _i = 0; _i < 2; ++_i) \
        __builtin_amdgcn_global_load_lds((const unsigned*)((const char*)(gbase) + (voff)[_i]), (PG8_LAS unsigned*)(lds + (bufoff) + ldsw + _i * 8192), 16, 0, 0); } while (0)
#define PG8_LDA(dst, b, h) do { _Pragma("unroll") for (int m = 0; m < 4; ++m) _Pragma("unroll") for (int k = 0; k < 2; ++k) dst[m][k] = *(const PG8_LAS bf16x8*)(lds + PG8_SA(b, h) + aoff + m * 2048 + k * 1024); } while (0)
#define PG8_LDB(dst, b, h) do { _Pragma("unroll") for (int n = 0; n < 2; ++n) _Pragma("unroll") for (int k = 0; k < 2; ++k) dst[n][k] = *(const PG8_LAS bf16x8*)(lds + PG8_SB(b, h) + boff + n * 2048 + k * 1024); } while (0)
#define PG8_MMA(ai, bj, At, Bt) do { __builtin_amdgcn_s_setprio(1); _Pragma("unroll") for (int m = 0; m < 4; ++m) _Pragma("unroll") for (int n = 0; n < 2; ++n) _Pragma("unroll") for (int k = 0; k < 2; ++k) \
        acc[ai][bj][m][n] = __builtin_amdgcn_mfma_f32_16x16x32_bf16(Bt[n][k], At[m][k], acc[ai][bj][m][n], 0, 0, 0); __builtin_amdgcn_s_setprio(0); } while (0)
#define PG8_WAIT_V(n) asm volatile("s_waitcnt vmcnt(" #n ")" ::: "memory")
#define PG8_WAIT_L(n) asm volatile("s_waitcnt lgkmcnt(" #n ")" ::: "memory")
#define PG8_BAR __builtin_amdgcn_s_barrier()
#define PG8_SCHED __builtin_amdgcn_sched_barrier(0)
    Unit cur, nxt; int ui = 0;
    if (!S.next(0, cur)) return;
    f32x4 acc[2][2][4][2];
#pragma unroll
    for (int a = 0; a < 2; ++a)
#pragma unroll
        for (int b = 0; b < 2; ++b)
#pragma unroll
            for (int m = 0; m < 4; ++m)
#pragma unroll
                for (int n = 0; n < 2; ++n) acc[a][b][m][n] = (f32x4){0.f, 0.f, 0.f, 0.f};
    bf16x8 At[4][2], B0[2][2], B1[2][2];
    const char* cA = (const char*)g.A + (size_t)cur.pm * tstep; const char* cB = (const char*)g.Bt + (size_t)cur.pn * tstep;
    S.a_ready(cur);
    if constexpr (SP2) {
        PG8_STAGE(PG8_SB(0, 0), cB, voffB); PG8_STAGE(PG8_SB(0, 1), cB + hstep, voffB); PG8_STAGE(PG8_SA(0, 0), cA, voffA); PG8_STAGE(PG8_SA(0, 1), cA + hstep, voffA);
        if (wr == 1) PG8_BAR;
        PG8_WAIT_V(2); PG8_BAR;
        PG8_STAGE(PG8_SB(1, 0), cB + kstep, voffB); PG8_STAGE(PG8_SA(1, 0), cA + kstep, voffA); PG8_STAGE(PG8_SB(1, 1), cB + hstep + kstep, voffB);
        PG8_WAIT_V(6); PG8_BAR;
    } else {
        PG8_STAGE(PG8_SB(0, 0), cB, voffB); PG8_STAGE(PG8_SA(0, 0), cA, voffA); PG8_STAGE(PG8_SB(0, 1), cB + hstep, voffB); PG8_STAGE(PG8_SA(0, 1), cA + hstep, voffA);
        if (wr == 1) PG8_BAR;
        PG8_WAIT_V(4); PG8_BAR;
        PG8_STAGE(PG8_SB(1, 0), cB + kstep, voffB); PG8_STAGE(PG8_SA(1, 0), cA + kstep, voffA); PG8_STAGE(PG8_SB(1, 1), cB + hstep + kstep, voffB);
        PG8_WAIT_V(6); PG8_BAR;
    }
    for (;;) {
        const bool has_next = S.next(ui + 1, nxt);
        const char* nA = has_next ? (const char*)g.A + (size_t)nxt.pm * tstep : cA; const char* nB = has_next ? (const char*)g.Bt + (size_t)nxt.pn * tstep : cB;
        for (int t = 0; t < nt; t += 2) {
            const bool last = (t == nt - 2);
            const char* a1 = cA + (size_t)(t + 1) * kstep;
            const char* a2 = last ? nA : cA + (size_t)(t + 2) * kstep; const char* b2 = last ? nB : cB + (size_t)(t + 2) * kstep;
            const char* a3 = a2 + kstep; const char* b3 = b2 + kstep;
            if (last && has_next) S.a_ready(nxt);
            if constexpr (SP2) {
            PG8_LDB(B0, 0, 0); PG8_LDB(B1, 0, 1); PG8_SCHED; PG8_LDA(At, 0, 0); PG8_STAGE(PG8_SA(1, 1), a1 + hstep, voffA);
            PG8_WAIT_V(8); PG8_WAIT_L(0); PG8_BAR; PG8_MMA(0, 0, At, B0); PG8_MMA(0, 1, At, B1); PG8_BAR; PG8_SCHED;
            PG8_LDA(At, 0, 1); PG8_STAGE(PG8_SB(0, 0), b2, voffB); PG8_STAGE(PG8_SB(0, 1), b2 + hstep, voffB); PG8_STAGE(PG8_SA(0, 0), a2, voffA);
            PG8_WAIT_V(8); PG8_WAIT_L(0); PG8_BAR; PG8_MMA(1, 0, At, B0); PG8_MMA(1, 1, At, B1); PG8_BAR; PG8_SCHED;
            PG8_LDB(B0, 1, 0); PG8_LDB(B1, 1, 1); PG8_SCHED; PG8_LDA(At, 1, 0); PG8_STAGE(PG8_SA(0, 1), a2 + hstep, voffA);
            PG8_WAIT_V(8); PG8_WAIT_L(0); PG8_BAR; PG8_MMA(0, 0, At, B0); PG8_MMA(0, 1, At, B1); PG8_BAR; PG8_SCHED;
            PG8_LDA(At, 1, 1); PG8_STAGE(PG8_SB(1, 0), b3, voffB); PG8_STAGE(PG8_SB(1, 1), b3 + hstep, voffB); PG8_STAGE(PG8_SA(1, 0), a3, voffA);
            PG8_WAIT_V(8); PG8_WAIT_L(0); PG8_BAR; PG8_MMA(1, 0, At, B0); PG8_MMA(1, 1, At, B1); PG8_BAR; PG8_SCHED;
            } else {
            PG8_LDB(B0, 0, 0); PG8_SCHED; PG8_LDA(At, 0, 0); PG8_STAGE(PG8_SA(1, 1), a1 + hstep, voffA);
            PG8_WAIT_L(8); PG8_BAR; PG8_WAIT_L(0); PG8_MMA(0, 0, At, B0); PG8_BAR; PG8_SCHED;
            PG8_LDB(B1, 0, 1); PG8_STAGE(PG8_SB(0, 0), b2, voffB);
            PG8_BAR; PG8_WAIT_L(0); PG8_MMA(0, 1, At, B1); PG8_BAR;
            PG8_LDA(At, 0, 1); PG8_STAGE(PG8_SA(0, 0), a2, voffA);
            PG8_BAR; PG8_WAIT_L(0); PG8_MMA(1, 0, At, B0); PG8_BAR; PG8_SCHED;
            PG8_STAGE(PG8_SB(0, 1), b2 + hstep, voffB);
            PG8_WAIT_V(6); PG8_BAR; PG8_MMA(1, 1, At, B1); PG8_BAR;
            PG8_LDB(B0, 1, 0); PG8_SCHED; PG8_LDA(At, 1, 0); PG8_STAGE(PG8_SA(0, 1), a2 + hstep, voffA);
            PG8_WAIT_L(8); PG8_BAR; PG8_WAIT_L(0); PG8_MMA(0, 0, At, B0); PG8_BAR; PG8_SCHED;
            PG8_LDB(B1, 1, 1); PG8_STAGE(PG8_SB(1, 0), b3, voffB);
            PG8_BAR; PG8_WAIT_L(0); PG8_MMA(0, 1, At, B1); PG8_BAR;
            PG8_LDA(At, 1, 1); PG8_STAGE(PG8_SA(1, 0), a3, voffA);
            PG8_BAR; PG8_WAIT_L(0); PG8_MMA(1, 0, At, B0); PG8_BAR; PG8_SCHED;
            PG8_STAGE(PG8_SB(1, 1), b3 + hstep, voffB);
            PG8_WAIT_V(6); PG8_BAR; PG8_MMA(1, 1, At, B1); PG8_BAR;
            }
        }
        if constexpr (ALIGN_EPI) { if (wr == 0) PG8_BAR; }
        if constexpr (!Epi::AFTER_DRAIN) { E(acc, cur, wr, wc, fr, fq, !has_next); S.done(cur); }
        if (!has_next) break;
#pragma unroll
        for (int a = 0; a < 2; ++a)
#pragma unroll
            for (int b = 0; b < 2; ++b)
#pragma unroll
                for (int m = 0; m < 4; ++m)
#pragma unroll
                    for (int n = 0; n < 2; ++n) acc[a][b][m][n] = (f32x4){0.f, 0.f, 0.f, 0.f};
        cur = nxt; cA = nA; cB = nB; ++ui;
        if constexpr (ALIGN_EPI) { if (wr == 1) PG8_BAR; }
    }
    PG8_WAIT_V(0);
    if constexpr (!ALIGN_EPI) { if (wr == 0) PG8_BAR; }
    PG8_BAR;
    if constexpr (Epi::AFTER_DRAIN) { E.fused(acc, cur, wr, wc, fr, fq, lds, wid, lane); S.done(cur); }
#undef PG8_SA
#undef PG8_SB
#undef PG8_STAGE
#undef PG8_LDA
#undef PG8_LDB
#undef PG8_MMA
#undef PG8_WAIT_V
#undef PG8_WAIT_L
#undef PG8_BAR
#undef PG8_SCHED
}
}

constexpr int NB = 8, SEQ = 2048, DM = 2048, T = NB * SEQ;
constexpr int DFF = 5632, NIN = 5120, NMOD = 6 * DM;
constexpr int NPROJ = 4096;
constexpr float EPS = 1e-6f;
constexpr int NTHREADS = 512, NWAVES = 8;
constexpr int LDS_BYTES = 147456;
constexpr float QSCALE = 0.08838834764831845f * 1.4426950408889634f;

constexpr size_t MiB = 1u << 20;
constexpr size_t WS_BAR = 0;
constexpr size_t WS_MODCNT = 15360;
constexpr size_t WS_CNT1 = 16384, WS_CNT2 = 32768;
constexpr size_t WS_MOD = 512 * 1024;
constexpr size_t WS_SS1 = 1 * MiB;
constexpr size_t WS_SS2 = 3 * MiB;
constexpr size_t WS_WIN = 6 * MiB;
constexpr size_t WS_WOUT = 26 * MiB;
constexpr size_t WS_WGU = 34 * MiB;
constexpr size_t WS_WDN = 78 * MiB;
constexpr size_t WS_H = 100 * MiB;
constexpr size_t WS_PROJ = 164 * MiB;
constexpr size_t WS_VT = 292 * MiB;
constexpr size_t WS_O = 324 * MiB;
constexpr size_t WS_GU = 164 * MiB;
constexpr size_t WS_X1 = 388 * MiB;
constexpr size_t WS_END = 452 * MiB;
static_assert(WS_GU + (size_t)T * DFF * 2 <= WS_END, "ws map");

#define LAS __attribute__((address_space(3)))
typedef unsigned short bf16;
typedef unsigned v4u __attribute__((ext_vector_type(4)));
typedef unsigned v2u __attribute__((ext_vector_type(2)));
typedef float f32x4 __attribute__((ext_vector_type(4)));
typedef short bf16x8 __attribute__((ext_vector_type(8)));
typedef short bf16x4 __attribute__((ext_vector_type(4)));

__device__ __forceinline__ unsigned pk2(float lo, float hi) { return pg8::cvt_pk_bf16(lo, hi); }
__device__ __forceinline__ float bflo(unsigned w) { return __uint_as_float(w << 16); }
__device__ __forceinline__ float bfhi(unsigned w) { return __uint_as_float(w & 0xffff0000u); }
__device__ __forceinline__ float wave_sum(float v) {
#pragma unroll
    for (int o = 1; o < 64; o <<= 1) v += __shfl_xor(v, o);
    return v;
}

struct Params {
    const float *x, *c, *w_ada, *b_ada, *norm1_g, *w_in, *v_norm_g, *w_spatial, *b_spatial, *out_norm_g, *w_out, *norm2_g, *w_gate, *w_up, *w_down, *final_g;
    float* out; unsigned char* ws;
};

constexpr int TSCR = 16640;
__device__ __forceinline__ void titem_decode(const Params& p, int it, int lane, const float*& tsrc, bf16*& tdst, int& tN, int& tK) {
    constexpr int I_IN = (DM / 64) * (NIN / 64), I_OUT = (DM / 64) * (DM / 64), I_G = (DM / 64) * (DFF / 64);
    bf16* Win = (bf16*)(p.ws + WS_WIN); bf16* Wout = (bf16*)(p.ws + WS_WOUT); bf16* Wgu = (bf16*)(p.ws + WS_WGU); bf16* Wdn = (bf16*)(p.ws + WS_WDN);
    int r = it, mid = 0;
    if (r >= I_IN) { r -= I_IN; mid = 1; if (r >= I_OUT) { r -= I_OUT; mid = 2; if (r >= I_G) { r -= I_G; mid = 3; if (r >= I_G) { r -= I_G; mid = 4; } } } }
#define TSEL(k, v) ((unsigned long long)(-(long long)(mid == (k))) & (unsigned long long)(v))
    const float* W = (const float*)(TSEL(0, p.w_in) | TSEL(1, p.w_out) | TSEL(2, p.w_gate) | TSEL(3, p.w_up) | TSEL(4, p.w_down));
    bf16* WT = (bf16*)(TSEL(0, Win) | TSEL(1, Wout) | TSEL(2, Wgu) | TSEL(3, Wgu) | TSEL(4, Wdn));
#undef TSEL
    const int K = (mid == 4) ? DFF : DM, N = (mid == 0) ? NIN : ((mid == 2 || mid == 3) ? DFF : DM);
    const bool gu = (mid == 2 || mid == 3); const int dadd = (mid == 3) ? 128 : 0; int nb;
    nb = N / 64; const int kb = r / nb, n0 = (r % nb) * 64, k0 = kb * 64;
    const int drow0 = gu ? ((n0 >> 7) * 256 + (n0 & 127) + dadd) : n0;
    tN = N; tK = K;
    tsrc = W + (size_t)(k0 + (lane >> 4)) * N + n0 + (lane & 15) * 4;
    tdst = WT + (size_t)(drow0 + (lane >> 3)) * K + k0 + 8 * (lane & 7);
}
constexpr int TR_IN = (DM / 64) * (NIN / 64);
constexpr int TR_ALL = (DM / 64) * (NIN / 64) + (DM / 64) * (DM / 64) + 2 * (DM / 64) * (DFF / 64) + (DFF / 64) * (DM / 64);
__device__ __forceinline__ void transpose_items_ex(const Params& p, LAS unsigned char* lds, const int first, const int NGW, const int it1, const int wave_s) {
    const int lane = fresh_tid(wave_s) & 63, wave = wave_s;
    LAS float* scr = (LAS float*)(lds + wave * TSCR);
    const int NITEMS = it1;
    {
        int it = first;
        f32x4 cur[16];
        const float* csrc; bf16* cdst; int cN, cK;
        titem_decode(p, it < NITEMS ? it : 0, lane, csrc, cdst, cN, cK);
        if (it < NITEMS) {
#pragma unroll
            for (int i = 0; i < 16; ++i) cur[i] = __builtin_nontemporal_load((const f32x4*)(csrc + (size_t)(4 * i) * cN));
        }
        while (it < NITEMS) {
            const int itn = it + NGW; const bool hn = itn < NITEMS;
            const float* nsrc; bf16* ndst; int nN, nK;
            titem_decode(p, hn ? itn : it, lane, nsrc, ndst, nN, nK);
            f32x4 nxt[16];
            if (hn) {
#pragma unroll
                for (int i = 0; i < 16; ++i) nxt[i] = __builtin_nontemporal_load((const f32x4*)(nsrc + (size_t)(4 * i) * nN));
            }
            const int lr = lane >> 4, lc = (lane & 15) * 4;
#pragma unroll
            for (int i = 0; i < 16; ++i) { LAS float* d = scr + (4 * i + lr) * 65 + lc; d[0] = cur[i][0]; d[1] = cur[i][1]; d[2] = cur[i][2]; d[3] = cur[i][3]; }
            asm volatile("s_waitcnt lgkmcnt(0)" ::: "memory");
            const int c = lane & 7;
#pragma unroll
            for (int j = 0; j < 8; ++j) { const LAS float* q = scr + (8 * c) * 65 + (lane >> 3) + 8 * j;
                v4u o; o.x = pk2(q[0 * 65], q[1 * 65]); o.y = pk2(q[2 * 65], q[3 * 65]); o.z = pk2(q[4 * 65], q[5 * 65]); o.w = pk2(q[6 * 65], q[7 * 65]);
                *(v4u*)(cdst + (size_t)(8 * j) * cK) = o; }
            asm volatile("s_waitcnt lgkmcnt(0)" ::: "memory");
            if (hn) {
#pragma unroll
                for (int i = 0; i < 16; ++i) cur[i] = nxt[i];
            }
            csrc = nsrc; cdst = ndst; cN = nN; cK = nK; it = itn;
        }
    }
}

__device__ __forceinline__ void transpose_items(const Params& p, LAS unsigned char* lds, const int it0, const int it1, const int vcu, const int G, const int wave_s) {
    transpose_items_ex(p, lds, it0 + vcu * NWAVES + wave_s, G * NWAVES, it1, wave_s);
}
__device__ __forceinline__ void phase_prep(const Params& p, LAS unsigned char* lds, int vcu, int G, const int wave_s) {
    const int tid = fresh_tid(wave_s), lane = tid & 63, wave = wave_s;
    LAS float* scr = (LAS float*)(lds + wave * TSCR);
    const int gw = vcu * NWAVES + wave, NGW = G * NWAVES;
    unsigned char* ws = p.ws;
    bf16* Win = (bf16*)(ws + WS_WIN); bf16* Wout = (bf16*)(ws + WS_WOUT); bf16* Wgu = (bf16*)(ws + WS_WGU); bf16* Wdn = (bf16*)(ws + WS_WDN);
    for (int cb = vcu; cb < NMOD / 64; cb += G) {
        float* mod = (float*)(ws + WS_MOD);
        const int kbase = 256 * wave, col = cb * 64 + lane;
#pragma unroll
        for (int b = 0; b < 8; ++b) { f32x4 cv = *(const f32x4*)(p.c + b * DM + kbase + lane * 4);
#pragma unroll
            for (int j = 0; j < 4; ++j) cv[j] = cv[j] / (1.0f + __expf(-cv[j]));
            *(LAS f32x4*)(scr + b * 256 + lane * 4) = cv; }
        asm volatile("s_waitcnt lgkmcnt(0)" ::: "memory");
        float a[8];
#pragma unroll
        for (int b = 0; b < 8; ++b) a[b] = 0.f;
        const float* wp = p.w_ada + (size_t)kbase * NMOD + col;
#pragma unroll 4
        for (int k4 = 0; k4 < 64; ++k4) {
            float wv[4];
#pragma unroll
            for (int i = 0; i < 4; ++i) wv[i] = __builtin_nontemporal_load(wp + (size_t)(4 * k4 + i) * NMOD);
#pragma unroll
            for (int b = 0; b < 8; ++b) { const f32x4 sv = *(const LAS f32x4*)(scr + b * 256 + 4 * k4); a[b] += (wv[0] * sv[0] + wv[1] * sv[1]) + (wv[2] * sv[2] + wv[3] * sv[3]); }
        }
        __syncthreads();
        LAS float* red = (LAS float*)lds;
#pragma unroll
        for (int b = 0; b < 8; ++b) red[(wave * 8 + b) * 64 + lane] = a[b];
        __syncthreads();
        { const int b = tid >> 6; float sacc = p.b_ada[col];
#pragma unroll
          for (int w2 = 0; w2 < 8; ++w2) sacc += red[(w2 * 8 + b) * 64 + lane];
          mod[(size_t)b * NMOD + col] = sacc; }
        asm volatile("s_waitcnt vmcnt(0)" ::: "memory");
        __syncthreads();
        if (tid == 0) { __builtin_amdgcn_fence(__ATOMIC_RELEASE, "agent"); __hip_atomic_fetch_add((unsigned*)(ws + WS_MODCNT), 1u, __ATOMIC_RELAXED, __HIP_MEMORY_SCOPE_AGENT); }
    }
    if (G == 256) {
        constexpr int NMB = NMOD / 64, MODW = NMB * NWAVES, SPLIT = MODW / 2;
        if (vcu < NMB) { const int m = vcu * NWAVES + wave_s; transpose_items_ex(p, lds, m, TR_IN  , m < SPLIT ? SPLIT : 0, wave_s); }
        else transpose_items_ex(p, lds, SPLIT + (vcu - NMB) * NWAVES + wave_s, (256 - NMB) * NWAVES, TR_IN, wave_s);
    } else transpose_items(p, lds, 0, TR_IN, vcu, G, wave_s);
}

template <int MODE>
__device__ __forceinline__ void phase_norm_mod(const Params& p, const void* srcv, const float* ssp, const float* ng, int shift_chunk, bf16* dst, int vcu, int G, const int wave_s) {
    const int tid = fresh_tid(wave_s), lane = tid & 63, wave = wave_s;
    const int gw = vcu * NWAVES + wave, NGW = G * NWAVES;
    const float* mod = (const float*)(p.ws + WS_MOD);
    for (int rb = gw; rb < T / 8; rb += NGW) {
        const int b = (rb * 8) / SEQ;
        f32x4 A[8], B[8];
#pragma unroll
        for (int j = 0; j < 8; ++j) { const int cidx = lane * 4 + 256 * j;
            const f32x4 g = *(const f32x4*)(ng + cidx);
            const f32x4 sh = *(const f32x4*)(mod + (size_t)b * NMOD + shift_chunk * DM + cidx);
            const f32x4 sc = *(const f32x4*)(mod + (size_t)b * NMOD + (shift_chunk + 1) * DM + cidx);
            A[j] = g * (sc + 1.0f); B[j] = sh; }
        for (int rr = 0; rr < 8; ++rr) {
            const int row = rb * 8 + rr;
            f32x4 v[8]; float s = 0.f;
            if (MODE == 0) { const f32x4* xr = (const f32x4*)((const float*)srcv + (size_t)row * DM) + lane;
#pragma unroll
                for (int j = 0; j < 8; ++j) { v[j] = __builtin_nontemporal_load(xr + 64 * j); s += (v[j][0] * v[j][0] + v[j][1] * v[j][1]) + (v[j][2] * v[j][2] + v[j][3] * v[j][3]); } }
            else { const v2u* xr = (const v2u*)((const bf16*)srcv + (size_t)row * DM) + lane;
#pragma unroll
                for (int j = 0; j < 8; ++j) { const v2u raw = xr[64 * j]; v[j] = (f32x4){bflo(raw.x), bfhi(raw.x), bflo(raw.y), bfhi(raw.y)}; } }
            float tot;
            if (MODE == 0) tot = wave_sum(s);
            else { float q = (lane < 32) ? ssp[(size_t)row * 32 + lane] : 0.f; tot = wave_sum(q); }
            const float rstd = 1.0f / sqrtf(tot * (1.0f / DM) + EPS);
            v2u* o8 = (v2u*)(dst + (size_t)row * DM) + lane;
#pragma unroll
            for (int j = 0; j < 8; ++j) { const f32x4 h = (v[j] * rstd) * A[j] + B[j]; v2u w; w.x = pk2(h[0], h[1]); w.y = pk2(h[2], h[3]); o8[64 * j] = w; }
        }
    }
}

__device__ __forceinline__ void phase_final(const Params& p, const float* ssp, int vcu, int G, const int wave_s) {
    const int tid = fresh_tid(wave_s), lane = tid & 63, wave = wave_s;
    const int gw = vcu * NWAVES + wave, NGW = G * NWAVES;
    f32x4 g[8];
#pragma unroll
    for (int j = 0; j < 8; ++j) g[j] = *(const f32x4*)(p.final_g + lane * 4 + 256 * j);
    for (int row = gw; row < T; row += NGW) {
        f32x4* xr = (f32x4*)(p.out + (size_t)row * DM) + lane;
        const v2u* xs = (const v2u*)((const bf16*)(p.ws + WS_X1) + (size_t)row * DM) + lane;
        f32x4 v[8];
#pragma unroll
        for (int j = 0; j < 8; ++j) { const v2u raw = xs[64 * j]; v[j] = (f32x4){bflo(raw.x), bfhi(raw.x), bflo(raw.y), bfhi(raw.y)}; }
        float q = (lane < 32) ? ssp[(size_t)row * 32 + lane] : 0.f; const float tot = wave_sum(q);
        const float rstd = 1.0f / sqrtf(tot * (1.0f / DM) + EPS);
#pragma unroll
        for (int j = 0; j < 8; ++j) xr[64 * j] = (v[j] * rstd) * g[j];
    }
}

constexpr int TP = 136;
__device__ __forceinline__ void gmlp_tile(const Params& p, LAS unsigned char* lds, int b, int n, int g, const int wave_s) {
    const int tid = fresh_tid(wave_s), lane = tid & 63, w = wave_s, r = lane & 15, cgp = lane >> 4;
    const bf16* PROJ = (const bf16*)(p.ws + WS_PROJ); bf16* O = (bf16*)(p.ws + WS_O);
    LAS bf16* Vt = (LAS bf16*)lds;
    const int tok0 = b * SEQ + n * 128;
    const int t = 16 * w + r;
    const float bsv = p.b_spatial[g * 128 + t];
    const bf16* urow = PROJ + (size_t)(tok0 + t) * NPROJ + g * 128 + cgp * 4;
    v2u uwv[8]; f32x4 ogv[8];
#pragma unroll
    for (int nd = 0; nd < 8; ++nd) { uwv[nd] = *(const v2u*)(urow + nd * 16); ogv[nd] = *(const f32x4*)(p.out_norm_g + g * 128 + nd * 16 + cgp * 4); }
    const float* wrow = p.w_spatial + (size_t)(g * 128 + t) * 128;
    f32x4 wq[4][2];
#pragma unroll
    for (int kk = 0; kk < 4; ++kk) { if (kk <= (w >> 1)) { wq[kk][0] = *(const f32x4*)(wrow + kk * 32 + cgp * 8); wq[kk][1] = *(const f32x4*)(wrow + kk * 32 + cgp * 8 + 4); } else { wq[kk][0] = (f32x4){0.f, 0.f, 0.f, 0.f}; wq[kk][1] = (f32x4){0.f, 0.f, 0.f, 0.f}; } }
    {
        const int s = 16 * w + r;
        const bf16* src = PROJ + (size_t)(tok0 + s) * NPROJ + 1024 + g * 128;
        float xv[4][8]; float s1 = 0.f;
#pragma unroll
        for (int pp = 0; pp < 4; ++pp) { const v4u raw = *(const v4u*)(src + (cgp * 4 + pp) * 8);
            xv[pp][0] = bflo(raw.x); xv[pp][1] = bfhi(raw.x); xv[pp][2] = bflo(raw.y); xv[pp][3] = bfhi(raw.y); xv[pp][4] = bflo(raw.z); xv[pp][5] = bfhi(raw.z); xv[pp][6] = bflo(raw.w); xv[pp][7] = bfhi(raw.w);
#pragma unroll
            for (int j = 0; j < 8; ++j) s1 += xv[pp][j]; }
        s1 += __shfl_xor(s1, 16); s1 += __shfl_xor(s1, 32);
        const float mean = s1 * (1.0f / 128.0f); float s2 = 0.f;
#pragma unroll
        for (int pp = 0; pp < 4; ++pp)
#pragma unroll
            for (int j = 0; j < 8; ++j) { xv[pp][j] -= mean; s2 += xv[pp][j] * xv[pp][j]; }
        s2 += __shfl_xor(s2, 16); s2 += __shfl_xor(s2, 32);
        const float rstd = 1.0f / sqrtf(s2 * (1.0f / 128.0f) + EPS);
#pragma unroll
        for (int pp = 0; pp < 4; ++pp) { const int d0 = (cgp * 4 + pp) * 8;
            const f32x4 g0 = *(const f32x4*)(p.v_norm_g + g * 128 + d0), g1 = *(const f32x4*)(p.v_norm_g + g * 128 + d0 + 4);
#pragma unroll
            for (int j = 0; j < 8; ++j) { const float y = xv[pp][j] * rstd * (j < 4 ? g0[j & 3] : g1[j & 3]); Vt[(d0 + j) * TP + s] = (bf16)(pk2(y, 0.f) & 0xffffu); } }
    }
    __syncthreads();
    f32x4 acc[8];
#pragma unroll
    for (int nd = 0; nd < 8; ++nd) acc[nd] = (f32x4){0.f, 0.f, 0.f, 0.f};
#pragma unroll
    for (int kk = 0; kk < 4; ++kk) {
        if (kk > (w >> 1)) break;
        const int s0 = kk * 32 + cgp * 8;
        const f32x4 w0 = wq[kk][0], w1 = wq[kk][1];
        float wv[8] = {w0[0], w0[1], w0[2], w0[3], w1[0], w1[1], w1[2], w1[3]};
#pragma unroll
        for (int j = 0; j < 8; ++j) wv[j] = (s0 + j <= t) ? wv[j] : 0.f;
        v4u wp; wp.x = pk2(wv[0], wv[1]); wp.y = pk2(wv[2], wv[3]); wp.z = pk2(wv[4], wv[5]); wp.w = pk2(wv[6], wv[7]);
        const bf16x8 wf = __builtin_bit_cast(bf16x8, wp);
#pragma unroll
        for (int nd = 0; nd < 8; ++nd) { const bf16x8 vf = *(const LAS bf16x8*)(Vt + (nd * 16 + r) * TP + s0);
            acc[nd] = __builtin_amdgcn_mfma_f32_16x16x32_bf16(vf, wf, acc[nd], 0, 0, 0); }
    }
    float ss = 0.f;
#pragma unroll
    for (int nd = 0; nd < 8; ++nd) { const v2u uw = uwv[nd];
        f32x4 o; o[0] = bflo(uw.x) * (acc[nd][0] + bsv); o[1] = bfhi(uw.x) * (acc[nd][1] + bsv); o[2] = bflo(uw.y) * (acc[nd][2] + bsv); o[3] = bfhi(uw.y) * (acc[nd][3] + bsv);
        acc[nd] = o; ss += (o[0] * o[0] + o[1] * o[1]) + (o[2] * o[2] + o[3] * o[3]); }
    ss += __shfl_xor(ss, 16); ss += __shfl_xor(ss, 32);
    const float rs = 1.0f / sqrtf(ss * (1.0f / 128.0f) + EPS);
    bf16* orow = O + (size_t)(tok0 + t) * DM + g * 128 + cgp * 4;
#pragma unroll
    for (int nd = 0; nd < 8; ++nd) { const f32x4 og = ogv[nd];
        v2u wv2; wv2.x = pk2(acc[nd][0] * rs * og[0], acc[nd][1] * rs * og[1]); wv2.y = pk2(acc[nd][2] * rs * og[2], acc[nd][3] * rs * og[3]);
        *(v2u*)(orow + nd * 16) = wv2; }
    __syncthreads();
}

typedef float f32x16 __attribute__((ext_vector_type(16)));
constexpr int TPK = 136, TPV = 132;
template <bool DIAG>
__device__ __forceinline__ void sb_tile(f32x16& z, float& run, int r, int hi) {
    float be[16], om[16];
#pragma unroll
    for (int i = 0; i < 16; ++i) { const float e = __builtin_amdgcn_exp2f(-z[i]);
        be[i] = __builtin_amdgcn_rcpf(1.0f + e); om[i] = 1.0f - be[i];
        if (DIAG) { const bool valid = (8 * (i >> 2) + 4 * hi + (i & 3)) < r; be[i] = valid ? be[i] : 0.f; om[i] = valid ? om[i] : 1.0f; } }
    float P[4], xo[4], Tt[4];
#pragma unroll
    for (int g = 0; g < 4; ++g) P[g] = (om[4 * g] * om[4 * g + 1]) * (om[4 * g + 2] * om[4 * g + 3]);
#pragma unroll
    for (int g = 0; g < 4; ++g) { const unsigned u = __float_as_uint(P[g]); const auto sw = __builtin_amdgcn_permlane32_swap(u, u, false, false);
        xo[g] = __uint_as_float(sw[1]); Tt[g] = __uint_as_float(sw[0]) * __uint_as_float(sw[1]); }
#pragma unroll
    for (int g = 3; g >= 0; --g) {
        float tl = run * (hi ? 1.0f : xo[g]); run *= Tt[g];
        z[4 * g + 3] = be[4 * g + 3] * tl; tl *= om[4 * g + 3];
        z[4 * g + 2] = be[4 * g + 2] * tl; tl *= om[4 * g + 2];
        z[4 * g + 1] = be[4 * g + 1] * tl; tl *= om[4 * g + 1];
        z[4 * g + 0] = be[4 * g + 0] * tl;
    }
}
__device__ __forceinline__ void sb_unit(const Params& p, LAS unsigned char* lds, int b, int h, int qb, const int wave_s) {
    const int tid = fresh_tid(wave_s), lane = tid & 63, w = wave_s, r = lane & 31, hi = lane >> 5;
    const bf16* PROJ = (const bf16*)(p.ws + WS_PROJ); const bf16* VT = (const bf16*)(p.ws + WS_VT); bf16* O = (bf16*)(p.ws + WS_O);
    LAS bf16* Ks = (LAS bf16*)lds;
    LAS bf16* Vs = (LAS bf16*)(lds + 2 * 128 * TPK * 2);
    const int tok0 = b * SEQ;
    const int qt = 8 * qb + w;
    bf16x8 qf[8];
    { const bf16* qrow = PROJ + (size_t)(tok0 + 32 * qt + r) * NPROJ + 2048 + h * 128 + 8 * hi;
#pragma unroll
      for (int st = 0; st < 8; ++st) qf[st] = *(const bf16x8*)(qrow + 16 * st);
#pragma unroll
      for (int st = 0; st < 8; ++st) asm volatile("" : "+v"(qf[st])); }
    const bf16* kbase = PROJ + (size_t)tok0 * NPROJ + 3072 + h * 128;
    const bf16* vbase = VT + (size_t)(h * 128) * T + tok0;
    v4u kr[4], vr[4];
#define SB_LOAD(jb) do { _Pragma("unroll") for (int pp = 0; pp < 4; ++pp) { const int c = tid + 512 * pp, rw = c >> 4, pc = c & 15; \
        kr[pp] = *(const v4u*)(kbase + (size_t)((jb) * 128 + rw) * NPROJ + pc * 8); vr[pp] = *(const v4u*)(vbase + (size_t)rw * T + (jb) * 128 + pc * 8); } } while (0)
#define SB_STORE(buf) do { _Pragma("unroll") for (int pp = 0; pp < 4; ++pp) { const int c = tid + 512 * pp, rw = c >> 4, pc = c & 15; \
        *(LAS v4u*)(Ks + ((buf) * 128 + rw) * TPK + pc * 8) = kr[pp]; \
        LAS v2u* vd = (LAS v2u*)(Vs + ((buf) * 128 + rw) * TPV + pc * 8); v2u lo2, hi2; lo2.x = vr[pp].x; lo2.y = vr[pp].y; hi2.x = vr[pp].z; hi2.y = vr[pp].w; vd[0] = lo2; vd[1] = hi2; } } while (0)
    f32x16 oacc[4];
#pragma unroll
    for (int dt = 0; dt < 4; ++dt)
#pragma unroll
        for (int i = 0; i < 16; ++i) oacc[dt][i] = 0.f;
    float run = 1.0f;
    const int jtop = 2 * qb + 1;
    SB_LOAD(jtop); SB_STORE(0);
    __syncthreads();
    for (int jb = jtop; jb >= 0; --jb) {
        const int cur = (jtop - jb) & 1;
        if (jb > 0) SB_LOAD(jb - 1);
#pragma unroll 1
        for (int c = 3; c >= 0; --c) {
            const int kt = 4 * jb + c;
            if (kt > qt) continue;
            const bool diag = (kt == qt);
            const LAS bf16* kp = Ks + (cur * 128 + 32 * c + r) * TPK + 8 * hi;
            bf16x8 kf[8];
#pragma unroll
            for (int st = 0; st < 8; ++st) kf[st] = *(const LAS bf16x8*)(kp + 16 * st);
            __builtin_amdgcn_sched_barrier(0);
            f32x16 z;
#pragma unroll
            for (int i = 0; i < 16; ++i) z[i] = 0.f;
#pragma unroll
            for (int st = 0; st < 8; ++st) z = __builtin_amdgcn_mfma_f32_32x32x16_bf16(kf[st], qf[st], z, 0, 0, 0);
            __builtin_amdgcn_sched_barrier(0);
            v2u vlo[2][4], vhh[2][4];
#pragma unroll
            for (int s2 = 0; s2 < 2; ++s2)
#pragma unroll
                for (int dt = 0; dt < 4; ++dt) { const LAS bf16* vp = Vs + (cur * 128 + 32 * dt + r) * TPV + 32 * c + 16 * s2 + 4 * hi;
                    vlo[s2][dt] = *(const LAS v2u*)vp; vhh[s2][dt] = *(const LAS v2u*)(vp + 8); }
            __builtin_amdgcn_sched_barrier(0);
            if (diag) sb_tile<true>(z, run, r, hi); else sb_tile<false>(z, run, r, hi);
            __builtin_amdgcn_sched_barrier(0);
#pragma unroll
            for (int s2 = 0; s2 < 2; ++s2) {
                v4u pw; pw.x = pk2(z[8 * s2 + 0], z[8 * s2 + 1]); pw.y = pk2(z[8 * s2 + 2], z[8 * s2 + 3]); pw.z = pk2(z[8 * s2 + 4], z[8 * s2 + 5]); pw.w = pk2(z[8 * s2 + 6], z[8 * s2 + 7]);
                const bf16x8 pf = __builtin_bit_cast(bf16x8, pw);
#pragma unroll
                for (int dt = 0; dt < 4; ++dt) { v4u vw; vw.x = vlo[s2][dt].x; vw.y = vlo[s2][dt].y; vw.z = vhh[s2][dt].x; vw.w = vhh[s2][dt].y;
                    oacc[dt] = __builtin_amdgcn_mfma_f32_32x32x16_bf16(__builtin_bit_cast(bf16x8, vw), pf, oacc[dt], 0, 0, 0); }
            }
        }
        if (jb > 0) SB_STORE(cur ^ 1);
        __syncthreads();
    }
#undef SB_LOAD
#undef SB_STORE
    float ss = 0.f;
#pragma unroll
    for (int dt = 0; dt < 4; ++dt)
#pragma unroll
        for (int i = 0; i < 16; ++i) ss += oacc[dt][i] * oacc[dt][i];
    ss += __shfl_xor(ss, 32);
    const float rs = 1.0f / sqrtf(ss * (1.0f / 128.0f) + EPS);
    bf16* orow = O + (size_t)(tok0 + 32 * qt + r) * DM + 1024 + h * 128 + 4 * hi;
    const float* ogp = p.out_norm_g + 1024 + h * 128 + 4 * hi;
    f32x4 ogv[4][4];
#pragma unroll
    for (int dt = 0; dt < 4; ++dt)
#pragma unroll
        for (int g = 0; g < 4; ++g) ogv[dt][g] = *(const f32x4*)(ogp + 32 * dt + 8 * g);
#pragma unroll
    for (int dt = 0; dt < 4; ++dt)
#pragma unroll
        for (int g = 0; g < 4; ++g) { const f32x4 og = ogv[dt][g];
            v2u wv2; wv2.x = pk2(oacc[dt][4 * g + 0] * rs * og[0], oacc[dt][4 * g + 1] * rs * og[1]); wv2.y = pk2(oacc[dt][4 * g + 2] * rs * og[2], oacc[dt][4 * g + 3] * rs * og[3]);
            *(v2u*)(orow + 32 * dt + 8 * g) = wv2; }
}

template <int HALF_ID>
__device__ __forceinline__ void mixers_half(const Params& p, LAS unsigned char* lds, int vcu, int G, const int wave_s) {
    if ((HALF_ID ^ (vcu & 1)) == 0) {
        for (int pr = vcu; pr < 256; pr += G) {
            const int bh = pr >> 2, ip = pr & 3, b = bh >> 3, h = bh & 7;
            sb_unit(p, lds, b, h, 7 - ip, wave_s);
            sb_unit(p, lds, b, h, ip, wave_s);
        }
    } else {
        for (int tl = vcu; tl < 1024; tl += G) { const int g = tl & 7, n = (tl >> 3) & 15, b = tl >> 7; gmlp_tile(p, lds, b, n, g, wave_s); }
    }
}
__device__ __forceinline__ void phase_mixers(const Params& p, LAS unsigned char* lds, int vcu, int G, const int wave_s) {
    mixers_half<0>(p, lds, vcu, G, wave_s);
    transpose_items(p, lds, TR_IN, TR_ALL, vcu, G, wave_s);
    __syncthreads();
    mixers_half<1>(p, lds, vcu, G, wave_s);
}

#define XB_TMO      128
#define XB_XCNT(j)  (256  + 64 * (j))
#define XB_XSUB(j)  (1280 + 64 * (j))
#define XB_XGEN(j)  (2304 + 64 * (j))
#define XB_TOP      3328
#define XB_TOPGEN   3392
#define XCD_BAR_WORDS 3456
#define XB_SPIN_CAP (1u << 18)

__device__ __forceinline__ unsigned xb_ld(unsigned* p)              { return __hip_atomic_load(p, __ATOMIC_RELAXED, __HIP_MEMORY_SCOPE_AGENT); }
__device__ __forceinline__ unsigned xb_add(unsigned* p, unsigned v) { return __hip_atomic_fetch_add(p, v, __ATOMIC_RELAXED, __HIP_MEMORY_SCOPE_AGENT); }
__device__ __forceinline__ unsigned xb_xcc_id() { return (unsigned)__builtin_amdgcn_s_getreg((3 << 11) | 20) & 0xFu; }
#define XB_SPIN(cond, bar) do { unsigned _sp = 0; while (cond) { __builtin_amdgcn_s_sleep(1); \
    if ((++_sp & 255u) == 0u) { if (xb_ld(&(bar)[XB_TMO])) break; if (_sp > XB_SPIN_CAP) { atomicAdd(&(bar)[XB_TMO], 1u); break; } } } } while (0)

struct XcdBarrier {
    unsigned* bar; unsigned x; int w;
    volatile LAS unsigned* st;
};

__device__ __forceinline__ XcdBarrier xcd_barrier_post(unsigned* bar, volatile LAS unsigned* st, int wave_s) {
    XcdBarrier b; b.bar = bar; b.x = xb_xcc_id(); b.st = st; b.w = wave_s;
    if (wave_s == 0 && lane_id() == 0) (void)xb_add(&bar[XB_XCNT(b.x)], 1u);
    return b;
}
__device__ __forceinline__ void xcd_barrier_complete(unsigned* bar, unsigned x, unsigned& nloc, unsigned& nx) {
    const unsigned G = gridDim.x * gridDim.y * gridDim.z;
    unsigned sum, cnt, mine, sp = 0u;
    for (;;) {
        sum = 0u; cnt = 0u; mine = 0u;
#pragma unroll
        for (unsigned j = 0; j < 16; ++j) { const unsigned c = xb_ld(&bar[XB_XCNT(j)]); sum += c; cnt += (c > 0u) ? 1u : 0u; mine = (j == x) ? c : mine; }
        if (sum == G) break;
        __builtin_amdgcn_s_sleep(1);
        if ((++sp & 255u) == 0u) { if (xb_ld(&bar[XB_TMO])) break; if (sp > XB_SPIN_CAP) { atomicAdd(&bar[XB_TMO], 1u); break; } }
    }
    nloc = mine > 0u ? mine : 1u; nx = cnt > 0u ? cnt : 1u;
}

__device__ __forceinline__ void xcd_barrier(const XcdBarrier& b) {
    asm volatile("s_waitcnt vmcnt(0)" ::: "memory");
    __syncthreads();
    if (b.w == 0 && lane_id() == 0) {
        unsigned* bar = b.bar;
        __builtin_amdgcn_s_waitcnt(0);
        unsigned nloc = b.st[0], nx = b.st[1];
        if (nloc == 0u) { xcd_barrier_complete(bar, b.x, nloc, nx); b.st[0] = nloc; b.st[1] = nx; }
        const unsigned old = xb_add(&bar[XB_XSUB(b.x)], 1u);
        const unsigned gen = old / nloc;
        if (old + 1u == (gen + 1u) * nloc) {
            __builtin_amdgcn_fence(__ATOMIC_RELEASE, "agent");
            asm volatile("s_waitcnt vmcnt(0)" ::: "memory");
            const unsigned og = xb_add(&bar[XB_TOP], 1u);
            const unsigned tg = og / nx;
            if (og + 1u == (tg + 1u) * nx) xb_add(&bar[XB_TOPGEN], 1u);
            else XB_SPIN(xb_ld(&bar[XB_TOPGEN]) == tg, bar);
            __builtin_amdgcn_fence(__ATOMIC_ACQUIRE, "agent");
            xb_add(&bar[XB_XGEN(b.x)], 1u);
            asm volatile("s_waitcnt vmcnt(0)" ::: "memory");
        } else {
            XB_SPIN(xb_ld(&bar[XB_XGEN(b.x)]) == gen, bar);
            __builtin_amdgcn_fence(__ATOMIC_ACQUIRE, "agent");
            asm volatile("s_waitcnt vmcnt(0)" ::: "memory");
        }
    }
    __syncthreads();
}

#ifndef PH_MASK
#define PH_MASK 0x3ff
#endif
#define PH(k) if constexpr ((PH_MASK >> (k)) & 1)
#ifndef DUP_MASK
#define DUP_MASK 0
#endif
#define DUP(k) _Pragma("unroll 1") for (int _r = 0; _r < ((((DUP_MASK) >> (k)) & 1) ? 2 : 1); ++_r)
__global__ void __launch_bounds__(NTHREADS, 2) fwd_megakernel(Params p) {
    extern __shared__ __attribute__((aligned(16))) unsigned char lds_raw[];
    LAS unsigned char* lds = (LAS unsigned char*)lds_raw;
    cg::grid_group grid = cg::this_grid();
    if (p.ws == nullptr) grid.sync();
    volatile LAS unsigned* bst = (volatile LAS unsigned*)(lds + LDS_BYTES - 64);
    const int wave_s = __builtin_amdgcn_readfirstlane((int)(threadIdx.x >> 6));
    if (wave_s == 0 && lane_id() == 0) { bst[0] = 0u; bst[1] = 0u; }
    __syncthreads();
    const XcdBarrier bar = xcd_barrier_post((unsigned*)(p.ws + WS_BAR), bst, wave_s);
    const int G = gridDim.x, bx = blockIdx.x;
    const int vcu = (G % 8 == 0) ? (bx % 8) * (G / 8) + bx / 8 : bx;
    unsigned char* ws = p.ws;
    bf16* Win = (bf16*)(ws + WS_WIN); bf16* Wout = (bf16*)(ws + WS_WOUT); bf16* Wgu = (bf16*)(ws + WS_WGU); bf16* Wdn = (bf16*)(ws + WS_WDN);
    bf16* H = (bf16*)(ws + WS_H); bf16* PROJ = (bf16*)(ws + WS_PROJ); bf16* VT = (bf16*)(ws + WS_VT); bf16* O = (bf16*)(ws + WS_O); bf16* GU = (bf16*)(ws + WS_GU); bf16* X1 = (bf16*)(ws + WS_X1);
    float* mod = (float*)(ws + WS_MOD); float* SS1 = (float*)(ws + WS_SS1); float* SS2 = (float*)(ws + WS_SS2);

#if TS_SEL >= 0
    unsigned long long* tsb = (unsigned long long*)(ws + 49152 + 1024);
#define STAMP(k) do { if (bx == 0 && wave_s == 0 && lane_id() == 0) __hip_atomic_store(tsb + (k), (unsigned long long)__builtin_amdgcn_s_memrealtime(), __ATOMIC_RELAXED, __HIP_MEMORY_SCOPE_AGENT); } while (0)
#else
#define STAMP(k) do { } while (0)
#endif
    STAMP(0);
    PH(0) DUP(0) phase_prep(p, lds, vcu, G, wave_s);
    { if (wave_s == 0) { unsigned sp = 0;
          while ((unsigned)__builtin_amdgcn_readfirstlane(__hip_atomic_load((unsigned*)(ws + WS_MODCNT), __ATOMIC_RELAXED, __HIP_MEMORY_SCOPE_AGENT)) < (unsigned)(NMOD / 64)) { __builtin_amdgcn_s_sleep(2); if (++sp > (1u << 22)) break; }
          __builtin_amdgcn_fence(__ATOMIC_ACQUIRE, "agent"); asm volatile("s_waitcnt vmcnt(0)" ::: "memory"); }
      __syncthreads(); }
    STAMP(1);
    PH(1) DUP(1) phase_norm_mod<0>(p, p.x, nullptr, p.norm1_g, 0, H, vcu, G, wave_s);
    xcd_barrier(bar); STAMP(2);
    PH(2) DUP(2) {
        pg8::Gemm g{H, Win, T, NPROJ, DM}; pg8::StaticOrder S; S.init(T, NPROJ, G, bx);
        pg8::EpiProj E{PROJ, NPROJ, 8, 8, 12, QSCALE};
        pg8::gemm_phase<pg8::EpiProj, pg8::StaticOrder, true, true>(lds, g, S, E, wave_s);
    }
    PH(9) DUP(2) {
        pg8::Gemm g{Win + (size_t)NPROJ * DM, H, 1024, T, DM}; pg8::StaticOrder S; S.init(1024, T, G, bx);
        pg8::EpiProj E{VT, T, 0, 0, 0, 1.f};
        pg8::gemm_phase<pg8::EpiProj, pg8::StaticOrder, true, true>(lds, g, S, E, wave_s);
    }
    xcd_barrier(bar); STAMP(3);
    PH(3) DUP(3) phase_mixers(p, lds, vcu, G, wave_s);
    xcd_barrier(bar); STAMP(4);
    PH(4) DUP(4) {
        pg8::Gemm g{O, Wout, T, DM, DM}; pg8::PanelOrder S; S.init(T, DM, G, bx);
        pg8::EpiResNorm<0> E{p.x, X1, mod + 2 * DM, SS1, (unsigned*)(ws + WS_CNT1), H, p.norm2_g, mod, 3, nullptr, nullptr, lds + 131072};
        pg8::gemm_phase<pg8::EpiResNorm<0>, pg8::PanelOrder, true, true>(lds, g, S, E, wave_s);
    }
    xcd_barrier(bar); STAMP(5);
    PH(6) DUP(6) {
        pg8::Gemm g{H, Wgu, T, 2 * DFF, DM}; pg8::StaticOrder S; S.init(T, 2 * DFF, G, bx);
        pg8::EpiGU E{GU, DFF};
        pg8::gemm_phase<pg8::EpiGU, pg8::StaticOrder, true, true>(lds, g, S, E, wave_s);
    }
    xcd_barrier(bar); STAMP(6);
    PH(7) {
        pg8::Gemm g{GU, Wdn, T, DM, DFF}; pg8::PanelOrder S; S.init(T, DM, G, bx);
        pg8::EpiResNorm<1> E{X1, X1, mod + 5 * DM, SS2, (unsigned*)(ws + WS_CNT2), nullptr, nullptr, nullptr, 0, p.out, p.final_g, lds + 131072};
        pg8::gemm_phase<pg8::EpiResNorm<1>, pg8::PanelOrder, true, true>(lds, g, S, E, wave_s);
    }
#if TS_SEL >= 0
    xcd_barrier(bar); STAMP(7);
    xcd_barrier(bar);
    { const unsigned long long t0 = __hip_atomic_load(tsb + TS_SEL, __ATOMIC_RELAXED, __HIP_MEMORY_SCOPE_AGENT), t1 = __hip_atomic_load(tsb + TS_SEL + 1, __ATOMIC_RELAXED, __HIP_MEMORY_SCOPE_AGENT);
#ifdef TS_CAL
      const float pert = 1.0f + sqrtf((float)TS_CAL * 8e-7f * TS_SCALE) + 0.0f * (float)(t1 - t0);
#else
      const float pert = 1.0f + sqrtf((float)(t1 - t0) * 0.01f * 8e-7f * TS_SCALE);
#endif
      for (size_t i = (size_t)bx * NTHREADS + fresh_tid(wave_s); i < (size_t)SEQ * DM / 4; i += (size_t)G * NTHREADS) { f32x4 v = ((f32x4*)p.out)[i]; v = v * pert; ((f32x4*)p.out)[i] = v; } }
#endif
}

extern "C" void kernel_launch(void* const* d_in, const int* in_sizes, int n_in, void* d_out, int out_size, void* d_ws, size_t ws_size, hipStream_t stream) {
    static int grid_blocks = 0;
    if (grid_blocks == 0) {
        if (n_in != 16 || ws_size < WS_END) { fprintf(stderr, "kernel_launch: unexpected n_in %d / ws_size %zu (need %zu)\n", n_in, ws_size, (size_t)WS_END); grid_blocks = -1; return; }
        int dev = 0, cus = 0, per_cu = 0;
        (void)hipGetDevice(&dev);
        (void)hipDeviceGetAttribute(&cus, hipDeviceAttributeMultiprocessorCount, dev);
        if (hipFuncSetAttribute((const void*)fwd_megakernel, hipFuncAttributeMaxDynamicSharedMemorySize, LDS_BYTES) != hipSuccess) { fprintf(stderr, "kernel_launch: hipFuncSetAttribute failed\n"); grid_blocks = -1; return; }
        if (hipOccupancyMaxActiveBlocksPerMultiprocessor(&per_cu, (const void*)fwd_megakernel, NTHREADS, LDS_BYTES) != hipSuccess || per_cu < 1) { fprintf(stderr, "kernel_launch: occupancy query says %d\n", per_cu); per_cu = 1; }
        (void)hipGetLastError();
        if (cus != 256) { fprintf(stderr, "kernel_launch: built for a 256-CU device (the fused-norm epilogues need exactly 256 workgroups); found %d CUs, nothing launched\n", cus); grid_blocks = -1; return; }
        grid_blocks = cus * 1;
    }
    if (grid_blocks < 0) return;
    if (hipMemsetAsync((char*)d_ws + WS_BAR, 0, 49152, stream) != hipSuccess) { fprintf(stderr, "kernel_launch: memset failed\n"); return; }
    Params p{};
    p.x = (const float*)d_in[0]; p.c = (const float*)d_in[1]; p.w_ada = (const float*)d_in[2]; p.b_ada = (const float*)d_in[3]; p.norm1_g = (const float*)d_in[4];
    p.w_in = (const float*)d_in[5]; p.v_norm_g = (const float*)d_in[6]; p.w_spatial = (const float*)d_in[7]; p.b_spatial = (const float*)d_in[8]; p.out_norm_g = (const float*)d_in[9];
    p.w_out = (const float*)d_in[10]; p.norm2_g = (const float*)d_in[11]; p.w_gate = (const float*)d_in[12]; p.w_up = (const float*)d_in[13]; p.w_down = (const float*)d_in[14]; p.final_g = (const float*)d_in[15];
    p.out = (float*)d_out; p.ws = (unsigned char*)d_ws;
    void* args[] = {&p};
    hipError_t e = hipLaunchCooperativeKernel((const void*)fwd_megakernel, dim3(grid_blocks), dim3(NTHREADS), args, LDS_BYTES, stream);
    if (e != hipSuccess) fprintf(stderr, "cooperative launch failed: %s (grid %d)\n", hipGetErrorString(e), grid_blocks);
}
```

```cpp
#include <hip/hip_runtime.h>
#include <hip/hip_cooperative_groups.h>
#include <cstdio>
#include <cstdint>
namespace cg = cooperative_groups;
__device__ __forceinline__ int lane_id() { int l; asm volatile("v_mbcnt_lo_u32_b32 %0, -1, 0\n\tv_mbcnt_hi_u32_b32 %0, -1, %0" : "=&v"(l)); return l; }
__device__ __forceinline__ int fresh_tid(int wave_s) { int t = (wave_s << 6) | lane_id(); asm volatile("" : "+v"(t)); return t; }
#ifndef TS_SEL
#define TS_SEL -1
#endif
#ifndef TS_SCALE
#define TS_SCALE 1.0f
#endif
namespace pg8 {
#define PG8_LAS __attribute__((address_space(3)))
typedef unsigned short bf16_t;
typedef short bf16x8 __attribute__((ext_vector_type(8)));
typedef float f32x4 __attribute__((ext_vector_type(4)));
typedef unsigned u32x4 __attribute__((ext_vector_type(4)));
constexpr int BM = 256, BK = 64, HALF = 128, HTB = HALF * BK * 2  , STAGE_BYTES = 8 * HTB, NXCD = 8, WGM = 8;

__host__ __device__ __forceinline__ int lds_byte(int r, int c) { const int st = (r >> 4) * 2 + (c >> 5), rr = r & 15, cc = c & 31, ob = rr * 64 + cc * 2; return st * 1024 + (ob ^ (((ob >> 9) & 1) << 5)); }
__host__ __device__ __forceinline__ void stage_rc(int b, int& R, int& C) { const int st = b / 1024, sb = b % 1024, swz = sb ^ (((sb >> 9) & 1) << 5); R = (st >> 1) * 16 + swz / 64; C = (st & 1) * 32 + (swz % 64) / 2; }
__host__ __device__ __forceinline__ int perm32(int rho) { const int n = rho >> 4, i = rho & 15; return 8 * (i >> 2) + 4 * n + (i & 3); }

struct Unit { int pm, pn; };
struct Gemm { const bf16_t* A; const bf16_t* Bt; int M, N, K; };

struct StaticOrder {
    int nM, nN, nwg, G, c;
    __host__ __device__ void init(int M, int N, int G_, int c_) { nM = M / BM; nN = N / BM; nwg = nM * nN; G = G_; c = c_; }
    __host__ __device__ bool next(int i, Unit& u) const {
        const long L = (long)i * G + c; if (L >= nwg) return false;
        int wgid = (int)L; { const int q = nwg / NXCD, r = nwg % NXCD, xcd = wgid % NXCD, off = wgid / NXCD; wgid = (xcd < r ? xcd * (q + 1) : r * (q + 1) + (xcd - r) * q) + off; }
        const int nig = WGM * nN, gid = wgid / nig, fm = gid * WGM, gsz = (nM - fm) < WGM ? (nM - fm) : WGM;
        u.pm = fm + ((wgid % nig) % gsz); u.pn = (wgid % nig) / gsz; return true;
    }
    __device__ __forceinline__ void a_ready(const Unit&) const {}
    __device__ __forceinline__ void done(const Unit&) const {}
};

__device__ __forceinline__ unsigned cvt_pk_bf16(float lo, float hi) { unsigned r; asm("v_cvt_pk_bf16_f32 %0, %1, %2" : "=v"(r) : "v"(lo), "v"(hi)); return r; }
typedef float f32x2 __attribute__((ext_vector_type(2)));
__device__ __forceinline__ f32x2 gelu_pk(f32x2 v) {
    const f32x2 av = __builtin_elementwise_abs(v), d = av * 0.2316418882f + 1.0f;
    f32x2 t; t.x = __builtin_amdgcn_rcpf(d.x); t.y = __builtin_amdgcn_rcpf(d.y);
    f32x2 q = t * 0.5307027145f + (-0.7265760135f); q = q * t + 0.7107068705f; q = q * t + (-0.142248368f); q = q * t + 0.127414796f; q = q * t;
    const f32x2 s = (v * v) * (-0.72134752044f);
    f32x2 e; e.x = __builtin_amdgcn_exp2f(s.x); e.y = __builtin_amdgcn_exp2f(s.y);
    const f32x2 m = v * (q * e), r = v - m;
    f32x2 o; o.x = v.x < 0.f ? m.x : r.x; o.y = v.y < 0.f ? m.y : r.y; return o;
}

struct EpiProj {
    static constexpr bool PERM = true, AFTER_DRAIN = false;
    bf16_t* O; int ldc; int gelu_tiles; int sc_lo, sc_hi; float sc;
    __device__ __forceinline__ void operator()(f32x4 (&acc)[2][2][4][2], const Unit& u, int wr, int wc, int fr, int fq, bool last) const {
        const int row0 = u.pm * BM + wr * 64 + fr, col0 = u.pn * BM + wc * 32 + 8 * fq;
        const bool g = u.pn < gelu_tiles; const float s = (u.pn >= sc_lo && u.pn < sc_hi) ? sc : 1.f;
#pragma unroll
        for (int ai = 0; ai < 2; ++ai)
#pragma unroll
            for (int m = 0; m < 4; ++m) { bf16_t* rowp = O + (size_t)(row0 + ai * HALF + m * 16) * ldc + col0;
#pragma unroll
                for (int bj = 0; bj < 2; ++bj) { f32x4 v0 = acc[ai][bj][m][0], v1 = acc[ai][bj][m][1];
                    if (g) { f32x2 a = gelu_pk((f32x2){v0[0], v0[1]}), b = gelu_pk((f32x2){v0[2], v0[3]}), c = gelu_pk((f32x2){v1[0], v1[1]}), d = gelu_pk((f32x2){v1[2], v1[3]});
                        v0 = (f32x4){a.x, a.y, b.x, b.y}; v1 = (f32x4){c.x, c.y, d.x, d.y}; }
                    v0 = v0 * s; v1 = v1 * s; u32x4 w; w.x = cvt_pk_bf16(v0[0], v0[1]); w.y = cvt_pk_bf16(v0[2], v0[3]); w.z = cvt_pk_bf16(v1[0], v1[1]); w.w = cvt_pk_bf16(v1[2], v1[3]);
                    *(u32x4*)(rowp + bj * HALF) = w; } }
    }
};
template <int MODE> struct EpiResNorm {
    static constexpr bool PERM = true, AFTER_DRAIN = false;
    static constexpr int MB = 2;
    const void* base; bf16_t* xres; const float* gate; float* ssq; unsigned* cnt;
    bf16_t* H; const float* ng; const float* modp; int shift_chunk;
    float* outf; const float* fg;
    PG8_LAS unsigned char* lx;
    __device__ __forceinline__ static void unpack8(const u32x4 raw, f32x4& a, f32x4& b) {
        a = (f32x4){__uint_as_float(raw.x << 16), __uint_as_float(raw.x & 0xffff0000u), __uint_as_float(raw.y << 16), __uint_as_float(raw.y & 0xffff0000u)};
        b = (f32x4){__uint_as_float(raw.z << 16), __uint_as_float(raw.z & 0xffff0000u), __uint_as_float(raw.w << 16), __uint_as_float(raw.w & 0xffff0000u)}; }
    __device__ __forceinline__ static u32x4 pack8(const f32x4 a, const f32x4 b) { u32x4 w; w.x = cvt_pk_bf16(a[0], a[1]); w.y = cvt_pk_bf16(a[2], a[3]); w.z = cvt_pk_bf16(b[0], b[1]); w.w = cvt_pk_bf16(b[2], b[3]); return w; }
    __device__ __forceinline__ void operator()(f32x4 (&acc)[2][2][4][2], const Unit& u, int wr, int wc, int fr, int fq, bool last) const {
        const int lane = fr + 16 * fq, wid = wr * 4 + wc;
        const int rl0 = wr * 64 + fr, row0 = u.pm * BM + rl0, col0 = u.pn * BM + wc * 32 + 8 * fq;
        const int b = u.pm >> 3;
        PG8_LAS float* P = (PG8_LAS float*)lx;
        PG8_LAS float* S = (PG8_LAS float*)(lx + 4096);
        {
            f32x4 gv[2][2];
#pragma unroll
            for (int bj = 0; bj < 2; ++bj)
#pragma unroll
                for (int n = 0; n < 2; ++n) gv[bj][n] = *(const f32x4*)(gate + (size_t)b * 12288 + col0 + bj * HALF + n * 4);
            constexpr int EB = (MODE == 1) ? 2 : 4;
            const char* bp = (const char*)base + ((size_t)(u.pm * BM + rl0) * 2048 + col0) * EB;
            char* xp = (char*)xres + ((size_t)(u.pm * BM + rl0) * 2048 + col0) * 2;
            constexpr size_t RS = (size_t)16 * 2048;
#pragma unroll
            for (int ai = 0; ai < 2; ++ai)
#pragma unroll
                for (int mp = 0; mp < 4 / MB; ++mp) {
                    asm volatile("" : "+v"(bp), "+v"(xp));
                    f32x4 b0[MB][2], b1[MB][2];
#pragma unroll
                    for (int mi = 0; mi < MB; ++mi)
#pragma unroll
                        for (int bj = 0; bj < 2; ++bj) {
                            if (MODE == 1) { const u32x4 raw = *(const u32x4*)(bp + (mi * RS + bj * HALF) * EB); unpack8(raw, b0[mi][bj], b1[mi][bj]); }
                            else { b0[mi][bj] = *(const f32x4*)(bp + (mi * RS + bj * HALF) * EB); b1[mi][bj] = *(const f32x4*)(bp + (mi * RS + bj * HALF) * EB + 16); } }
#pragma unroll
                    for (int mi = 0; mi < MB; ++mi) { const int m = MB * mp + mi; const int rl = rl0 + ai * HALF + m * 16; float ss = 0.f;
#pragma unroll
                        for (int bj = 0; bj < 2; ++bj) {
                            const f32x4 o0 = b0[mi][bj] + gv[bj][0] * acc[ai][bj][m][0], o1 = b1[mi][bj] + gv[bj][1] * acc[ai][bj][m][1];
                            ss += ((o0[0] * o0[0] + o0[1] * o0[1]) + (o0[2] * o0[2] + o0[3] * o0[3])) + ((o1[0] * o1[0] + o1[1] * o1[1]) + (o1[2] * o1[2] + o1[3] * o1[3]));
                            acc[ai][bj][m][0] = o0; acc[ai][bj][m][1] = o1;
                            if (MODE == 0) *(u32x4*)(xp + (mi * RS + bj * HALF) * 2) = pack8(o0, o1); }
                        ss += __shfl_xor(ss, 16); ss += __shfl_xor(ss, 32);
                        if (fq == 0) P[rl * 4 + wc] = ss; }
                    const size_t rstep = (size_t)((mp == 4 / MB - 1) ? (HALF - 48 + (MB - 1) * 16) : 16 * MB) * 2048;
                    bp += rstep * EB; xp += rstep * 2;
                    asm volatile("" ::: "memory"); }
        }
        asm volatile("s_waitcnt lgkmcnt(0)" ::: "memory"); __builtin_amdgcn_s_barrier(); asm volatile("" ::: "memory");
        if (lane < 32) { const int rl = wid * 32 + lane; const f32x4 pv = *(const PG8_LAS f32x4*)(P + rl * 4);
            __hip_atomic_store(ssq + (size_t)(u.pm * BM + rl) * 8 + u.pn, (pv[0] + pv[1]) + (pv[2] + pv[3]), __ATOMIC_RELAXED, __HIP_MEMORY_SCOPE_AGENT); }
        asm volatile("s_waitcnt vmcnt(0)" ::: "memory");
        if (lane == 0) __hip_atomic_fetch_add(cnt + 64 * u.pm, 1u, __ATOMIC_RELAXED, __HIP_MEMORY_SCOPE_AGENT);
        if (wid == 0) { unsigned sp = 0;
            while ((unsigned)__builtin_amdgcn_readfirstlane(__hip_atomic_load(cnt + 64 * u.pm, __ATOMIC_RELAXED, __HIP_MEMORY_SCOPE_AGENT)) < 64u) { __builtin_amdgcn_s_sleep(2); if (++sp > (1u << 20)) break; }
            __builtin_amdgcn_fence(__ATOMIC_ACQUIRE, "agent");
            asm volatile("s_waitcnt vmcnt(0)" ::: "memory"); }
        asm volatile("s_waitcnt vmcnt(0) lgkmcnt(0)" ::: "memory"); __builtin_amdgcn_s_barrier(); asm volatile("" ::: "memory");
        { const int t = wid * 64 + lane;
          if (t < 256) { const unsigned long long* sp8 = (const unsigned long long*)(ssq + (size_t)(u.pm * BM + t) * 8); float s = 0.f;
#pragma unroll
              for (int q = 0; q < 4; ++q) { const unsigned long long w = __hip_atomic_load(sp8 + q, __ATOMIC_RELAXED, __HIP_MEMORY_SCOPE_AGENT); s += __uint_as_float((unsigned)w) + __uint_as_float((unsigned)(w >> 32)); }
              S[t] = 1.0f / sqrtf(s * (1.0f / 2048.0f) + 1e-6f); } }
        asm volatile("s_waitcnt lgkmcnt(0)" ::: "memory"); __builtin_amdgcn_s_barrier(); asm volatile("" ::: "memory");
        {
            const int cbase = col0;
            f32x4 A[2][2], B[2][2];
#pragma unroll
            for (int bj = 0; bj < 2; ++bj)
#pragma unroll
                for (int n = 0; n < 2; ++n) { const int c = cbase + bj * HALF + n * 4;
                    if (MODE == 0) { A[bj][n] = *(const f32x4*)(ng + c) * (*(const f32x4*)(modp + (size_t)b * 12288 + (shift_chunk + 1) * 2048 + c) + 1.0f); B[bj][n] = *(const f32x4*)(modp + (size_t)b * 12288 + shift_chunk * 2048 + c); }
                    else { A[bj][n] = *(const f32x4*)(fg + c); B[bj][n] = (f32x4){0.f, 0.f, 0.f, 0.f}; } }
#pragma unroll
            for (int ai = 0; ai < 2; ++ai)
#pragma unroll
                for (int m = 0; m < 4; ++m) { const int rl = rl0 + ai * HALF + m * 16; const float rs = S[rl]; const size_t off = (size_t)(u.pm * BM + rl) * 2048 + cbase;
#pragma unroll
                    for (int bj = 0; bj < 2; ++bj) {
                        const f32x4 o0 = (acc[ai][bj][m][0] * rs) * A[bj][0] + B[bj][0], o1 = (acc[ai][bj][m][1] * rs) * A[bj][1] + B[bj][1];
                        if (MODE == 0) *(u32x4*)(H + off + bj * HALF) = pack8(o0, o1);
                        else { *(f32x4*)(outf + off + bj * HALF) = o0; *(f32x4*)(outf + off + bj * HALF + 4) = o1; } } }
        }
    }
};
struct EpiGU {
    static constexpr bool PERM = true, AFTER_DRAIN = false;
    bf16_t* O; int ldc;
    __device__ __forceinline__ void operator()(f32x4 (&acc)[2][2][4][2], const Unit& u, int wr, int wc, int fr, int fq, bool last) const {
        const int row0 = u.pm * BM + wr * 64 + fr, col0 = u.pn * HALF + wc * 32 + 8 * fq;
#pragma unroll
        for (int ai = 0; ai < 2; ++ai)
#pragma unroll
            for (int m = 0; m < 4; ++m) { bf16_t* rowp = O + (size_t)(row0 + ai * HALF + m * 16) * ldc + col0; float v[8];
#pragma unroll
                for (int n = 0; n < 2; ++n)
#pragma unroll
                    for (int j = 0; j < 4; ++j) { const float g = acc[ai][0][m][n][j], up = acc[ai][1][m][n][j];
                        const float e = __builtin_amdgcn_exp2f(g * (-1.44269504089f)); v[n * 4 + j] = g * __builtin_amdgcn_rcpf(1.0f + e) * up; }
                u32x4 w; w.x = cvt_pk_bf16(v[0], v[1]); w.y = cvt_pk_bf16(v[2], v[3]); w.z = cvt_pk_bf16(v[4], v[5]); w.w = cvt_pk_bf16(v[6], v[7]);
                *(u32x4*)rowp = w; }
    }
};

struct PanelOrder {
    int c;
    __host__ __device__ void init(int, int, int, int c_) { c = c_; }
    __host__ __device__ bool next(int i, Unit& u) const { if (i >= 2) return false; const int o = c >> 3; u.pm = 8 * (c & 7) + 4 * i + (o & 3); u.pn = o >> 2; return true; }
    __device__ __forceinline__ void a_ready(const Unit&) const {}
    __device__ __forceinline__ void done(const Unit&) const {}
};
template <class Epi, class Sched, bool ALIGN_EPI = false, bool SP2 = false>
__device__ __forceinline__ void gemm_phase(PG8_LAS unsigned char* lds, const Gemm g, const Sched& S, const Epi& E, const int wave_s) {
    const int tid = fresh_tid(wave_s), wid = wave_s, lane = tid & 63, wr = wid >> 2, wc = wid & 3, fr = lane & 15, fq = lane >> 4;
    const int K = g.K, nt = K / BK;
    unsigned voffA[2], voffB[2];
#pragma unroll
    for (int i = 0; i < 2; ++i) { int R, C; stage_rc(tid * 16 + i * 8192, R, C); const int Rb = Epi::PERM ? ((R & ~31) + perm32(R & 31)) : R;
        voffA[i] = (unsigned)(R * K + C) * 2u; voffB[i] = (unsigned)(Rb * K + C) * 2u; }
    const size_t kstep = (size_t)(BK * 2);
    const size_t hstep = (size_t)HALF * K * 2;
    const size_t tstep = 2 * hstep;
    const unsigned ldsw = (unsigned)wid * 1024u;
    const int aoff = lds_byte(wr * 64 + fr, fq * 8), boff = lds_byte(wc * 32 + fr, fq * 8);
#define PG8_SA(b, h) (((b) * 2 + (h)) * HTB)
#define PG8_SB(b, h) ((4 + (b) * 2 + (h)) * HTB)
#define PG8_STAGE(bufoff, gbase, voff) do { _Pragma("unroll") for (int _i = 0; _i < 2; ++_i) \
        __builtin_amdgcn_global_load_lds((const unsigned*)((const char*)(gbase) + (voff)[_i]), (PG8_LAS unsigned*)(lds + (bufoff) + ldsw + _i * 8192), 16, 0, 0); } while (0)
#define PG8_LDA(dst, b, h) do { _Pragma("unroll") for (int m = 0; m < 4; ++m) _Pragma("unroll") for (int k = 0; k < 2; ++k) dst[m][k] = *(const PG8_LAS bf16x8*)(lds + PG8_SA(b, h) + aoff + m * 2048 + k * 1024); } while (0)
#define PG8_LDB(dst, b, h) do { _Pragma("unroll") for (int n = 0; n < 2; ++n) _Pragma("unroll") for (int k = 0; k < 2; ++k) dst[n][k] = *(const PG8_LAS bf16x8*)(lds + PG8_SB(b, h) + boff + n * 2048 + k * 1024); } while (0)
#define PG8_MMA(ai, bj, At, Bt) do { __builtin_amdgcn_s_setprio(1); _Pragma("unroll") for (int m = 0; m < 4; ++m) _Pragma("unroll") for (int n = 0; n < 2; ++n) _Pragma("unroll") for (int k = 0; k < 2; ++k) \
        acc[ai][bj][m][n] = __builtin_amdgcn_mfma_f32_16x16x32_bf16(Bt[n][k], At[m][k], acc[ai][bj][m][n], 0, 0, 0); __builtin_amdgcn_s_setprio(0); } while (0)
#define PG8_WAIT_V(n) asm volatile("s_waitcnt vmcnt(" #n ")" ::: "memory")
#define PG8_WAIT_L(n) asm volatile("s_waitcnt lgkmcnt(" #n ")" ::: "memory")
#define PG8_BAR __builtin_amdgcn_s_barrier()
#define PG8_SCHED __builtin_amdgcn_sched_barrier(0)
    Unit cur, nxt; int ui = 0;
    if (!S.next(0, cur)) return;
    f32x4 acc[2][2][4][2];
#pragma unroll
    for (int a = 0; a < 2; ++a)
#pragma unroll
        for (int b = 0; b < 2; ++b)
#pragma unroll
            for (int m = 0; m < 4; ++m)
#pragma unroll
                for (int n = 0; n < 2; ++n) acc[a][b][m][n] = (f32x4){0.f, 0.f, 0.f, 0.f};
    bf16x8 At[4][2], B0[2][2], B1[2][2];
    const char* cA = (const char*)g.A + (size_t)cur.pm * tstep; const char* cB = (const char*)g.Bt + (size_t)cur.pn * tstep;
    S.a_ready(cur);
    if constexpr (SP2) {
        PG8_STAGE(PG8_SB(0, 0), cB, voffB); PG8_STAGE(PG8_SB(0, 1), cB + hstep, voffB); PG8_STAGE(PG8_SA(0, 0), cA, voffA); PG8_STAGE(PG8_SA(0, 1), cA + hstep, voffA);
        if (wr == 1) PG8_BAR;
        PG8_WAIT_V(2); PG8_BAR;
        PG8_STAGE(PG8_SB(1, 0), cB + kstep, voffB); PG8_STAGE(PG8_SA(1, 0), cA + kstep, voffA); PG8_STAGE(PG8_SB(1, 1), cB + hstep + kstep, voffB);
        PG8_WAIT_V(6); PG8_BAR;
    } else {
        PG8_STAGE(PG8_SB(0, 0), cB, voffB); PG8_STAGE(PG8_SA(0, 0), cA, voffA); PG8_STAGE(PG8_SB(0, 1), cB + hstep, voffB); PG8_STAGE(PG8_SA(0, 1), cA + hstep, voffA);
        if (wr == 1) PG8_BAR;
        PG8_WAIT_V(4); PG8_BAR;
        PG8_STAGE(PG8_SB(1, 0), cB + kstep, voffB); PG8_STAGE(PG8_SA(1, 0), cA + kstep, voffA); PG8_STAGE(PG8_SB(1, 1), cB + hstep + kstep, voffB);
        PG8_WAIT_V(6); PG8_BAR;
    }
    for (;;) {
        const bool has_next = S.next(ui + 1, nxt);
        const char* nA = has_next ? (const char*)g.A + (size_t)nxt.pm * tstep : cA; const char* nB = has_next ? (const char*)g.Bt + (size_t)nxt.pn * tstep : cB;
        for (int t = 0; t < nt; t += 2) {
            const bool last = (t == nt - 2);
            const char* a1 = cA + (size_t)(t + 1) * kstep;
            const char* a2 = last ? nA : cA + (size_t)(t + 2) * kstep; const char* b2 = last ? nB : cB + (size_t)(t + 2) * kstep;
            const char* a3 = a2 + kstep; const char* b3 = b2 + kstep;
            if (last && has_next) S.a_ready(nxt);
            if constexpr (SP2) {
            PG8_LDB(B0, 0, 0); PG8_LDB(B1, 0, 1); PG8_SCHED; PG8_LDA(At, 0, 0); PG8_STAGE(PG8_SA(1, 1), a1 + hstep, voffA);
            PG8_WAIT_V(8); PG8_WAIT_L(0); PG8_BAR; PG8_MMA(0, 0, At, B0); PG8_MMA(0, 1, At, B1); PG8_BAR; PG8_SCHED;
            PG8_LDA(At, 0, 1); PG8_STAGE(PG8_SB(0, 0), b2, voffB); PG8_STAGE(PG8_SB(0, 1), b2 + hstep, voffB); PG8_STAGE(PG8_SA(0, 0), a2, voffA);
            PG8_WAIT_V(8); PG8_WAIT_L(0); PG8_BAR; PG8_MMA(1, 0, At, B0); PG8_MMA(1, 1, At, B1); PG8_BAR; PG8_SCHED;
            PG8_LDB(B0, 1, 0); PG8_LDB(B1, 1, 1); PG8_SCHED; PG8_LDA(At, 1, 0); PG8_STAGE(PG8_SA(0, 1), a2 + hstep, voffA);
            PG8_WAIT_V(8); PG8_WAIT_L(0); PG8_BAR; PG8_MMA(0, 0, At, B0); PG8_MMA(0, 1, At, B1); PG8_BAR; PG8_SCHED;
            PG8_LDA(At, 1, 1); PG8_STAGE(PG8_SB(1, 0), b3, voffB); PG8_STAGE(PG8_SB(1, 1), b3 + hstep, voffB); PG8_STAGE(PG8_SA(1, 0), a3, voffA);
            PG8_WAIT_V(8); PG8_WAIT_L(0); PG8_BAR; PG8_MMA(1, 0, At, B0); PG8_MMA(1, 1, At, B1); PG8_BAR; PG8_SCHED;
            } else {
            PG8_LDB(B0, 0, 0); PG8_SCHED; PG8_LDA(At, 0, 0); PG8_STAGE(PG8_SA(1, 1), a1 + hstep, voffA);
            PG8_WAIT_L(8); PG8_BAR; PG8_WAIT_L(0); PG8_MMA(0, 0, At, B0); PG8_BAR; PG8_SCHED;
            PG8_LDB(B1, 0, 1); PG8_STAGE(PG8_SB(0, 0), b2, voffB);
            PG8_BAR; PG8_WAIT_L(0); PG8_MMA(0, 1, At, B1); PG8_BAR;
            PG8_LDA(At, 0, 1); PG8_STAGE(PG8_SA(0, 0), a2, voffA);
            PG8_BAR; PG8_WAIT_L(0); PG8_MMA(1, 0, At, B0); PG8_BAR; PG8_SCHED;
            PG8_STAGE(PG8_SB(0, 1), b2 + hstep, voffB);
            PG8_WAIT_V(6); PG8_BAR; PG8_MMA(1, 1, At, B1); PG8_BAR;
            PG8_LDB(B0, 1, 0); PG8_SCHED; PG8_LDA(At, 1, 0); PG8_STAGE(PG8_SA(0, 1), a2 + hstep, voffA);
            PG8_WAIT_L(8); PG8_BAR; PG8_WAIT_L(0); PG8_MMA(0, 0, At, B0); PG8_BAR; PG8_SCHED;
            PG8_LDB(B1, 1, 1); PG8_STAGE(PG8_SB(1, 0), b3, voffB);
            PG8_BAR; PG8_WAIT_L(0); PG8_MMA(0, 1, At, B1); PG8_BAR;
            PG8_LDA(At, 1, 1); PG8_STAGE(PG8_SA(1, 0), a3, voffA);
            PG8_BAR; PG8_WAIT_L(0); PG8_MMA(1, 0, At, B0); PG8_BAR; PG8_SCHED;
            PG8_STAGE(PG8_SB(1, 1), b3 + hstep, voffB);
            PG8_WAIT_V(6); PG8_BAR; PG8_MMA(1, 1, At, B1); PG8_BAR;
            }
        }
        if constexpr (ALIGN_EPI) { if (wr == 0) PG8_BAR; }
        if constexpr (!Epi::AFTER_DRAIN) { E(acc, cur, wr, wc, fr, fq, !has_next); S.done(cur); }
        if (!has_next) break;
#pragma unroll
        for (int a = 0; a < 2; ++a)
#pragma unroll
            for (int b = 0; b < 2; ++b)
#pragma unroll
                for (int m = 0; m < 4; ++m)
#pragma unroll
                    for (int n = 0; n < 2; ++n) acc[a][b][m][n] = (f32x4){0.f, 0.f, 0.f, 0.f};
        cur = nxt; cA = nA; cB = nB; ++ui;
        if constexpr (ALIGN_EPI) { if (wr == 1) PG8_BAR; }
    }
    PG8_WAIT_V(0);
    if constexpr (!ALIGN_EPI) { if (wr == 0) PG8_BAR; }
    PG8_BAR;
    if constexpr (Epi::AFTER_DRAIN) { E.fused(acc, cur, wr, wc, fr, fq, lds, wid, lane); S.done(cur); }
#undef PG8_SA
#undef PG8_SB
#undef PG8_STAGE
#undef PG8_LDA
#undef PG8_LDB
#undef PG8_MMA
#undef PG8_WAIT_V
#undef PG8_WAIT_L
#undef PG8_BAR
#undef PG8_SCHED
}
}

constexpr int NB = 8, SEQ = 2048, DM = 2048, T = NB * SEQ;
constexpr int DFF = 5632, NIN = 5120, NMOD = 6 * DM;
constexpr int NPROJ = 4096;
constexpr float EPS = 1e-6f;
constexpr int NTHREADS = 512, NWAVES = 8;
constexpr int LDS_BYTES = 147456;
constexpr float QSCALE = 0.08838834764831845f * 1.4426950408889634f;

constexpr size_t MiB = 1u << 20;
constexpr size_t WS_BAR = 0;
constexpr size_t WS_MODCNT = 15360;
constexpr size_t WS_CNT1 = 16384, WS_CNT2 = 32768;
constexpr size_t WS_MOD = 512 * 1024;
constexpr size_t WS_SS1 = 1 * MiB;
constexpr size_t WS_SS2 = 3 * MiB;
constexpr size_t WS_WIN = 6 * MiB;
constexpr size_t WS_WOUT = 26 * MiB;
constexpr size_t WS_WGU = 34 * MiB;
constexpr size_t WS_WDN = 78 * MiB;
constexpr size_t WS_H = 100 * MiB;
constexpr size_t WS_PROJ = 164 * MiB;
constexpr size_t WS_VT = 292 * MiB;
constexpr size_t WS_O = 324 * MiB;
constexpr size_t WS_GU = 164 * MiB;
constexpr size_t WS_X1 = 388 * MiB;
constexpr size_t WS_END = 452 * MiB;
static_assert(WS_GU + (size_t)T * DFF * 2 <= WS_END, "ws map");

#define LAS __attribute__((address_space(3)))
typedef unsigned short bf16;
typedef unsigned v4u __attribute__((ext_vector_type(4)));
typedef unsigned v2u __attribute__((ext_vector_type(2)));
typedef float f32x4 __attribute__((ext_vector_type(4)));
typedef short bf16x8 __attribute__((ext_vector_type(8)));
typedef short bf16x4 __attribute__((ext_vector_type(4)));

__device__ __forceinline__ unsigned pk2(float lo, float hi) { return pg8::cvt_pk_bf16(lo, hi); }
__device__ __forceinline__ float bflo(unsigned w) { return __uint_as_float(w << 16); }
__device__ __forceinline__ float bfhi(unsigned w) { return __uint_as_float(w & 0xffff0000u); }
__device__ __forceinline__ float wave_sum(float v) {
#pragma unroll
    for (int o = 1; o < 64; o <<= 1) v += __shfl_xor(v, o);
    return v;
}

struct Params {
    const float *x, *c, *w_ada, *b_ada, *norm1_g, *w_in, *v_norm_g, *w_spatial, *b_spatial, *out_norm_g, *w_out, *norm2_g, *w_gate, *w_up, *w_down, *final_g;
    float* out; unsigned char* ws;
};

constexpr int TSCR = 16640;
__device__ __forceinline__ void titem_decode(const Params& p, int it, int lane, const float*& tsrc, bf16*& tdst, int& tN, int& tK) {
    constexpr int I_IN = (DM / 64) * (NIN / 64), I_OUT = (DM / 64) * (DM / 64), I_G = (DM / 64) * (DFF / 64);
    bf16* Win = (bf16*)(p.ws + WS_WIN); bf16* Wout = (bf16*)(p.ws + WS_WOUT); bf16* Wgu = (bf16*)(p.ws + WS_WGU); bf16* Wdn = (bf16*)(p.ws + WS_WDN);
    int r = it, mid = 0;
    if (r >= I_IN) { r -= I_IN; mid = 1; if (r >= I_OUT) { r -= I_OUT; mid = 2; if (r >= I_G) { r -= I_G; mid = 3; if (r >= I_G) { r -= I_G; mid = 4; } } } }
#define TSEL(k, v) ((unsigned long long)(-(long long)(mid == (k))) & (unsigned long long)(v))
    const float* W = (const float*)(TSEL(0, p.w_in) | TSEL(1, p.w_out) | TSEL(2, p.w_gate) | TSEL(3, p.w_up) | TSEL(4, p.w_down));
    bf16* WT = (bf16*)(TSEL(0, Win) | TSEL(1, Wout) | TSEL(2, Wgu) | TSEL(3, Wgu) | TSEL(4, Wdn));
#undef TSEL
    const int K = (mid == 4) ? DFF : DM, N = (mid == 0) ? NIN : ((mid == 2 || mid == 3) ? DFF : DM);
    const bool gu = (mid == 2 || mid == 3); const int dadd = (mid == 3) ? 128 : 0; int nb;
    nb = N / 64; const int kb = r / nb, n0 = (r % nb) * 64, k0 = kb * 64;
    const int drow0 = gu ? ((n0 >> 7) * 256 + (n0 & 127) + dadd) : n0;
    tN = N; tK = K;
    tsrc = W + (size_t)(k0 + (lane >> 4)) * N + n0 + (lane & 15) * 4;
    tdst = WT + (size_t)(drow0 + (lane >> 3)) * K + k0 + 8 * (lane & 7);
}
constexpr int TR_IN = (DM / 64) * (NIN / 64);
constexpr int TR_ALL = (DM / 64) * (NIN / 64) + (DM / 64) * (DM / 64) + 2 * (DM / 64) * (DFF / 64) + (DFF / 64) * (DM / 64);
__device__ __forceinline__ void transpose_items_ex(const Params& p, LAS unsigned char* lds, const int first, const int NGW, const int it1, const int wave_s) {
    const int lane = fresh_tid(wave_s) & 63, wave = wave_s;
    LAS float* scr = (LAS float*)(lds + wave * TSCR);
    const int NITEMS = it1;
    {
        int it = first;
        f32x4 cur[16];
        const float* csrc; bf16* cdst; int cN, cK;
        titem_decode(p, it < NITEMS ? it : 0, lane, csrc, cdst, cN, cK);
        if (it < NITEMS) {
#pragma unroll
            for (int i = 0; i < 16; ++i) cur[i] = __builtin_nontemporal_load((const f32x4*)(csrc + (size_t)(4 * i) * cN));
        }
        while (it < NITEMS) {
            const int itn = it + NGW; const bool hn = itn < NITEMS;
            const float* nsrc; bf16* ndst; int nN, nK;
            titem_decode(p, hn ? itn : it, lane, nsrc, ndst, nN, nK);
            f32x4 nxt[16];
            if (hn) {
#pragma unroll
                for (int i = 0; i < 16; ++i) nxt[i] = __builtin_nontemporal_load((const f32x4*)(nsrc + (size_t)(4 * i) * nN));
            }
            const int lr = lane >> 4, lc = (lane & 15) * 4;
#pragma unroll
            for (int i = 0; i < 16; ++i) { LAS float* d = scr + (4 * i + lr) * 65 + lc; d[0] = cur[i][0]; d[1] = cur[i][1]; d[2] = cur[i][2]; d[3] = cur[i][3]; }
            asm volatile("s_waitcnt lgkmcnt(0)" ::: "memory");
            const int c = lane & 7;
#pragma unroll
            for (int j = 0; j < 8; ++j) { const LAS float* q = scr + (8 * c) * 65 + (lane >> 3) + 8 * j;
                v4u o; o.x = pk2(q[0 * 65], q[1 * 65]); o.y = pk2(q[2 * 65], q[3 * 65]); o.z = pk2(q[4 * 65], q[5 * 65]); o.w = pk2(q[6 * 65], q[7 * 65]);
                *(v4u*)(cdst + (size_t)(8 * j) * cK) = o; }
            asm volatile("s_waitcnt lgkmcnt(0)" ::: "memory");
            if (hn) {
#pragma unroll
                for (int i = 0; i < 16; ++i) cur[i] = nxt[i];
            }
            csrc = nsrc; cdst = ndst; cN = nN; cK = nK; it = itn;
        }
    }
}

__device__ __forceinline__ void transpose_items(const Params& p, LAS unsigned char* lds, const int it0, const int it1, const int vcu, const int G, const int wave_s) {
    transpose_items_ex(p, lds, it0 + vcu * NWAVES + wave_s, G * NWAVES, it1, wave_s);
}
__device__ __forceinline__ void phase_prep(const Params& p, LAS unsigned char* lds, int vcu, int G, const int wave_s) {
    const int tid = fresh_tid(wave_s), lane = tid & 63, wave = wave_s;
    LAS float* scr = (LAS float*)(lds + wave * TSCR);
    const int gw = vcu * NWAVES + wave, NGW = G * NWAVES;
    unsigned char* ws = p.ws;
    bf16* Win = (bf16*)(ws + WS_WIN); bf16* Wout = (bf16*)(ws + WS_WOUT); bf16* Wgu = (bf16*)(ws + WS_WGU); bf16* Wdn = (bf16*)(ws + WS_WDN);
    for (int cb = vcu; cb < NMOD / 64; cb += G) {
        float* mod = (float*)(ws + WS_MOD);
        const int kbase = 256 * wave, col = cb * 64 + lane;
#pragma unroll
        for (int b = 0; b < 8; ++b) { f32x4 cv = *(const f32x4*)(p.c + b * DM + kbase + lane * 4);
#pragma unroll
            for (int j = 0; j < 4; ++j) cv[j] = cv[j] / (1.0f + __expf(-cv[j]));
            *(LAS f32x4*)(scr + b * 256 + lane * 4) = cv; }
        asm volatile("s_waitcnt lgkmcnt(0)" ::: "memory");
        float a[8];
#pragma unroll
        for (int b = 0; b < 8; ++b) a[b] = 0.f;
        const float* wp = p.w_ada + (size_t)kbase * NMOD + col;
#pragma unroll 4
        for (int k4 = 0; k4 < 64; ++k4) {
            float wv[4];
#pragma unroll
            for (int i = 0; i < 4; ++i) wv[i] = __builtin_nontemporal_load(wp + (size_t)(4 * k4 + i) * NMOD);
#pragma unroll
            for (int b = 0; b < 8; ++b) { const f32x4 sv = *(const LAS f32x4*)(scr + b * 256 + 4 * k4); a[b] += (wv[0] * sv[0] + wv[1] * sv[1]) + (wv[2] * sv[2] + wv[3] * sv[3]); }
        }
        __syncthreads();
        LAS float* red = (LAS float*)lds;
#pragma unroll
        for (int b = 0; b < 8; ++b) red[(wave * 8 + b) * 64 + lane] = a[b];
        __syncthreads();
        { const int b = tid >> 6; float sacc = p.b_ada[col];
#pragma unroll
          for (int w2 = 0; w2 < 8; ++w2) sacc += red[(w2 * 8 + b) * 64 + lane];
          mod[(size_t)b * NMOD + col] = sacc; }
        asm volatile("s_waitcnt vmcnt(0)" ::: "memory");
        __syncthreads();
        if (tid == 0) { __builtin_amdgcn_fence(__ATOMIC_RELEASE, "agent"); __hip_atomic_fetch_add((unsigned*)(ws + WS_MODCNT), 1u, __ATOMIC_RELAXED, __HIP_MEMORY_SCOPE_AGENT); }
    }
    if (G == 256) {
        constexpr int NMB = NMOD / 64, MODW = NMB * NWAVES, SPLIT = MODW / 2;
        if (vcu < NMB) { const int m = vcu * NWAVES + wave_s; transpose_items_ex(p, lds, m, TR_IN  , m < SPLIT ? SPLIT : 0, wave_s); }
        else transpose_items_ex(p, lds, SPLIT + (vcu - NMB) * NWAVES + wave_s, (256 - NMB) * NWAVES, TR_IN, wave_s);
    } else transpose_items(p, lds, 0, TR_IN, vcu, G, wave_s);
}

template <int MODE>
__device__ __forceinline__ void phase_norm_mod(const Params& p, const void* srcv, const float* ssp, const float* ng, int shift_chunk, bf16* dst, int vcu, int G, const int wave_s) {
    const int tid = fresh_tid(wave_s), lane = tid & 63, wave = wave_s;
    const int gw = vcu * NWAVES + wave, NGW = G * NWAVES;
    const float* mod = (const float*)(p.ws + WS_MOD);
    for (int rb = gw; rb < T / 8; rb += NGW) {
        const int b = (rb * 8) / SEQ;
        f32x4 A[8], B[8];
#pragma unroll
        for (int j = 0; j < 8; ++j) { const int cidx = lane * 4 + 256 * j;
            const f32x4 g = *(const f32x4*)(ng + cidx);
            const f32x4 sh = *(const f32x4*)(mod + (size_t)b * NMOD + shift_chunk * DM + cidx);
            const f32x4 sc = *(const f32x4*)(mod + (size_t)b * NMOD + (shift_chunk + 1) * DM + cidx);
            A[j] = g * (sc + 1.0f); B[j] = sh; }
        for (int rr = 0; rr < 8; ++rr) {
            const int row = rb * 8 + rr;
            f32x4 v[8]; float s = 0.f;
            if (MODE == 0) { const f32x4* xr = (const f32x4*)((const float*)srcv + (size_t)row * DM) + lane;
#pragma unroll
                for (int j = 0; j < 8; ++j) { v[j] = __builtin_nontemporal_load(xr + 64 * j); s += (v[j][0] * v[j][0] + v[j][1] * v[j][1]) + (v[j][2] * v[j][2] + v[j][3] * v[j][3]); } }
            else { const v2u* xr = (const v2u*)((const bf16*)srcv + (size_t)row * DM) + lane;
#pragma unroll
                for (int j = 0; j < 8; ++j) { const v2u raw = xr[64 * j]; v[j] = (f32x4){bflo(raw.x), bfhi(raw.x), bflo(raw.y), bfhi(raw.y)}; } }
            float tot;
            if (MODE == 0) tot = wave_sum(s);
            else { float q = (lane < 32) ? ssp[(size_t)row * 32 + lane] : 0.f; tot = wave_sum(q); }
            const float rstd = 1.0f / sqrtf(tot * (1.0f / DM) + EPS);
            v2u* o8 = (v2u*)(dst + (size_t)row * DM) + lane;
#pragma unroll
            for (int j = 0; j < 8; ++j) { const f32x4 h = (v[j] * rstd) * A[j] + B[j]; v2u w; w.x = pk2(h[0], h[1]); w.y = pk2(h[2], h[3]); o8[64 * j] = w; }
        }
    }
}

__device__ __forceinline__ void phase_final(const Params& p, const float* ssp, int vcu, int G, const int wave_s) {
    const int tid = fresh_tid(wave_s), lane = tid & 63, wave = wave_s;
    const int gw = vcu * NWAVES + wave, NGW = G * NWAVES;
    f32x4 g[8];
#pragma unroll
    for (int j = 0; j < 8; ++j) g[j] = *(const f32x4*)(p.final_g + lane * 4 + 256 * j);
    for (int row = gw; row < T; row += NGW) {
        f32x4* xr = (f32x4*)(p.out + (size_t)row * DM) + lane;
        const v2u* xs = (const v2u*)((const bf16*)(p.ws + WS_X1) + (size_t)row * DM) + lane;
        f32x4 v[8];
#pragma unroll
        for (int j = 0; j < 8; ++j) { const v2u raw = xs[64 * j]; v[j] = (f32x4){bflo(raw.x), bfhi(raw.x), bflo(raw.y), bfhi(raw.y)}; }
        float q = (lane < 32) ? ssp[(size_t)row * 32 + lane] : 0.f; const float tot = wave_sum(q);
        const float rstd = 1.0f / sqrtf(tot * (1.0f / DM) + EPS);
#pragma unroll
        for (int j = 0; j < 8; ++j) xr[64 * j] = (v[j] * rstd) * g[j];
    }
}

constexpr int TP = 136;
__device__ __forceinline__ void gmlp_tile(const Params& p, LAS unsigned char* lds, int b, int n, int g, const int wave_s) {
    const int tid = fresh_tid(wave_s), lane = tid & 63, w = wave_s, r = lane & 15, cgp = lane >> 4;
    const bf16* PROJ = (const bf16*)(p.ws + WS_PROJ); bf16* O = (bf16*)(p.ws + WS_O);
    LAS bf16* Vt = (LAS bf16*)lds;
    const int tok0 = b * SEQ + n * 128;
    const int t = 16 * w + r;
    const float bsv = p.b_spatial[g * 128 + t];
    const bf16* urow = PROJ + (size_t)(tok0 + t) * NPROJ + g * 128 + cgp * 4;
    v2u uwv[8]; f32x4 ogv[8];
#pragma unroll
    for (int nd = 0; nd < 8; ++nd) { uwv[nd] = *(const v2u*)(urow + nd * 16); ogv[nd] = *(const f32x4*)(p.out_norm_g + g * 128 + nd * 16 + cgp * 4); }
    const float* wrow = p.w_spatial + (size_t)(g * 128 + t) * 128;
    f32x4 wq[4][2];
#pragma unroll
    for (int kk = 0; kk < 4; ++kk) { if (kk <= (w >> 1)) { wq[kk][0] = *(const f32x4*)(wrow + kk * 32 + cgp * 8); wq[kk][1] = *(const f32x4*)(wrow + kk * 32 + cgp * 8 + 4); } else { wq[kk][0] = (f32x4){0.f, 0.f, 0.f, 0.f}; wq[kk][1] = (f32x4){0.f, 0.f, 0.f, 0.f}; } }
    {
        const int s = 16 * w + r;
        const bf16* src = PROJ + (size_t)(tok0 + s) * NPROJ + 1024 + g * 128;
        float xv[4][8]; float s1 = 0.f;
#pragma unroll
        for (int pp = 0; pp < 4; ++pp) { const v4u raw = *(const v4u*)(src + (cgp * 4 + pp) * 8);
            xv[pp][0] = bflo(raw.x); xv[pp][1] = bfhi(raw.x); xv[pp][2] = bflo(raw.y); xv[pp][3] = bfhi(raw.y); xv[pp][4] = bflo(raw.z); xv[pp][5] = bfhi(raw.z); xv[pp][6] = bflo(raw.w); xv[pp][7] = bfhi(raw.w);
#pragma unroll
            for (int j = 0; j < 8; ++j) s1 += xv[pp][j]; }
        s1 += __shfl_xor(s1, 16); s1 += __shfl_xor(s1, 32);
        const float mean = s1 * (1.0f / 128.0f); float s2 = 0.f;
#pragma unroll
        for (int pp = 0; pp < 4; ++pp)
#pragma unroll
            for (int j = 0; j < 8; ++j) { xv[pp][j] -= mean; s2 += xv[pp][j] * xv[pp][j]; }
        s2 += __shfl_xor(s2, 16); s2 += __shfl_xor(s2, 32);
        const float rstd = 1.0f / sqrtf(s2 * (1.0f / 128.0f) + EPS);
#pragma unroll
        for (int pp = 0; pp < 4; ++pp) { const int d0 = (cgp * 4 + pp) * 8;
            const f32x4 g0 = *(const f32x4*)(p.v_norm_g + g * 128 + d0), g1 = *(const f32x4*)(p.v_norm_g + g * 128 + d0 + 4);
#pragma unroll
            for (int j = 0; j < 8; ++j) { const float y = xv[pp][j] * rstd * (j < 4 ? g0[j & 3] : g1[j & 3]); Vt[(d0 + j) * TP + s] = (bf16)(pk2(y, 0.f) & 0xffffu); } }
    }
    __syncthreads();
    f32x4 acc[8];
#pragma unroll
    for (int nd = 0; nd < 8; ++nd) acc[nd] = (f32x4){0.f, 0.f, 0.f, 0.f};
#pragma unroll
    for (int kk = 0; kk < 4; ++kk) {
        if (kk > (w >> 1)) break;
        const int s0 = kk * 32 + cgp * 8;
        const f32x4 w0 = wq[kk][0], w1 = wq[kk][1];
        float wv[8] = {w0[0], w0[1], w0[2], w0[3], w1[0], w1[1], w1[2], w1[3]};
#pragma unroll
        for (int j = 0; j < 8; ++j) wv[j] = (s0 + j <= t) ? wv[j] : 0.f;
        v4u wp; wp.x = pk2(wv[0], wv[1]); wp.y = pk2(wv[2], wv[3]); wp.z = pk2(wv[4], wv[5]); wp.w = pk2(wv[6], wv[7]);
        const bf16x8 wf = __builtin_bit_cast(bf16x8, wp);
#pragma unroll
        for (int nd = 0; nd < 8; ++nd) { const bf16x8 vf = *(const LAS bf16x8*)(Vt + (nd * 16 + r) * TP + s0);
            acc[nd] = __builtin_amdgcn_mfma_f32_16x16x32_bf16(vf, wf, acc[nd], 0, 0, 0); }
    }
    float ss = 0.f;
#pragma unroll
    for (int nd = 0; nd < 8; ++nd) { const v2u uw = uwv[nd];
        f32x4 o; o[0] = bflo(uw.x) * (acc[nd][0] + bsv); o[1] = bfhi(uw.x) * (acc[nd][1] + bsv); o[2] = bflo(uw.y) * (acc[nd][2] + bsv); o[3] = bfhi(uw.y) * (acc[nd][3] + bsv);
        acc[nd] = o; ss += (o[0] * o[0] + o[1] * o[1]) + (o[2] * o[2] + o[3] * o[3]); }
    ss += __shfl_xor(ss, 16); ss += __shfl_xor(ss, 32);
    const float rs = 1.0f / sqrtf(ss * (1.0f / 128.0f) + EPS);
    bf16* orow = O + (size_t)(tok0 + t) * DM + g * 128 + cgp * 4;
#pragma unroll
    for (int nd = 0; nd < 8; ++nd) { const f32x4 og = ogv[nd];
        v2u wv2; wv2.x = pk2(acc[nd][0] * rs * og[0], acc[nd][1] * rs * og[1]); wv2.y = pk2(acc[nd][2] * rs * og[2], acc[nd][3] * rs * og[3]);
        *(v2u*)(orow + nd * 16) = wv2; }
    __syncthreads();
}

typedef float f32x16 __attribute__((ext_vector_type(16)));
constexpr int TPK = 136, TPV = 132;
template <bool DIAG>
__device__ __forceinline__ void sb_tile(f32x16& z, float& run, int r, int hi) {
    float be[16], om[16];
#pragma unroll
    for (int i = 0; i < 16; ++i) { const float e = __builtin_amdgcn_exp2f(-z[i]);
        be[i] = __builtin_amdgcn_rcpf(1.0f + e); om[i] = 1.0f - be[i];
        if (DIAG) { const bool valid = (8 * (i >> 2) + 4 * hi + (i & 3)) < r; be[i] = valid ? be[i] : 0.f; om[i] = valid ? om[i] : 1.0f; } }
    float P[4], xo[4], Tt[4];
#pragma unroll
    for (int g = 0; g < 4; ++g) P[g] = (om[4 * g] * om[4 * g + 1]) * (om[4 * g + 2] * om[4 * g + 3]);
#pragma unroll
    for (int g = 0; g < 4; ++g) { const unsigned u = __float_as_uint(P[g]); const auto sw = __builtin_amdgcn_permlane32_swap(u, u, false, false);
        xo[g] = __uint_as_float(sw[1]); Tt[g] = __uint_as_float(sw[0]) * __uint_as_float(sw[1]); }
#pragma unroll
    for (int g = 3; g >= 0; --g) {
        float tl = run * (hi ? 1.0f : xo[g]); run *= Tt[g];
        z[4 * g + 3] = be[4 * g + 3] * tl; tl *= om[4 * g + 3];
        z[4 * g + 2] = be[4 * g + 2] * tl; tl *= om[4 * g + 2];
        z[4 * g + 1] = be[4 * g + 1] * tl; tl *= om[4 * g + 1];
        z[4 * g + 0] = be[4 * g + 0] * tl;
    }
}
__device__ __forceinline__ void sb_unit(const Params& p, LAS unsigned char* lds, int b, int h, int qb, const int wave_s) {
    const int tid = fresh_tid(wave_s), lane = tid & 63, w = wave_s, r = lane & 31, hi = lane >> 5;
    const bf16* PROJ = (const bf16*)(p.ws + WS_PROJ); const bf16* VT = (const bf16*)(p.ws + WS_VT); bf16* O = (bf16*)(p.ws + WS_O);
    LAS bf16* Ks = (LAS bf16*)lds;
    LAS bf16* Vs = (LAS bf16*)(lds + 2 * 128 * TPK * 2);
    const int tok0 = b * SEQ;
    const int qt = 8 * qb + w;
    bf16x8 qf[8];
    { const bf16* qrow = PROJ + (size_t)(tok0 + 32 * qt + r) * NPROJ + 2048 + h * 128 + 8 * hi;
#pragma unroll
      for (int st = 0; st < 8; ++st) qf[st] = *(const bf16x8*)(qrow + 16 * st);
#pragma unroll
      for (int st = 0; st < 8; ++st) asm volatile("" : "+v"(qf[st])); }
    const bf16* kbase = PROJ + (size_t)tok0 * NPROJ + 3072 + h * 128;
    const bf16* vbase = VT + (size_t)(h * 128) * T + tok0;
    v4u kr[4], vr[4];
#define SB_LOAD(jb) do { _Pragma("unroll") for (int pp = 0; pp < 4; ++pp) { const int c = tid + 512 * pp, rw = c >> 4, pc = c & 15; \
        kr[pp] = *(const v4u*)(kbase + (size_t)((jb) * 128 + rw) * NPROJ + pc * 8); vr[pp] = *(const v4u*)(vbase + (size_t)rw * T + (jb) * 128 + pc * 8); } } while (0)
#define SB_STORE(buf) do { _Pragma("unroll") for (int pp = 0; pp < 4; ++pp) { const int c = tid + 512 * pp, rw = c >> 4, pc = c & 15; \
        *(LAS v4u*)(Ks + ((buf) * 128 + rw) * TPK + pc * 8) = kr[pp]; \
        LAS v2u* vd = (LAS v2u*)(Vs + ((buf) * 128 + rw) * TPV + pc * 8); v2u lo2, hi2; lo2.x = vr[pp].x; lo2.y = vr[pp].y; hi2.x = vr[pp].z; hi2.y = vr[pp].w; vd[0] = lo2; vd[1] = hi2; } } while (0)
    f32x16 oacc[4];
#pragma unroll
    for (int dt = 0; dt < 4; ++dt)
#pragma unroll
        for (int i = 0; i < 16; ++i) oacc[dt][i] = 0.f;
    float run = 1.0f;
    const int jtop = 2 * qb + 1;
    SB_LOAD(jtop); SB_STORE(0);
    __syncthreads();
    for (int jb = jtop; jb >= 0; --jb) {
        const int cur = (jtop - jb) & 1;
        if (jb > 0) SB_LOAD(jb - 1);
#pragma unroll 1
        for (int c = 3; c >= 0; --c) {
            const int kt = 4 * jb + c;
            if (kt > qt) continue;
            const bool diag = (kt == qt);
            const LAS bf16* kp = Ks + (cur * 128 + 32 * c + r) * TPK + 8 * hi;
            bf16x8 kf[8];
#pragma unroll
            for (int st = 0; st < 8; ++st) kf[st] = *(const LAS bf16x8*)(kp + 16 * st);
            __builtin_amdgcn_sched_barrier(0);
            f32x16 z;
#pragma unroll
            for (int i = 0; i < 16; ++i) z[i] = 0.f;
#pragma unroll
            for (int st = 0; st < 8; ++st) z = __builtin_amdgcn_mfma_f32_32x32x16_bf16(kf[st], qf[st], z, 0, 0, 0);
            __builtin_amdgcn_sched_barrier(0);
            v2u vlo[2][4], vhh[2][4];
#pragma unroll
            for (int s2 = 0; s2 < 2; ++s2)
#pragma unroll
                for (int dt = 0; dt < 4; ++dt) { const LAS bf16* vp = Vs + (cur * 128 + 32 * dt + r) * TPV + 32 * c + 16 * s2 + 4 * hi;
                    vlo[s2][dt] = *(const LAS v2u*)vp; vhh[s2][dt] = *(const LAS v2u*)(vp + 8); }
            __builtin_amdgcn_sched_barrier(0);
            if (diag) sb_tile<true>(z, run, r, hi); else sb_tile<false>(z, run, r, hi);
            __builtin_amdgcn_sched_barrier(0);
#pragma unroll
            for (int s2 = 0; s2 < 2; ++s2) {
                v4u pw; pw.x = pk2(z[8 * s2 + 0], z[8 * s2 + 1]); pw.y = pk2(z[8 * s2 + 2], z[8 * s2 + 3]); pw.z = pk2(z[8 * s2 + 4], z[8 * s2 + 5]); pw.w = pk2(z[8 * s2 + 6], z[8 * s2 + 7]);
                const bf16x8 pf = __builtin_bit_cast(bf16x8, pw);
#pragma unroll
                for (int dt = 0; dt < 4; ++dt) { v4u vw; vw.x = vlo[s2][dt].x; vw.y = vlo[s2][dt].y; vw.z = vhh[s2][dt].x; vw.w = vhh[s2][dt].y;
                    oacc[dt] = __builtin_amdgcn_mfma_f32_32x32x16_bf16(__builtin_bit_cast(bf16x8, vw), pf, oacc[dt], 0, 0, 0); }
            }
        }
        if (jb > 0) SB_STORE(cur ^ 1);
        __syncthreads();
    }
#undef SB_LOAD
#undef SB_STORE
    float ss = 0.f;
#pragma unroll
    for (int dt = 0; dt < 4; ++dt)
#pragma unroll
        for (int i = 0; i < 16; ++i) ss += oacc[dt][i] * oacc[dt][i];
    ss += __shfl_xor(ss, 32);
    const float rs = 1.0f / sqrtf(ss * (1.0f / 128.0f) + EPS);
    bf16* orow = O + (size_t)(tok0 + 32 * qt + r) * DM + 1024 + h * 128 + 8 * hi;
    const float* ogp = p.out_norm_g + 1024 + h * 128 + 4 * hi;
    f32x4 ogv[4][4];
#pragma unroll
    for (int dt = 0; dt < 4; ++dt)
#pragma unroll
        for (int g = 0; g < 4; ++g) ogv[dt][g] = *(const f32x4*)(ogp + 32 * dt + 8 * g);
#pragma unroll
    for (int dt = 0; dt < 4; ++dt) {
        v2u pk[4];
#pragma unroll
        for (int g = 0; g < 4; ++g) { const f32x4 og = ogv[dt][g];
            pk[g].x = pk2(oacc[dt][4 * g + 0] * rs * og[0], oacc[dt][4 * g + 1] * rs * og[1]); pk[g].y = pk2(oacc[dt][4 * g + 2] * rs * og[2], oacc[dt][4 * g + 3] * rs * og[3]); }
#pragma unroll
        for (int k = 0; k < 2; ++k) {
            const auto sx = __builtin_amdgcn_permlane32_swap(pk[2 * k].x, pk[2 * k + 1].x, false, false);
            const auto sy = __builtin_amdgcn_permlane32_swap(pk[2 * k].y, pk[2 * k + 1].y, false, false);
            v4u w; w.x = sx[0]; w.y = sy[0]; w.z = sx[1]; w.w = sy[1];
            *(v4u*)(orow + 32 * dt + 16 * k) = w; }
    }
}

template <int HALF_ID>
__device__ __forceinline__ void mixers_half(const Params& p, LAS unsigned char* lds, int vcu, int G, const int wave_s) {
    if ((HALF_ID ^ (vcu & 1)) == 0) {
        for (int pr = vcu; pr < 256; pr += G) {
            const int bh = pr >> 2, ip = pr & 3, b = bh >> 3, h = bh & 7;
            sb_unit(p, lds, b, h, 7 - ip, wave_s);
            sb_unit(p, lds, b, h, ip, wave_s);
        }
    } else {
        for (int tl = vcu; tl < 1024; tl += G) { const int g = tl & 7, n = (tl >> 3) & 15, b = tl >> 7; gmlp_tile(p, lds, b, n, g, wave_s); }
    }
}
__device__ __forceinline__ void phase_mixers(const Params& p, LAS unsigned char* lds, int vcu, int G, const int wave_s) {
    mixers_half<0>(p, lds, vcu, G, wave_s);
    transpose_items(p, lds, TR_IN, TR_ALL, vcu, G, wave_s);
    __syncthreads();
    mixers_half<1>(p, lds, vcu, G, wave_s);
}

#define XB_TMO      128
#define XB_XCNT(j)  (256  + 64 * (j))
#define XB_XSUB(j)  (1280 + 64 * (j))
#define XB_XGEN(j)  (2304 + 64 * (j))
#define XB_TOP      3328
#define XB_TOPGEN   3392
#define XCD_BAR_WORDS 3456
#define XB_SPIN_CAP (1u << 18)

__device__ __forceinline__ unsigned xb_ld(unsigned* p)              { return __hip_atomic_load(p, __ATOMIC_RELAXED, __HIP_MEMORY_SCOPE_AGENT); }
__device__ __forceinline__ unsigned xb_add(unsigned* p, unsigned v) { return __hip_atomic_fetch_add(p, v, __ATOMIC_RELAXED, __HIP_MEMORY_SCOPE_AGENT); }
__device__ __forceinline__ unsigned xb_xcc_id() { return (unsigned)__builtin_amdgcn_s_getreg((3 << 11) | 20) & 0xFu; }
#define XB_SPIN(cond, bar) do { unsigned _sp = 0; while (cond) { __builtin_amdgcn_s_sleep(1); \
    if ((++_sp & 255u) == 0u) { if (xb_ld(&(bar)[XB_TMO])) break; if (_sp > XB_SPIN_CAP) { atomicAdd(&(bar)[XB_TMO], 1u); break; } } } } while (0)

struct XcdBarrier {
    unsigned* bar; unsigned x; int w;
    volatile LAS unsigned* st;
};

__device__ __forceinline__ XcdBarrier xcd_barrier_post(unsigned* bar, volatile LAS unsigned* st, int wave_s) {
    XcdBarrier b; b.bar = bar; b.x = xb_xcc_id(); b.st = st; b.w = wave_s;
    if (wave_s == 0 && lane_id() == 0) (void)xb_add(&bar[XB_XCNT(b.x)], 1u);
    return b;
}
__device__ __forceinline__ void xcd_barrier_complete(unsigned* bar, unsigned x, unsigned& nloc, unsigned& nx) {
    const unsigned G = gridDim.x * gridDim.y * gridDim.z;
    unsigned sum, cnt, mine, sp = 0u;
    for (;;) {
        sum = 0u; cnt = 0u; mine = 0u;
#pragma unroll
        for (unsigned j = 0; j < 16; ++j) { const unsigned c = xb_ld(&bar[XB_XCNT(j)]); sum += c; cnt += (c > 0u) ? 1u : 0u; mine = (j == x) ? c : mine; }
        if (sum == G) break;
        __builtin_amdgcn_s_sleep(1);
        if ((++sp & 255u) == 0u) { if (xb_ld(&bar[XB_TMO])) break; if (sp > XB_SPIN_CAP) { atomicAdd(&bar[XB_TMO], 1u); break; } }
    }
    nloc = mine > 0u ? mine : 1u; nx = cnt > 0u ? cnt : 1u;
}

__device__ __forceinline__ void xcd_barrier(const XcdBarrier& b) {
    asm volatile("s_waitcnt vmcnt(0)" ::: "memory");
    __syncthreads();
    if (b.w == 0 && lane_id() == 0) {
        unsigned* bar = b.bar;
        __builtin_amdgcn_s_waitcnt(0);
        unsigned nloc = b.st[0], nx = b.st[1];
        if (nloc == 0u) { xcd_barrier_complete(bar, b.x, nloc, nx); b.st[0] = nloc; b.st[1] = nx; }
        const unsigned old = xb_add(&bar[XB_XSUB(b.x)], 1u);
        const unsigned gen = old / nloc;
        if (old + 1u == (gen + 1u) * nloc) {
            __builtin_amdgcn_fence(__ATOMIC_RELEASE, "agent");
            asm volatile("s_waitcnt vmcnt(0)" ::: "memory");
            const unsigned og = xb_add(&bar[XB_TOP], 1u);
            const unsigned tg = og / nx;
            if (og + 1u == (tg + 1u) * nx) xb_add(&bar[XB_TOPGEN], 1u);
            else XB_SPIN(xb_ld(&bar[XB_TOPGEN]) == tg, bar);
            __builtin_amdgcn_fence(__ATOMIC_ACQUIRE, "agent");
            xb_add(&bar[XB_XGEN(b.x)], 1u);
            asm volatile("s_waitcnt vmcnt(0)" ::: "memory");
        } else {
            XB_SPIN(xb_ld(&bar[XB_XGEN(b.x)]) == gen, bar);
            __builtin_amdgcn_fence(__ATOMIC_ACQUIRE, "agent");
            asm volatile("s_waitcnt vmcnt(0)" ::: "memory");
        }
    }
    __syncthreads();
}

#ifndef PH_MASK
#define PH_MASK 0x3ff
#endif
#define PH(k) if constexpr ((PH_MASK >> (k)) & 1)
#ifndef DUP_MASK
#define DUP_MASK 0
#endif
#define DUP(k) _Pragma("unroll 1") for (int _r = 0; _r < ((((DUP_MASK) >> (k)) & 1) ? 2 : 1); ++_r)
__global__ void __launch_bounds__(NTHREADS, 2) fwd_megakernel(Params p) {
    extern __shared__ __attribute__((aligned(16))) unsigned char lds_raw[];
    LAS unsigned char* lds = (LAS unsigned char*)lds_raw;
    cg::grid_group grid = cg::this_grid();
    if (p.ws == nullptr) grid.sync();
    volatile LAS unsigned* bst = (volatile LAS unsigned*)(lds + LDS_BYTES - 64);
    const int wave_s = __builtin_amdgcn_readfirstlane((int)(threadIdx.x >> 6));
    if (wave_s == 0 && lane_id() == 0) { bst[0] = 0u; bst[1] = 0u; }
    __syncthreads();
    const XcdBarrier bar = xcd_barrier_post((unsigned*)(p.ws + WS_BAR), bst, wave_s);
    const int G = gridDim.x, bx = blockIdx.x;
    const int vcu = (G % 8 == 0) ? (bx % 8) * (G / 8) + bx / 8 : bx;
    unsigned char* ws = p.ws;
    bf16* Win = (bf16*)(ws + WS_WIN); bf16* Wout = (bf16*)(ws + WS_WOUT); bf16* Wgu = (bf16*)(ws + WS_WGU); bf16* Wdn = (bf16*)(ws + WS_WDN);
    bf16* H = (bf16*)(ws + WS_H); bf16* PROJ = (bf16*)(ws + WS_PROJ); bf16* VT = (bf16*)(ws + WS_VT); bf16* O = (bf16*)(ws + WS_O); bf16* GU = (bf16*)(ws + WS_GU); bf16* X1 = (bf16*)(ws + WS_X1);
    float* mod = (float*)(ws + WS_MOD); float* SS1 = (float*)(ws + WS_SS1); float* SS2 = (float*)(ws + WS_SS2);

#if TS_SEL >= 0
    unsigned long long* tsb = (unsigned long long*)(ws + 49152 + 1024);
#define STAMP(k) do { if (bx == 0 && wave_s == 0 && lane_id() == 0) __hip_atomic_store(tsb + (k), (unsigned long long)__builtin_amdgcn_s_memrealtime(), __ATOMIC_RELAXED, __HIP_MEMORY_SCOPE_AGENT); } while (0)
#else
#define STAMP(k) do { } while (0)
#endif
    STAMP(0);
    PH(0) DUP(0) phase_prep(p, lds, vcu, G, wave_s);
    { if (wave_s == 0) { unsigned sp = 0;
          while ((unsigned)__builtin_amdgcn_readfirstlane(__hip_atomic_load((unsigned*)(ws + WS_MODCNT), __ATOMIC_RELAXED, __HIP_MEMORY_SCOPE_AGENT)) < (unsigned)(NMOD / 64)) { __builtin_amdgcn_s_sleep(2); if (++sp > (1u << 22)) break; }
          __builtin_amdgcn_fence(__ATOMIC_ACQUIRE, "agent"); asm volatile("s_waitcnt vmcnt(0)" ::: "memory"); }
      __syncthreads(); }
    STAMP(1);
    PH(1) DUP(1) phase_norm_mod<0>(p, p.x, nullptr, p.norm1_g, 0, H, vcu, G, wave_s);
    xcd_barrier(bar); STAMP(2);
    PH(2) DUP(2) {
        pg8::Gemm g{H, Win, T, NPROJ, DM}; pg8::StaticOrder S; S.init(T, NPROJ, G, bx);
        pg8::EpiProj E{PROJ, NPROJ, 8, 8, 12, QSCALE};
        pg8::gemm_phase<pg8::EpiProj, pg8::StaticOrder, true, true>(lds, g, S, E, wave_s);
    }
    PH(9) DUP(2) {
        pg8::Gemm g{Win + (size_t)NPROJ * DM, H, 1024, T, DM}; pg8::StaticOrder S; S.init(1024, T, G, bx);
        pg8::EpiProj E{VT, T, 0, 0, 0, 1.f};
        pg8::gemm_phase<pg8::EpiProj, pg8::StaticOrder, true, true>(lds, g, S, E, wave_s);
    }
    xcd_barrier(bar); STAMP(3);
    PH(3) DUP(3) phase_mixers(p, lds, vcu, G, wave_s);
    xcd_barrier(bar); STAMP(4);
    PH(4) DUP(4) {
        pg8::Gemm g{O, Wout, T, DM, DM}; pg8::PanelOrder S; S.init(T, DM, G, bx);
        pg8::EpiResNorm<0> E{p.x, X1, mod + 2 * DM, SS1, (unsigned*)(ws + WS_CNT1), H, p.norm2_g, mod, 3, nullptr, nullptr, lds + 131072};
        pg8::gemm_phase<pg8::EpiResNorm<0>, pg8::PanelOrder, true, true>(lds, g, S, E, wave_s);
    }
    xcd_barrier(bar); STAMP(5);
    PH(6) DUP(6) {
        pg8::Gemm g{H, Wgu, T, 2 * DFF, DM}; pg8::StaticOrder S; S.init(T, 2 * DFF, G, bx);
        pg8::EpiGU E{GU, DFF};
        pg8::gemm_phase<pg8::EpiGU, pg8::StaticOrder, true, true>(lds, g, S, E, wave_s);
    }
    xcd_barrier(bar); STAMP(6);
    PH(7) {
        pg8::Gemm g{GU, Wdn, T, DM, DFF}; pg8::PanelOrder S; S.init(T, DM, G, bx);
        pg8::EpiResNorm<1> E{X1, X1, mod + 5 * DM, SS2, (unsigned*)(ws + WS_CNT2), nullptr, nullptr, nullptr, 0, p.out, p.final_g, lds + 131072};
        pg8::gemm_phase<pg8::EpiResNorm<1>, pg8::PanelOrder, true, true>(lds, g, S, E, wave_s);
    }
#if TS_SEL >= 0
    xcd_barrier(bar); STAMP(7);
    xcd_barrier(bar);
    { const unsigned long long t0 = __hip_atomic_load(tsb + TS_SEL, __ATOMIC_RELAXED, __HIP_MEMORY_SCOPE_AGENT), t1 = __hip_atomic_load(tsb + TS_SEL + 1, __ATOMIC_RELAXED, __HIP_MEMORY_SCOPE_AGENT);
#ifdef TS_CAL
      const float pert = 1.0f + sqrtf((float)TS_CAL * 8e-7f * TS_SCALE) + 0.0f * (float)(t1 - t0);
#else
      const float pert = 1.0f + sqrtf((float)(t1 - t0) * 0.01f * 8e-7f * TS_SCALE);
#endif
      for (size_t i = (size_t)bx * NTHREADS + fresh_tid(wave_s); i < (size_t)SEQ * DM / 4; i += (size_t)G * NTHREADS) { f32x4 v = ((f32x4*)p.out)[i]; v = v * pert; ((f32x4*)p.out)[i] = v; } }
#endif
}

extern "C" void kernel_launch(void* const* d_in, const int* in_sizes, int n_in, void* d_out, int out_size, void* d_ws, size_t ws_size, hipStream_t stream) {
    static int grid_blocks = 0;
    if (grid_blocks == 0) {
        if (n_in != 16 || ws_size < WS_END) { fprintf(stderr, "kernel_launch: unexpected n_in %d / ws_size %zu (need %zu)\n", n_in, ws_size, (size_t)WS_END); grid_blocks = -1; return; }
        int dev = 0, cus = 0, per_cu = 0;
        (void)hipGetDevice(&dev);
        (void)hipDeviceGetAttribute(&cus, hipDeviceAttributeMultiprocessorCount, dev);
        if (hipFuncSetAttribute((const void*)fwd_megakernel, hipFuncAttributeMaxDynamicSharedMemorySize, LDS_BYTES) != hipSuccess) { fprintf(stderr, "kernel_launch: hipFuncSetAttribute failed\n"); grid_blocks = -1; return; }
        if (hipOccupancyMaxActiveBlocksPerMultiprocessor(&per_cu, (const void*)fwd_megakernel, NTHREADS, LDS_BYTES) != hipSuccess || per_cu < 1) { fprintf(stderr, "kernel_launch: occupancy query says %d\n", per_cu); per_cu = 1; }
        (void)hipGetLastError();
        if (cus != 256) { fprintf(stderr, "kernel_launch: built for a 256-CU device (the fused-norm epilogues need exactly 256 workgroups); found %d CUs, nothing launched\n", cus); grid_blocks = -1; return; }
        grid_blocks = cus * 1;
    }
    if (grid_blocks < 0) return;
    if (hipMemsetAsync((char*)d_ws + WS_BAR, 0, 49152, stream) != hipSuccess) { fprintf(stderr, "kernel_launch: memset failed\n"); return; }
    Params p{};
    p.x = (const float*)d_in[0]; p.c = (const float*)d_in[1]; p.w_ada = (const float*)d_in[2]; p.b_ada = (const float*)d_in[3]; p.norm1_g = (const float*)d_in[4];
    p.w_in = (const float*)d_in[5]; p.v_norm_g = (const float*)d_in[6]; p.w_spatial = (const float*)d_in[7]; p.b_spatial = (const float*)d_in[8]; p.out_norm_g = (const float*)d_in[9];
    p.w_out = (const float*)d_in[10]; p.norm2_g = (const float*)d_in[11]; p.w_gate = (const float*)d_in[12]; p.w_up = (const float*)d_in[13]; p.w_down = (const float*)d_in[14]; p.final_g = (const float*)d_in[15];
    p.out = (float*)d_out; p.ws = (unsigned char*)d_ws;
    void* args[] = {&p};
    hipError_t e = hipLaunchCooperativeKernel((const void*)fwd_megakernel, dim3(grid_blocks), dim3(NTHREADS), args, LDS_BYTES, stream);
    if (e != hipSuccess) fprintf(stderr, "cooperative launch failed: %s (grid %d)\n", hipGetErrorString(e), grid_blocks);
}
```

```cpp
#include <hip/hip_runtime.h>
#include <hip/hip_cooperative_groups.h>
#include <cstdio>
#include <cstdint>
namespace cg = cooperative_groups;
__device__ __forceinline__ int lane_id() { int l; asm volatile("v_mbcnt_lo_u32_b32 %0, -1, 0\n\tv_mbcnt_hi_u32_b32 %0, -1, %0" : "=&v"(l)); return l; }
__device__ __forceinline__ int fresh_tid(int wave_s) { int t = (wave_s << 6) | lane_id(); asm volatile("" : "+v"(t)); return t; }
#ifndef TS_SEL
#define TS_SEL -1
#endif
#ifndef TS_SCALE
#define TS_SCALE 1.0f
#endif
namespace pg8 {
#define PG8_LAS __attribute__((address_space(3)))
typedef unsigned short bf16_t;
typedef short bf16x8 __attribute__((ext_vector_type(8)));
typedef float f32x4 __attribute__((ext_vector_type(4)));
typedef unsigned u32x4 __attribute__((ext_vector_type(4)));
constexpr int BM = 256, BK = 64, HALF = 128, HTB = HALF * BK * 2  , STAGE_BYTES = 8 * HTB, NXCD = 8, WGM = 8;

__host__ __device__ __forceinline__ int lds_byte(int r, int c) { const int st = (r >> 4) * 2 + (c >> 5), rr = r & 15, cc = c & 31, ob = rr * 64 + cc * 2; return st * 1024 + (ob ^ (((ob >> 9) & 1) << 5)); }
__host__ __device__ __forceinline__ void stage_rc(int b, int& R, int& C) { const int st = b / 1024, sb = b % 1024, swz = sb ^ (((sb >> 9) & 1) << 5); R = (st >> 1) * 16 + swz / 64; C = (st & 1) * 32 + (swz % 64) / 2; }
__host__ __device__ __forceinline__ int perm32(int rho) { const int n = rho >> 4, i = rho & 15; return 8 * (i >> 2) + 4 * n + (i & 3); }

struct Unit { int pm, pn; };
struct Gemm { const bf16_t* A; const bf16_t* Bt; int M, N, K; };

struct StaticOrder {
    int nM, nN, nwg, G, c;
    __host__ __device__ void init(int M, int N, int G_, int c_) { nM = M / BM; nN = N / BM; nwg = nM * nN; G = G_; c = c_; }
    __host__ __device__ bool next(int i, Unit& u) const {
        const long L = (long)i * G + c; if (L >= nwg) return false;
        int wgid = (int)L; { const int q = nwg / NXCD, r = nwg % NXCD, xcd = wgid % NXCD, off = wgid / NXCD; wgid = (xcd < r ? xcd * (q + 1) : r * (q + 1) + (xcd - r) * q) + off; }
        const int nig = WGM * nN, gid = wgid / nig, fm = gid * WGM, gsz = (nM - fm) < WGM ? (nM - fm) : WGM;
        u.pm = fm + ((wgid % nig) % gsz); u.pn = (wgid % nig) / gsz; return true;
    }
    __device__ __forceinline__ void a_ready(const Unit&) const {}
    __device__ __forceinline__ void done(const Unit&) const {}
};

__device__ __forceinline__ unsigned cvt_pk_bf16(float lo, float hi) { unsigned r; asm("v_cvt_pk_bf16_f32 %0, %1, %2" : "=v"(r) : "v"(lo), "v"(hi)); return r; }
typedef float f32x2 __attribute__((ext_vector_type(2)));
__device__ __forceinline__ f32x2 gelu_pk(f32x2 v) {
    const f32x2 av = __builtin_elementwise_abs(v), d = av * 0.2316418882f + 1.0f;
    f32x2 t; t.x = __builtin_amdgcn_rcpf(d.x); t.y = __builtin_amdgcn_rcpf(d.y);
    f32x2 q = t * 0.5307027145f + (-0.7265760135f); q = q * t + 0.7107068705f; q = q * t + (-0.142248368f); q = q * t + 0.127414796f; q = q * t;
    const f32x2 s = (v * v) * (-0.72134752044f);
    f32x2 e; e.x = __builtin_amdgcn_exp2f(s.x); e.y = __builtin_amdgcn_exp2f(s.y);
    const f32x2 m = v * (q * e), r = v - m;
    f32x2 o; o.x = v.x < 0.f ? m.x : r.x; o.y = v.y < 0.f ? m.y : r.y; return o;
}

struct EpiProj {
    static constexpr bool PERM = true, AFTER_DRAIN = false;
    bf16_t* O; int ldc; int gelu_tiles; int sc_lo, sc_hi; float sc;
    __device__ __forceinline__ void operator()(f32x4 (&acc)[2][2][4][2], const Unit& u, int wr, int wc, int fr, int fq, bool last) const {
        const int row0 = u.pm * BM + wr * 64 + fr, col0 = u.pn * BM + wc * 32 + 8 * fq;
        const bool g = u.pn < gelu_tiles; const float s = (u.pn >= sc_lo && u.pn < sc_hi) ? sc : 1.f;
#pragma unroll
        for (int ai = 0; ai < 2; ++ai)
#pragma unroll
            for (int m = 0; m < 4; ++m) { bf16_t* rowp = O + (size_t)(row0 + ai * HALF + m * 16) * ldc + col0;
#pragma unroll
                for (int bj = 0; bj < 2; ++bj) { f32x4 v0 = acc[ai][bj][m][0], v1 = acc[ai][bj][m][1];
                    if (g) { f32x2 a = gelu_pk((f32x2){v0[0], v0[1]}), b = gelu_pk((f32x2){v0[2], v0[3]}), c = gelu_pk((f32x2){v1[0], v1[1]}), d = gelu_pk((f32x2){v1[2], v1[3]});
                        v0 = (f32x4){a.x, a.y, b.x, b.y}; v1 = (f32x4){c.x, c.y, d.x, d.y}; }
                    v0 = v0 * s; v1 = v1 * s; u32x4 w; w.x = cvt_pk_bf16(v0[0], v0[1]); w.y = cvt_pk_bf16(v0[2], v0[3]); w.z = cvt_pk_bf16(v1[0], v1[1]); w.w = cvt_pk_bf16(v1[2], v1[3]);
                    *(u32x4*)(rowp + bj * HALF) = w; } }
    }
};
template <int MODE> struct EpiResNorm {
    static constexpr bool PERM = true, AFTER_DRAIN = false;
    static constexpr int MB = 2;
    const void* base; bf16_t* xres; const float* gate; float* ssq; unsigned* cnt;
    bf16_t* H; const float* ng; const float* modp; int shift_chunk;
    float* outf; const float* fg;
    PG8_LAS unsigned char* lx;
    __device__ __forceinline__ static void unpack8(const u32x4 raw, f32x4& a, f32x4& b) {
        a = (f32x4){__uint_as_float(raw.x << 16), __uint_as_float(raw.x & 0xffff0000u), __uint_as_float(raw.y << 16), __uint_as_float(raw.y & 0xffff0000u)};
        b = (f32x4){__uint_as_float(raw.z << 16), __uint_as_float(raw.z & 0xffff0000u), __uint_as_float(raw.w << 16), __uint_as_float(raw.w & 0xffff0000u)}; }
    __device__ __forceinline__ static u32x4 pack8(const f32x4 a, const f32x4 b) { u32x4 w; w.x = cvt_pk_bf16(a[0], a[1]); w.y = cvt_pk_bf16(a[2], a[3]); w.z = cvt_pk_bf16(b[0], b[1]); w.w = cvt_pk_bf16(b[2], b[3]); return w; }
    __device__ __forceinline__ void operator()(f32x4 (&acc)[2][2][4][2], const Unit& u, int wr, int wc, int fr, int fq, bool last) const {
        const int lane = fr + 16 * fq, wid = wr * 4 + wc;
        const int rl0 = wr * 64 + fr, row0 = u.pm * BM + rl0, col0 = u.pn * BM + wc * 32 + 8 * fq;
        const int b = u.pm >> 3;
        PG8_LAS float* P = (PG8_LAS float*)lx;
        PG8_LAS float* S = (PG8_LAS float*)(lx + 4096);
        {
            f32x4 gv[2][2];
#pragma unroll
            for (int bj = 0; bj < 2; ++bj)
#pragma unroll
                for (int n = 0; n < 2; ++n) gv[bj][n] = *(const f32x4*)(gate + (size_t)b * 12288 + col0 + bj * HALF + n * 4);
            constexpr int EB = (MODE == 1) ? 2 : 4;
            const char* bp = (const char*)base + ((size_t)(u.pm * BM + rl0) * 2048 + col0) * EB;
            char* xp = (char*)xres + ((size_t)(u.pm * BM + rl0) * 2048 + col0) * 2;
            constexpr size_t RS = (size_t)16 * 2048;
#pragma unroll
            for (int ai = 0; ai < 2; ++ai)
#pragma unroll
                for (int mp = 0; mp < 4 / MB; ++mp) {
                    asm volatile("" : "+v"(bp), "+v"(xp));
                    f32x4 b0[MB][2], b1[MB][2];
#pragma unroll
                    for (int mi = 0; mi < MB; ++mi)
#pragma unroll
                        for (int bj = 0; bj < 2; ++bj) {
                            if (MODE == 1) { const u32x4 raw = *(const u32x4*)(bp + (mi * RS + bj * HALF) * EB); unpack8(raw, b0[mi][bj], b1[mi][bj]); }
                            else { b0[mi][bj] = *(const f32x4*)(bp + (mi * RS + bj * HALF) * EB); b1[mi][bj] = *(const f32x4*)(bp + (mi * RS + bj * HALF) * EB + 16); } }
#pragma unroll
                    for (int mi = 0; mi < MB; ++mi) { const int m = MB * mp + mi; const int rl = rl0 + ai * HALF + m * 16; float ss = 0.f;
#pragma unroll
                        for (int bj = 0; bj < 2; ++bj) {
                            const f32x4 o0 = b0[mi][bj] + gv[bj][0] * acc[ai][bj][m][0], o1 = b1[mi][bj] + gv[bj][1] * acc[ai][bj][m][1];
                            ss += ((o0[0] * o0[0] + o0[1] * o0[1]) + (o0[2] * o0[2] + o0[3] * o0[3])) + ((o1[0] * o1[0] + o1[1] * o1[1]) + (o1[2] * o1[2] + o1[3] * o1[3]));
                            acc[ai][bj][m][0] = o0; acc[ai][bj][m][1] = o1;
                            if (MODE == 0) *(u32x4*)(xp + (mi * RS + bj * HALF) * 2) = pack8(o0, o1); }
                        ss += __shfl_xor(ss, 16); ss += __shfl_xor(ss, 32);
                        if (fq == 0) P[rl * 4 + wc] = ss; }
                    const size_t rstep = (size_t)((mp == 4 / MB - 1) ? (HALF - 48 + (MB - 1) * 16) : 16 * MB) * 2048;
                    bp += rstep * EB; xp += rstep * 2;
                    asm volatile("" ::: "memory"); }
        }
        asm volatile("s_waitcnt lgkmcnt(0)" ::: "memory"); __builtin_amdgcn_s_barrier(); asm volatile("" ::: "memory");
        if (lane < 32) { const int rl = wid * 32 + lane; const f32x4 pv = *(const PG8_LAS f32x4*)(P + rl * 4);
            __hip_atomic_store(ssq + (size_t)(u.pm * BM + rl) * 8 + u.pn, (pv[0] + pv[1]) + (pv[2] + pv[3]), __ATOMIC_RELAXED, __HIP_MEMORY_SCOPE_AGENT); }
        asm volatile("s_waitcnt vmcnt(0)" ::: "memory");
        if (lane == 0) __hip_atomic_fetch_add(cnt + 64 * u.pm, 1u, __ATOMIC_RELAXED, __HIP_MEMORY_SCOPE_AGENT);
        if (wid == 0) { unsigned sp = 0;
            while ((unsigned)__builtin_amdgcn_readfirstlane(__hip_atomic_load(cnt + 64 * u.pm, __ATOMIC_RELAXED, __HIP_MEMORY_SCOPE_AGENT)) < 64u) { __builtin_amdgcn_s_sleep(2); if (++sp > (1u << 20)) break; }
            __builtin_amdgcn_fence(__ATOMIC_ACQUIRE, "agent");
            asm volatile("s_waitcnt vmcnt(0)" ::: "memory"); }
        asm volatile("s_waitcnt vmcnt(0) lgkmcnt(0)" ::: "memory"); __builtin_amdgcn_s_barrier(); asm volatile("" ::: "memory");
        { const int t = wid * 64 + lane;
          if (t < 256) { const unsigned long long* sp8 = (const unsigned long long*)(ssq + (size_t)(u.pm * BM + t) * 8); float s = 0.f;
#pragma unroll
              for (int q = 0; q < 4; ++q) { const unsigned long long w = __hip_atomic_load(sp8 + q, __ATOMIC_RELAXED, __HIP_MEMORY_SCOPE_AGENT); s += __uint_as_float((unsigned)w) + __uint_as_float((unsigned)(w >> 32)); }
              S[t] = 1.0f / sqrtf(s * (1.0f / 2048.0f) + 1e-6f); } }
        asm volatile("s_waitcnt lgkmcnt(0)" ::: "memory"); __builtin_amdgcn_s_barrier(); asm volatile("" ::: "memory");
        {
            const int cbase = col0;
            f32x4 A[2][2], B[2][2];
#pragma unroll
            for (int bj = 0; bj < 2; ++bj)
#pragma unroll
                for (int n = 0; n < 2; ++n) { const int c = cbase + bj * HALF + n * 4;
                    if (MODE == 0) { A[bj][n] = *(const f32x4*)(ng + c) * (*(const f32x4*)(modp + (size_t)b * 12288 + (shift_chunk + 1) * 2048 + c) + 1.0f); B[bj][n] = *(const f32x4*)(modp + (size_t)b * 12288 + shift_chunk * 2048 + c); }
                    else { A[bj][n] = *(const f32x4*)(fg + c); B[bj][n] = (f32x4){0.f, 0.f, 0.f, 0.f}; } }
#pragma unroll
            for (int ai = 0; ai < 2; ++ai)
#pragma unroll
                for (int m = 0; m < 4; ++m) { const int rl = rl0 + ai * HALF + m * 16; const float rs = S[rl]; const size_t off = (size_t)(u.pm * BM + rl) * 2048 + cbase;
#pragma unroll
                    for (int bj = 0; bj < 2; ++bj) {
                        const f32x4 o0 = (acc[ai][bj][m][0] * rs) * A[bj][0] + B[bj][0], o1 = (acc[ai][bj][m][1] * rs) * A[bj][1] + B[bj][1];
                        if (MODE == 0) *(u32x4*)(H + off + bj * HALF) = pack8(o0, o1);
                        else { *(f32x4*)(outf + off + bj * HALF) = o0; *(f32x4*)(outf + off + bj * HALF + 4) = o1; } } }
        }
    }
};
struct EpiGU {
    static constexpr bool PERM = true, AFTER_DRAIN = false;
    bf16_t* O; int ldc;
    __device__ __forceinline__ void operator()(f32x4 (&acc)[2][2][4][2], const Unit& u, int wr, int wc, int fr, int fq, bool last) const {
        const int row0 = u.pm * BM + wr * 64 + fr, col0 = u.pn * HALF + wc * 32 + 8 * fq;
#pragma unroll
        for (int ai = 0; ai < 2; ++ai)
#pragma unroll
            for (int m = 0; m < 4; ++m) { bf16_t* rowp = O + (size_t)(row0 + ai * HALF + m * 16) * ldc + col0; float v[8];
#pragma unroll
                for (int n = 0; n < 2; ++n)
#pragma unroll
                    for (int j = 0; j < 4; ++j) { const float g = acc[ai][0][m][n][j], up = acc[ai][1][m][n][j];
                        const float e = __builtin_amdgcn_exp2f(g * (-1.44269504089f)); v[n * 4 + j] = g * __builtin_amdgcn_rcpf(1.0f + e) * up; }
                u32x4 w; w.x = cvt_pk_bf16(v[0], v[1]); w.y = cvt_pk_bf16(v[2], v[3]); w.z = cvt_pk_bf16(v[4], v[5]); w.w = cvt_pk_bf16(v[6], v[7]);
                *(u32x4*)rowp = w; }
    }
};

struct PanelOrder {
    int c;
    __host__ __device__ void init(int, int, int, int c_) { c = c_; }
    __host__ __device__ bool next(int i, Unit& u) const { if (i >= 2) return false; const int o = c >> 3; u.pm = 8 * (c & 7) + 4 * i + (o & 3); u.pn = o >> 2; return true; }
    __device__ __forceinline__ void a_ready(const Unit&) const {}
    __device__ __forceinline__ void done(const Unit&) const {}
};
template <class Epi, class Sched, bool ALIGN_EPI = false, bool SP2 = false>
__device__ __forceinline__ void gemm_phase(PG8_LAS unsigned char* lds, const Gemm g, const Sched& S, const Epi& E, const int wave_s) {
    const int tid = fresh_tid(wave_s), wid = wave_s, lane = tid & 63, wr = wid >> 2, wc = wid & 3, fr = lane & 15, fq = lane >> 4;
    const int K = g.K, nt = K / BK;
    unsigned voffA[2], voffB[2];
#pragma unroll
    for (int i = 0; i < 2; ++i) { int R, C; stage_rc(tid * 16 + i * 8192, R, C); const int Rb = Epi::PERM ? ((R & ~31) + perm32(R & 31)) : R;
        voffA[i] = (unsigned)(R * K + C) * 2u; voffB[i] = (unsigned)(Rb * K + C) * 2u; }
    const size_t kstep = (size_t)(BK * 2);
    const size_t hstep = (size_t)HALF * K * 2;
    const size_t tstep = 2 * hstep;
    const unsigned ldsw = (unsigned)wid * 1024u;
    const int aoff = lds_byte(wr * 64 + fr, fq * 8), boff = lds_byte(wc * 32 + fr, fq * 8);
#define PG8_SA(b, h) (((b) * 2 + (h)) * HTB)
#define PG8_SB(b, h) ((4 + (b) * 2 + (h)) * HTB)
#define PG8_STAGE(bufoff, gbase, voff) do { _Pragma("unroll") for (int _i = 0; _i < 2; ++_i) \
        __builtin_amdgcn_global_load_lds((const unsigned*)((const char*)(gbase) + (voff)[_i]), (PG8_LAS unsigned*)(lds + (bufoff) + ldsw + _i * 8192), 16, 0, 0); } while (0)
#define PG8_LDA(dst, b, h) do { _Pragma("unroll") for (int m = 0; m < 4; ++m) _Pragma("unroll") for (int k = 0; k < 2; ++k) dst[m][k] = *(const PG8_LAS bf16x8*)(lds + PG8_SA(b, h) + aoff + m * 2048 + k * 1024); } while (0)
#define PG8_LDB(dst, b, h) do { _Pragma("unroll") for (int n = 0; n < 2; ++n) _Pragma("unroll") for (int k = 0; k < 2; ++k) dst[n][k] = *(const PG8_LAS bf16x8*)(lds + PG8_SB(b, h) + boff + n * 2048 + k * 1024); } while (0)
#define PG8_MMA(ai, bj, At, Bt) do { __builtin_amdgcn_s_setprio(1); _Pragma("unroll") for (int m = 0; m < 4; ++m) _Pragma("unroll") for (int n = 0; n < 2; ++n) _Pragma("unroll") for (int k = 0; k < 2; ++k) \
        acc[ai][bj][m][n] = __builtin_amdgcn_mfma_f32_16x16x32_bf16(Bt[n][k], At[m][k], acc[ai][bj][m][n], 0, 0, 0); __builtin_amdgcn_s_setprio(0); } while (0)
#define PG8_WAIT_V(n) asm volatile("s_waitcnt vmcnt(" #n ")" ::: "memory")
#define PG8_WAIT_L(n) asm volatile("s_waitcnt lgkmcnt(" #n ")" ::: "memory")
#define PG8_BAR __builtin_amdgcn_s_barrier()
#define PG8_SCHED __builtin_amdgcn_sched_barrier(0)
    Unit cur, nxt; int ui = 0;
    if (!S.next(0, cur)) return;
    f32x4 acc[2][2][4][2];
#pragma unroll
    for (int a = 0; a < 2; ++a)
#pragma unroll
        for (int b = 0; b < 2; ++b)
#pragma unroll
            for (int m = 0; m < 4; ++m)
#pragma unroll
                for (int n = 0; n < 2; ++n) acc[a][b][m][n] = (f32x4){0.f, 0.f, 0.f, 0.f};
    bf16x8 At[4][2], B0[2][2], B1[2][2];
    const char* cA = (const char*)g.A + (size_t)cur.pm * tstep; const char* cB = (const char*)g.Bt + (size_t)cur.pn * tstep;
    S.a_ready(cur);
    if constexpr (SP2) {
        PG8_STAGE(PG8_SB(0, 0), cB, voffB); PG8_STAGE(PG8_SB(0, 1), cB + hstep, voffB); PG8_STAGE(PG8_SA(0, 0), cA, voffA); PG8_STAGE(PG8_SA(0, 1), cA + hstep, voffA);
        if (wr == 1) PG8_BAR;
        PG8_WAIT_V(2); PG8_BAR;
        PG8_STAGE(PG8_SB(1, 0), cB + kstep, voffB); PG8_STAGE(PG8_SA(1, 0), cA + kstep, voffA); PG8_STAGE(PG8_SB(1, 1), cB + hstep + kstep, voffB);
        PG8_WAIT_V(6); PG8_BAR;
    } else {
        PG8_STAGE(PG8_SB(0, 0), cB, voffB); PG8_STAGE(PG8_SA(0, 0), cA, voffA); PG8_STAGE(PG8_SB(0, 1), cB + hstep, voffB); PG8_STAGE(PG8_SA(0, 1), cA + hstep, voffA);
        if (wr == 1) PG8_BAR;
        PG8_WAIT_V(4); PG8_BAR;
        PG8_STAGE(PG8_SB(1, 0), cB + kstep, voffB); PG8_STAGE(PG8_SA(1, 0), cA + kstep, voffA); PG8_STAGE(PG8_SB(1, 1), cB + hstep + kstep, voffB);
        PG8_WAIT_V(6); PG8_BAR;
    }
    for (;;) {
        const bool has_next = S.next(ui + 1, nxt);
        const char* nA = has_next ? (const char*)g.A + (size_t)nxt.pm * tstep : cA; const char* nB = has_next ? (const char*)g.Bt + (size_t)nxt.pn * tstep : cB;
        for (int t = 0; t < nt; t += 2) {
            const bool last = (t == nt - 2);
            const char* a1 = cA + (size_t)(t + 1) * kstep;
            const char* a2 = last ? nA : cA + (size_t)(t + 2) * kstep; const char* b2 = last ? nB : cB + (size_t)(t + 2) * kstep;
            const char* a3 = a2 + kstep; const char* b3 = b2 + kstep;
            if (last && has_next) S.a_ready(nxt);
            if constexpr (SP2) {
            PG8_LDB(B0, 0, 0); PG8_LDB(B1, 0, 1); PG8_SCHED; PG8_LDA(At, 0, 0); PG8_STAGE(PG8_SA(1, 1), a1 + hstep, voffA);
            PG8_WAIT_V(8); PG8_WAIT_L(0); PG8_BAR; PG8_MMA(0, 0, At, B0); PG8_MMA(0, 1, At, B1); PG8_BAR; PG8_SCHED;
            PG8_LDA(At, 0, 1); PG8_STAGE(PG8_SB(0, 0), b2, voffB); PG8_STAGE(PG8_SB(0, 1), b2 + hstep, voffB); PG8_STAGE(PG8_SA(0, 0), a2, voffA);
            PG8_WAIT_V(8); PG8_WAIT_L(0); PG8_BAR; PG8_MMA(1, 0, At, B0); PG8_MMA(1, 1, At, B1); PG8_BAR; PG8_SCHED;
            PG8_LDB(B0, 1, 0); PG8_LDB(B1, 1, 1); PG8_SCHED; PG8_LDA(At, 1, 0); PG8_STAGE(PG8_SA(0, 1), a2 + hstep, voffA);
            PG8_WAIT_V(8); PG8_WAIT_L(0); PG8_BAR; PG8_MMA(0, 0, At, B0); PG8_MMA(0, 1, At, B1); PG8_BAR; PG8_SCHED;
            PG8_LDA(At, 1, 1); PG8_STAGE(PG8_SB(1, 0), b3, voffB); PG8_STAGE(PG8_SB(1, 1), b3 + hstep, voffB); PG8_STAGE(PG8_SA(1, 0), a3, voffA);
            PG8_WAIT_V(8); PG8_WAIT_L(0); PG8_BAR; PG8_MMA(1, 0, At, B0); PG8_MMA(1, 1, At, B1); PG8_BAR; PG8_SCHED;
            } else {
            PG8_LDB(B0, 0, 0); PG8_SCHED; PG8_LDA(At, 0, 0); PG8_STAGE(PG8_SA(1, 1), a1 + hstep, voffA);
            PG8_WAIT_L(8); PG8_BAR; PG8_WAIT_L(0); PG8_MMA(0, 0, At, B0); PG8_BAR; PG8_SCHED;
            PG8_LDB(B1, 0, 1); PG8_STAGE(PG8_SB(0, 0), b2, voffB);
            PG8_BAR; PG8_WAIT_L(0); PG8_MMA(0, 1, At, B1); PG8_BAR;
            PG8_LDA(At, 0, 1); PG8_STAGE(PG8_SA(0, 0), a2, voffA);
            PG8_BAR; PG8_WAIT_L(0); PG8_MMA(1, 0, At, B0); PG8_BAR; PG8_SCHED;
            PG8_STAGE(PG8_SB(0, 1), b2 + hstep, voffB);
            PG8_WAIT_V(6); PG8_BAR; PG8_MMA(1, 1, At, B1); PG8_BAR;
            PG8_LDB(B0, 1, 0); PG8_SCHED; PG8_LDA(At, 1, 0); PG8_STAGE(PG8_SA(0, 1), a2 + hstep, voffA);
            PG8_WAIT_L(8); PG8_BAR; PG8_WAIT_L(0); PG8_MMA(0, 0, At, B0); PG8_BAR; PG8_SCHED;
            PG8_LDB(B1, 1, 1); PG8_STAGE(PG8_SB(1, 0), b3, voffB);
            PG8_BAR; PG8_WAIT_L(0); PG8_MMA(0, 1, At, B1); PG8_BAR;
            PG8_LDA(At, 1, 1); PG8_STAGE(PG8_SA(1, 0), a3, voffA);
            PG8_BAR; PG8_WAIT_L(0); PG8_MMA(1, 0, At, B0); PG8_BAR; PG8_SCHED;
            PG8_STAGE(PG8_SB(1, 1), b3 + hstep, voffB);
            PG8_WAIT_V(6); PG8_BAR; PG8_MMA(1, 1, At, B1); PG8_BAR;
            }
        }
        if constexpr (ALIGN_EPI) { if (wr == 0) PG8_BAR; }
        if constexpr (!Epi::AFTER_DRAIN) { E(acc, cur, wr, wc, fr, fq, !has_next); S.done(cur); }
        if (!has_next) break;
#pragma unroll
        for (int a = 0; a < 2; ++a)
#pragma unroll
            for (int b = 0; b < 2; ++b)
#pragma unroll
                for (int m = 0; m < 4; ++m)
#pragma unroll
                    for (int n = 0; n < 2; ++n) acc[a][b][m][n] = (f32x4){0.f, 0.f, 0.f, 0.f};
        cur = nxt; cA = nA; cB = nB; ++ui;
        if constexpr (ALIGN_EPI) { if (wr == 1) PG8_BAR; }
    }
    PG8_WAIT_V(0);
    if constexpr (!ALIGN_EPI) { if (wr == 0) PG8_BAR; }
    PG8_BAR;
    if constexpr (Epi::AFTER_DRAIN) { E.fused(acc, cur, wr, wc, fr, fq, lds, wid, lane); S.done(cur); }
#undef PG8_SA
#undef PG8_SB
#undef PG8_STAGE
#undef PG8_LDA
#undef PG8_LDB
#undef PG8_MMA
#undef PG8_WAIT_V
#undef PG8_WAIT_L
#undef PG8_BAR
#undef PG8_SCHED
}
}

constexpr int NB = 8, SEQ = 2048, DM = 2048, T = NB * SEQ;
constexpr int DFF = 5632, NIN = 5120, NMOD = 6 * DM;
constexpr int NPROJ = 4096;
constexpr float EPS = 1e-6f;
constexpr int NTHREADS = 512, NWAVES = 8;
constexpr int LDS_BYTES = 147456;
constexpr float QSCALE = 0.08838834764831845f * 1.4426950408889634f;

constexpr size_t MiB = 1u << 20;
constexpr size_t WS_BAR = 0;
constexpr size_t WS_MODCNT = 15360;
constexpr size_t WS_CNT1 = 16384, WS_CNT2 = 32768;
constexpr size_t WS_MOD = 512 * 1024;
constexpr size_t WS_SS1 = 1 * MiB;
constexpr size_t WS_SS2 = 3 * MiB;
constexpr size_t WS_WIN = 6 * MiB;
constexpr size_t WS_WOUT = 26 * MiB;
constexpr size_t WS_WGU = 34 * MiB;
constexpr size_t WS_WDN = 78 * MiB;
constexpr size_t WS_H = 100 * MiB;
constexpr size_t WS_PROJ = 164 * MiB;
constexpr size_t WS_VT = 292 * MiB;
constexpr size_t WS_O = 324 * MiB;
constexpr size_t WS_GU = 164 * MiB;
constexpr size_t WS_X1 = 388 * MiB;
constexpr size_t WS_END = 452 * MiB;
static_assert(WS_GU + (size_t)T * DFF * 2 <= WS_END, "ws map");

#define LAS __attribute__((address_space(3)))
typedef unsigned short bf16;
typedef unsigned v4u __attribute__((ext_vector_type(4)));
typedef unsigned v2u __attribute__((ext_vector_type(2)));
typedef float f32x4 __attribute__((ext_vector_type(4)));
typedef short bf16x8 __attribute__((ext_vector_type(8)));
typedef short bf16x4 __attribute__((ext_vector_type(4)));

__device__ __forceinline__ unsigned pk2(float lo, float hi) { return pg8::cvt_pk_bf16(lo, hi); }
__device__ __forceinline__ float bflo(unsigned w) { return __uint_as_float(w << 16); }
__device__ __forceinline__ float bfhi(unsigned w) { return __uint_as_float(w & 0xffff0000u); }
__device__ __forceinline__ float wave_sum(float v) {
#pragma unroll
    for (int o = 1; o < 64; o <<= 1) v += __shfl_xor(v, o);
    return v;
}

struct Params {
    const float *x, *c, *w_ada, *b_ada, *norm1_g, *w_in, *v_norm_g, *w_spatial, *b_spatial, *out_norm_g, *w_out, *norm2_g, *w_gate, *w_up, *w_down, *final_g;
    float* out; unsigned char* ws;
};

constexpr int TSCR = 16640;
__device__ __forceinline__ void titem_decode(const Params& p, int it, int lane, const float*& tsrc, bf16*& tdst, int& tN, int& tK) {
    constexpr int I_IN = (DM / 64) * (NIN / 64), I_OUT = (DM / 64) * (DM / 64), I_G = (DM / 64) * (DFF / 64);
    bf16* Win = (bf16*)(p.ws + WS_WIN); bf16* Wout = (bf16*)(p.ws + WS_WOUT); bf16* Wgu = (bf16*)(p.ws + WS_WGU); bf16* Wdn = (bf16*)(p.ws + WS_WDN);
    int r = it, mid = 0;
    if (r >= I_IN) { r -= I_IN; mid = 1; if (r >= I_OUT) { r -= I_OUT; mid = 2; if (r >= I_G) { r -= I_G; mid = 3; if (r >= I_G) { r -= I_G; mid = 4; } } } }
#define TSEL(k, v) ((unsigned long long)(-(long long)(mid == (k))) & (unsigned long long)(v))
    const float* W = (const float*)(TSEL(0, p.w_in) | TSEL(1, p.w_out) | TSEL(2, p.w_gate) | TSEL(3, p.w_up) | TSEL(4, p.w_down));
    bf16* WT = (bf16*)(TSEL(0, Win) | TSEL(1, Wout) | TSEL(2, Wgu) | TSEL(3, Wgu) | TSEL(4, Wdn));
#undef TSEL
    const int K = (mid == 4) ? DFF : DM, N = (mid == 0) ? NIN : ((mid == 2 || mid == 3) ? DFF : DM);
    const bool gu = (mid == 2 || mid == 3); const int dadd = (mid == 3) ? 128 : 0; int nb;
    nb = N / 64; const int kb = r / nb, n0 = (r % nb) * 64, k0 = kb * 64;
    const int drow0 = gu ? ((n0 >> 7) * 256 + (n0 & 127) + dadd) : n0;
    tN = N; tK = K;
    tsrc = W + (size_t)(k0 + (lane >> 4)) * N + n0 + (lane & 15) * 4;
    tdst = WT + (size_t)(drow0 + (lane >> 3)) * K + k0 + 8 * (lane & 7);
}
constexpr int TR_IN = (DM / 64) * (NIN / 64);
constexpr int TR_ALL = (DM / 64) * (NIN / 64) + (DM / 64) * (DM / 64) + 2 * (DM / 64) * (DFF / 64) + (DFF / 64) * (DM / 64);
__device__ __forceinline__ void transpose_items_ex(const Params& p, LAS unsigned char* lds, const int first, const int NGW, const int it1, const int wave_s) {
    const int lane = fresh_tid(wave_s) & 63, wave = wave_s;
    LAS float* scr = (LAS float*)(lds + wave * TSCR);
    const int NITEMS = it1;
    {
        int it = first;
        f32x4 cur[16];
        const float* csrc; bf16* cdst; int cN, cK;
        titem_decode(p, it < NITEMS ? it : 0, lane, csrc, cdst, cN, cK);
        if (it < NITEMS) {
#pragma unroll
            for (int i = 0; i < 16; ++i) cur[i] = __builtin_nontemporal_load((const f32x4*)(csrc + (size_t)(4 * i) * cN));
        }
        while (it < NITEMS) {
            const int itn = it + NGW; const bool hn = itn < NITEMS;
            const float* nsrc; bf16* ndst; int nN, nK;
            titem_decode(p, hn ? itn : it, lane, nsrc, ndst, nN, nK);
            f32x4 nxt[16];
            if (hn) {
#pragma unroll
                for (int i = 0; i < 16; ++i) nxt[i] = __builtin_nontemporal_load((const f32x4*)(nsrc + (size_t)(4 * i) * nN));
            }
            const int lr = lane >> 4, lc = (lane & 15) * 4;
#pragma unroll
            for (int i = 0; i < 16; ++i) { LAS float* d = scr + (4 * i + lr) * 65 + lc; d[0] = cur[i][0]; d[1] = cur[i][1]; d[2] = cur[i][2]; d[3] = cur[i][3]; }
            asm volatile("s_waitcnt lgkmcnt(0)" ::: "memory");
            const int c = lane & 7;
#pragma unroll
            for (int j = 0; j < 8; ++j) { const LAS float* q = scr + (8 * c) * 65 + (lane >> 3) + 8 * j;
                v4u o; o.x = pk2(q[0 * 65], q[1 * 65]); o.y = pk2(q[2 * 65], q[3 * 65]); o.z = pk2(q[4 * 65], q[5 * 65]); o.w = pk2(q[6 * 65], q[7 * 65]);
                *(v4u*)(cdst + (size_t)(8 * j) * cK) = o; }
            asm volatile("s_waitcnt lgkmcnt(0)" ::: "memory");
            if (hn) {
#pragma unroll
                for (int i = 0; i < 16; ++i) cur[i] = nxt[i];
            }
            csrc = nsrc; cdst = ndst; cN = nN; cK = nK; it = itn;
        }
    }
}

__device__ __forceinline__ void transpose_items(const Params& p, LAS unsigned char* lds, const int it0, const int it1, const int vcu, const int G, const int wave_s) {
    transpose_items_ex(p, lds, it0 + vcu * NWAVES + wave_s, G * NWAVES, it1, wave_s);
}
__device__ __forceinline__ void phase_prep(const Params& p, LAS unsigned char* lds, int vcu, int G, const int wave_s) {
    const int tid = fresh_tid(wave_s), lane = tid & 63, wave = wave_s;
    LAS float* scr = (LAS float*)(lds + wave * TSCR);
    const int gw = vcu * NWAVES + wave, NGW = G * NWAVES;
    unsigned char* ws = p.ws;
    bf16* Win = (bf16*)(ws + WS_WIN); bf16* Wout = (bf16*)(ws + WS_WOUT); bf16* Wgu = (bf16*)(ws + WS_WGU); bf16* Wdn = (bf16*)(ws + WS_WDN);
    for (int cb = vcu; cb < NMOD / 64; cb += G) {
        float* mod = (float*)(ws + WS_MOD);
        const int kbase = 256 * wave, col = cb * 64 + lane;
#pragma unroll
        for (int b = 0; b < 8; ++b) { f32x4 cv = *(const f32x4*)(p.c + b * DM + kbase + lane * 4);
#pragma unroll
            for (int j = 0; j < 4; ++j) cv[j] = cv[j] / (1.0f + __expf(-cv[j]));
            *(LAS f32x4*)(scr + b * 256 + lane * 4) = cv; }
        asm volatile("s_waitcnt lgkmcnt(0)" ::: "memory");
        float a[8];
#pragma unroll
        for (int b = 0; b < 8; ++b) a[b] = 0.f;
        const float* wp = p.w_ada + (size_t)kbase * NMOD + col;
#pragma unroll 4
        for (int k4 = 0; k4 < 64; ++k4) {
            float wv[4];
#pragma unroll
            for (int i = 0; i < 4; ++i) wv[i] = __builtin_nontemporal_load(wp + (size_t)(4 * k4 + i) * NMOD);
#pragma unroll
            for (int b = 0; b < 8; ++b) { const f32x4 sv = *(const LAS f32x4*)(scr + b * 256 + 4 * k4); a[b] += (wv[0] * sv[0] + wv[1] * sv[1]) + (wv[2] * sv[2] + wv[3] * sv[3]); }
        }
        __syncthreads();
        LAS float* red = (LAS float*)lds;
#pragma unroll
        for (int b = 0; b < 8; ++b) red[(wave * 8 + b) * 64 + lane] = a[b];
        __syncthreads();
        { const int b = tid >> 6; float sacc = p.b_ada[col];
#pragma unroll
          for (int w2 = 0; w2 < 8; ++w2) sacc += red[(w2 * 8 + b) * 64 + lane];
          mod[(size_t)b * NMOD + col] = sacc; }
        asm volatile("s_waitcnt vmcnt(0)" ::: "memory");
        __syncthreads();
        if (tid == 0) { __builtin_amdgcn_fence(__ATOMIC_RELEASE, "agent"); __hip_atomic_fetch_add((unsigned*)(ws + WS_MODCNT), 1u, __ATOMIC_RELAXED, __HIP_MEMORY_SCOPE_AGENT); }
    }
    if (G == 256) {
        constexpr int NMB = NMOD / 64, MODW = NMB * NWAVES, SPLIT = MODW / 2;
        if (vcu < NMB) { const int m = vcu * NWAVES + wave_s; transpose_items_ex(p, lds, m, TR_IN  , m < SPLIT ? SPLIT : 0, wave_s); }
        else transpose_items_ex(p, lds, SPLIT + (vcu - NMB) * NWAVES + wave_s, (256 - NMB) * NWAVES, TR_IN, wave_s);
    } else transpose_items(p, lds, 0, TR_IN, vcu, G, wave_s);
}

template <int MODE>
__device__ __forceinline__ void phase_norm_mod(const Params& p, const void* srcv, const float* ssp, const float* ng, int shift_chunk, bf16* dst, int vcu, int G, const int wave_s) {
    const int tid = fresh_tid(wave_s), lane = tid & 63, wave = wave_s;
    const int gw = vcu * NWAVES + wave, NGW = G * NWAVES;
    const float* mod = (const float*)(p.ws + WS_MOD);
    for (int rb = gw; rb < T / 8; rb += NGW) {
        const int b = (rb * 8) / SEQ;
        f32x4 A[8], B[8];
#pragma unroll
        for (int j = 0; j < 8; ++j) { const int cidx = lane * 4 + 256 * j;
            const f32x4 g = *(const f32x4*)(ng + cidx);
            const f32x4 sh = *(const f32x4*)(mod + (size_t)b * NMOD + shift_chunk * DM + cidx);
            const f32x4 sc = *(const f32x4*)(mod + (size_t)b * NMOD + (shift_chunk + 1) * DM + cidx);
            A[j] = g * (sc + 1.0f); B[j] = sh; }
        for (int rr = 0; rr < 8; ++rr) {
            const int row = rb * 8 + rr;
            f32x4 v[8]; float s = 0.f;
            if (MODE == 0) { const f32x4* xr = (const f32x4*)((const float*)srcv + (size_t)row * DM) + lane;
#pragma unroll
                for (int j = 0; j < 8; ++j) { v[j] = __builtin_nontemporal_load(xr + 64 * j); s += (v[j][0] * v[j][0] + v[j][1] * v[j][1]) + (v[j][2] * v[j][2] + v[j][3] * v[j][3]); } }
            else { const v2u* xr = (const v2u*)((const bf16*)srcv + (size_t)row * DM) + lane;
#pragma unroll
                for (int j = 0; j < 8; ++j) { const v2u raw = xr[64 * j]; v[j] = (f32x4){bflo(raw.x), bfhi(raw.x), bflo(raw.y), bfhi(raw.y)}; } }
            float tot;
            if (MODE == 0) tot = wave_sum(s);
            else { float q = (lane < 32) ? ssp[(size_t)row * 32 + lane] : 0.f; tot = wave_sum(q); }
            const float rstd = 1.0f / sqrtf(tot * (1.0f / DM) + EPS);
            v2u* o8 = (v2u*)(dst + (size_t)row * DM) + lane;
#pragma unroll
            for (int j = 0; j < 8; ++j) { const f32x4 h = (v[j] * rstd) * A[j] + B[j]; v2u w; w.x = pk2(h[0], h[1]); w.y = pk2(h[2], h[3]); o8[64 * j] = w; }
        }
    }
}

__device__ __forceinline__ void phase_final(const Params& p, const float* ssp, int vcu, int G, const int wave_s) {
    const int tid = fresh_tid(wave_s), lane = tid & 63, wave = wave_s;
    const int gw = vcu * NWAVES + wave, NGW = G * NWAVES;
    f32x4 g[8];
#pragma unroll
    for (int j = 0; j < 8; ++j) g[j] = *(const f32x4*)(p.final_g + lane * 4 + 256 * j);
    for (int row = gw; row < T; row += NGW) {
        f32x4* xr = (f32x4*)(p.out + (size_t)row * DM) + lane;
        const v2u* xs = (const v2u*)((const bf16*)(p.ws + WS_X1) + (size_t)row * DM) + lane;
        f32x4 v[8];
#pragma unroll
        for (int j = 0; j < 8; ++j) { const v2u raw = xs[64 * j]; v[j] = (f32x4){bflo(raw.x), bfhi(raw.x), bflo(raw.y), bfhi(raw.y)}; }
        float q = (lane < 32) ? ssp[(size_t)row * 32 + lane] : 0.f; const float tot = wave_sum(q);
        const float rstd = 1.0f / sqrtf(tot * (1.0f / DM) + EPS);
#pragma unroll
        for (int j = 0; j < 8; ++j) xr[64 * j] = (v[j] * rstd) * g[j];
    }
}

constexpr int TP = 136;
__device__ __forceinline__ void gmlp_tile(const Params& p, LAS unsigned char* lds, int b, int n, int g, const int wave_s) {
    const int tid = fresh_tid(wave_s), lane = tid & 63, w = wave_s, r = lane & 15, cgp = lane >> 4;
    const bf16* PROJ = (const bf16*)(p.ws + WS_PROJ); bf16* O = (bf16*)(p.ws + WS_O);
    LAS bf16* Vt = (LAS bf16*)lds;
    const int tok0 = b * SEQ + n * 128;
    const int t = 16 * w + r;
    const float bsv = p.b_spatial[g * 128 + t];
    const bf16* urow = PROJ + (size_t)(tok0 + t) * NPROJ + g * 128 + cgp * 4;
    v2u uwv[8]; f32x4 ogv[8];
#pragma unroll
    for (int nd = 0; nd < 8; ++nd) { uwv[nd] = *(const v2u*)(urow + nd * 16); ogv[nd] = *(const f32x4*)(p.out_norm_g + g * 128 + nd * 16 + cgp * 4); }
    const float* wrow = p.w_spatial + (size_t)(g * 128 + t) * 128;
    f32x4 wq[4][2];
#pragma unroll
    for (int kk = 0; kk < 4; ++kk) { if (kk <= (w >> 1)) { wq[kk][0] = *(const f32x4*)(wrow + kk * 32 + cgp * 8); wq[kk][1] = *(const f32x4*)(wrow + kk * 32 + cgp * 8 + 4); } else { wq[kk][0] = (f32x4){0.f, 0.f, 0.f, 0.f}; wq[kk][1] = (f32x4){0.f, 0.f, 0.f, 0.f}; } }
    {
        const int s = 16 * w + r;
        const bf16* src = PROJ + (size_t)(tok0 + s) * NPROJ + 1024 + g * 128;
        float xv[4][8]; float s1 = 0.f;
#pragma unroll
        for (int pp = 0; pp < 4; ++pp) { const v4u raw = *(const v4u*)(src + (cgp * 4 + pp) * 8);
            xv[pp][0] = bflo(raw.x); xv[pp][1] = bfhi(raw.x); xv[pp][2] = bflo(raw.y); xv[pp][3] = bfhi(raw.y); xv[pp][4] = bflo(raw.z); xv[pp][5] = bfhi(raw.z); xv[pp][6] = bflo(raw.w); xv[pp][7] = bfhi(raw.w);
#pragma unroll
            for (int j = 0; j < 8; ++j) s1 += xv[pp][j]; }
        s1 += __shfl_xor(s1, 16); s1 += __shfl_xor(s1, 32);
        const float mean = s1 * (1.0f / 128.0f); float s2 = 0.f;
#pragma unroll
        for (int pp = 0; pp < 4; ++pp)
#pragma unroll
            for (int j = 0; j < 8; ++j) { xv[pp][j] -= mean; s2 += xv[pp][j] * xv[pp][j]; }
        s2 += __shfl_xor(s2, 16); s2 += __shfl_xor(s2, 32);
        const float rstd = 1.0f / sqrtf(s2 * (1.0f / 128.0f) + EPS);
#pragma unroll
        for (int pp = 0; pp < 4; ++pp) { const int d0 = (cgp * 4 + pp) * 8;
            const f32x4 g0 = *(const f32x4*)(p.v_norm_g + g * 128 + d0), g1 = *(const f32x4*)(p.v_norm_g + g * 128 + d0 + 4);
#pragma unroll
            for (int j = 0; j < 8; ++j) { const float y = xv[pp][j] * rstd * (j < 4 ? g0[j & 3] : g1[j & 3]); Vt[(d0 + j) * TP + s] = (bf16)(pk2(y, 0.f) & 0xffffu); } }
    }
    __syncthreads();
    f32x4 acc[8];
#pragma unroll
    for (int nd = 0; nd < 8; ++nd) acc[nd] = (f32x4){0.f, 0.f, 0.f, 0.f};
#pragma unroll
    for (int kk = 0; kk < 4; ++kk) {
        if (kk > (w >> 1)) break;
        const int s0 = kk * 32 + cgp * 8;
        const f32x4 w0 = wq[kk][0], w1 = wq[kk][1];
        float wv[8] = {w0[0], w0[1], w0[2], w0[3], w1[0], w1[1], w1[2], w1[3]};
#pragma unroll
        for (int j = 0; j < 8; ++j) wv[j] = (s0 + j <= t) ? wv[j] : 0.f;
        v4u wp; wp.x = pk2(wv[0], wv[1]); wp.y = pk2(wv[2], wv[3]); wp.z = pk2(wv[4], wv[5]); wp.w = pk2(wv[6], wv[7]);
        const bf16x8 wf = __builtin_bit_cast(bf16x8, wp);
#pragma unroll
        for (int nd = 0; nd < 8; ++nd) { const bf16x8 vf = *(const LAS bf16x8*)(Vt + (nd * 16 + r) * TP + s0);
            acc[nd] = __builtin_amdgcn_mfma_f32_16x16x32_bf16(vf, wf, acc[nd], 0, 0, 0); }
    }
    float ss = 0.f;
#pragma unroll
    for (int nd = 0; nd < 8; ++nd) { const v2u uw = uwv[nd];
        f32x4 o; o[0] = bflo(uw.x) * (acc[nd][0] + bsv); o[1] = bfhi(uw.x) * (acc[nd][1] + bsv); o[2] = bflo(uw.y) * (acc[nd][2] + bsv); o[3] = bfhi(uw.y) * (acc[nd][3] + bsv);
        acc[nd] = o; ss += (o[0] * o[0] + o[1] * o[1]) + (o[2] * o[2] + o[3] * o[3]); }
    ss += __shfl_xor(ss, 16); ss += __shfl_xor(ss, 32);
    const float rs = 1.0f / sqrtf(ss * (1.0f / 128.0f) + EPS);
    bf16* orow = O + (size_t)(tok0 + t) * DM + g * 128 + 16 * (cgp & 1) + 8 * (cgp >> 1);
    v2u pkv[8];
#pragma unroll
    for (int nd = 0; nd < 8; ++nd) { const f32x4 og = ogv[nd];
        pkv[nd].x = pk2(acc[nd][0] * rs * og[0], acc[nd][1] * rs * og[1]); pkv[nd].y = pk2(acc[nd][2] * rs * og[2], acc[nd][3] * rs * og[3]); }
#pragma unroll
    for (int k = 0; k < 4; ++k) {
        const auto sx = __builtin_amdgcn_permlane16_swap(pkv[2 * k].x, pkv[2 * k + 1].x, false, false);
        const auto sy = __builtin_amdgcn_permlane16_swap(pkv[2 * k].y, pkv[2 * k + 1].y, false, false);
        v4u w; w.x = sx[0]; w.y = sy[0]; w.z = sx[1]; w.w = sy[1];
        *(v4u*)(orow + 32 * k) = w; }
    __syncthreads();
}

typedef float f32x16 __attribute__((ext_vector_type(16)));
constexpr int TPK = 136, TPV = 132;
template <bool DIAG>
__device__ __forceinline__ void sb_tile(f32x16& z, float& run, int r, int hi) {
    float be[16], om[16];
#pragma unroll
    for (int i = 0; i < 16; ++i) { const float e = __builtin_amdgcn_exp2f(-z[i]);
        be[i] = __builtin_amdgcn_rcpf(1.0f + e); om[i] = 1.0f - be[i];
        if (DIAG) { const bool valid = (8 * (i >> 2) + 4 * hi + (i & 3)) < r; be[i] = valid ? be[i] : 0.f; om[i] = valid ? om[i] : 1.0f; } }
    float P[4], xo[4], Tt[4];
#pragma unroll
    for (int g = 0; g < 4; ++g) P[g] = (om[4 * g] * om[4 * g + 1]) * (om[4 * g + 2] * om[4 * g + 3]);
#pragma unroll
    for (int g = 0; g < 4; ++g) { const unsigned u = __float_as_uint(P[g]); const auto sw = __builtin_amdgcn_permlane32_swap(u, u, false, false);
        xo[g] = __uint_as_float(sw[1]); Tt[g] = __uint_as_float(sw[0]) * __uint_as_float(sw[1]); }
#pragma unroll
    for (int g = 3; g >= 0; --g) {
        float tl = run * (hi ? 1.0f : xo[g]); run *= Tt[g];
        z[4 * g + 3] = be[4 * g + 3] * tl; tl *= om[4 * g + 3];
        z[4 * g + 2] = be[4 * g + 2] * tl; tl *= om[4 * g + 2];
        z[4 * g + 1] = be[4 * g + 1] * tl; tl *= om[4 * g + 1];
        z[4 * g + 0] = be[4 * g + 0] * tl;
    }
}
__device__ __forceinline__ void sb_unit(const Params& p, LAS unsigned char* lds, int b, int h, int qb, const int wave_s) {
    const int tid = fresh_tid(wave_s), lane = tid & 63, w = wave_s, r = lane & 31, hi = lane >> 5;
    const bf16* PROJ = (const bf16*)(p.ws + WS_PROJ); const bf16* VT = (const bf16*)(p.ws + WS_VT); bf16* O = (bf16*)(p.ws + WS_O);
    LAS bf16* Ks = (LAS bf16*)lds;
    LAS bf16* Vs = (LAS bf16*)(lds + 2 * 128 * TPK * 2);
    const int tok0 = b * SEQ;
    const int qt = 8 * qb + w;
    bf16x8 qf[8];
    { const bf16* qrow = PROJ + (size_t)(tok0 + 32 * qt + r) * NPROJ + 2048 + h * 128 + 8 * hi;
#pragma unroll
      for (int st = 0; st < 8; ++st) qf[st] = *(const bf16x8*)(qrow + 16 * st);
#pragma unroll
      for (int st = 0; st < 8; ++st) asm volatile("" : "+v"(qf[st])); }
    const bf16* kbase = PROJ + (size_t)tok0 * NPROJ + 3072 + h * 128;
    const bf16* vbase = VT + (size_t)(h * 128) * T + tok0;
    v4u kr[4], vr[4];
#define SB_LOAD(jb) do { _Pragma("unroll") for (int pp = 0; pp < 4; ++pp) { const int c = tid + 512 * pp, rw = c >> 4, pc = c & 15; \
        kr[pp] = *(const v4u*)(kbase + (size_t)((jb) * 128 + rw) * NPROJ + pc * 8); vr[pp] = *(const v4u*)(vbase + (size_t)rw * T + (jb) * 128 + pc * 8); } } while (0)
#define SB_STORE(buf) do { _Pragma("unroll") for (int pp = 0; pp < 4; ++pp) { const int c = tid + 512 * pp, rw = c >> 4, pc = c & 15; \
        *(LAS v4u*)(Ks + ((buf) * 128 + rw) * TPK + pc * 8) = kr[pp]; \
        LAS v2u* vd = (LAS v2u*)(Vs + ((buf) * 128 + rw) * TPV + pc * 8); v2u lo2, hi2; lo2.x = vr[pp].x; lo2.y = vr[pp].y; hi2.x = vr[pp].z; hi2.y = vr[pp].w; vd[0] = lo2; vd[1] = hi2; } } while (0)
    f32x16 oacc[4];
#pragma unroll
    for (int dt = 0; dt < 4; ++dt)
#pragma unroll
        for (int i = 0; i < 16; ++i) oacc[dt][i] = 0.f;
    float run = 1.0f;
    const int jtop = 2 * qb + 1;
    SB_LOAD(jtop); SB_STORE(0);
    __syncthreads();
    for (int jb = jtop; jb >= 0; --jb) {
        const int cur = (jtop - jb) & 1;
        if (jb > 0) SB_LOAD(jb - 1);
#pragma unroll 1
        for (int c = 3; c >= 0; --c) {
            const int kt = 4 * jb + c;
            if (kt > qt) continue;
            const bool diag = (kt == qt);
            const LAS bf16* kp = Ks + (cur * 128 + 32 * c + r) * TPK + 8 * hi;
            bf16x8 kf[8];
#pragma unroll
            for (int st = 0; st < 8; ++st) kf[st] = *(const LAS bf16x8*)(kp + 16 * st);
            __builtin_amdgcn_sched_barrier(0);
            f32x16 z;
#pragma unroll
            for (int i = 0; i < 16; ++i) z[i] = 0.f;
#pragma unroll
            for (int st = 0; st < 8; ++st) z = __builtin_amdgcn_mfma_f32_32x32x16_bf16(kf[st], qf[st], z, 0, 0, 0);
            __builtin_amdgcn_sched_barrier(0);
            v2u vlo[2][4], vhh[2][4];
#pragma unroll
            for (int s2 = 0; s2 < 2; ++s2)
#pragma unroll
                for (int dt = 0; dt < 4; ++dt) { const LAS bf16* vp = Vs + (cur * 128 + 32 * dt + r) * TPV + 32 * c + 16 * s2 + 4 * hi;
                    vlo[s2][dt] = *(const LAS v2u*)vp; vhh[s2][dt] = *(const LAS v2u*)(vp + 8); }
            __builtin_amdgcn_sched_barrier(0);
            if (diag) sb_tile<true>(z, run, r, hi); else sb_tile<false>(z, run, r, hi);
            __builtin_amdgcn_sched_barrier(0);
#pragma unroll
            for (int s2 = 0; s2 < 2; ++s2) {
                v4u pw; pw.x = pk2(z[8 * s2 + 0], z[8 * s2 + 1]); pw.y = pk2(z[8 * s2 + 2], z[8 * s2 + 3]); pw.z = pk2(z[8 * s2 + 4], z[8 * s2 + 5]); pw.w = pk2(z[8 * s2 + 6], z[8 * s2 + 7]);
                const bf16x8 pf = __builtin_bit_cast(bf16x8, pw);
#pragma unroll
                for (int dt = 0; dt < 4; ++dt) { v4u vw; vw.x = vlo[s2][dt].x; vw.y = vlo[s2][dt].y; vw.z = vhh[s2][dt].x; vw.w = vhh[s2][dt].y;
                    oacc[dt] = __builtin_amdgcn_mfma_f32_32x32x16_bf16(__builtin_bit_cast(bf16x8, vw), pf, oacc[dt], 0, 0, 0); }
            }
        }
        if (jb > 0) SB_STORE(cur ^ 1);
        __syncthreads();
    }
#undef SB_LOAD
#undef SB_STORE
    float ss = 0.f;
#pragma unroll
    for (int dt = 0; dt < 4; ++dt)
#pragma unroll
        for (int i = 0; i < 16; ++i) ss += oacc[dt][i] * oacc[dt][i];
    ss += __shfl_xor(ss, 32);
    const float rs = 1.0f / sqrtf(ss * (1.0f / 128.0f) + EPS);
    bf16* orow = O + (size_t)(tok0 + 32 * qt + r) * DM + 1024 + h * 128 + 8 * hi;
    const float* ogp = p.out_norm_g + 1024 + h * 128 + 4 * hi;
    f32x4 ogv[4][4];
#pragma unroll
    for (int dt = 0; dt < 4; ++dt)
#pragma unroll
        for (int g = 0; g < 4; ++g) ogv[dt][g] = *(const f32x4*)(ogp + 32 * dt + 8 * g);
#pragma unroll
    for (int dt = 0; dt < 4; ++dt) {
        v2u pk[4];
#pragma unroll
        for (int g = 0; g < 4; ++g) { const f32x4 og = ogv[dt][g];
            pk[g].x = pk2(oacc[dt][4 * g + 0] * rs * og[0], oacc[dt][4 * g + 1] * rs * og[1]); pk[g].y = pk2(oacc[dt][4 * g + 2] * rs * og[2], oacc[dt][4 * g + 3] * rs * og[3]); }
#pragma unroll
        for (int k = 0; k < 2; ++k) {
            const auto sx = __builtin_amdgcn_permlane32_swap(pk[2 * k].x, pk[2 * k + 1].x, false, false);
            const auto sy = __builtin_amdgcn_permlane32_swap(pk[2 * k].y, pk[2 * k + 1].y, false, false);
            v4u w; w.x = sx[0]; w.y = sy[0]; w.z = sx[1]; w.w = sy[1];
            *(v4u*)(orow + 32 * dt + 16 * k) = w; }
    }
}

template <int HALF_ID>
__device__ __forceinline__ void mixers_half(const Params& p, LAS unsigned char* lds, int vcu, int G, const int wave_s) {
    if ((HALF_ID ^ (vcu & 1)) == 0) {
        for (int pr = vcu; pr < 256; pr += G) {
            const int bh = pr >> 2, ip = pr & 3, b = bh >> 3, h = bh & 7;
            sb_unit(p, lds, b, h, 7 - ip, wave_s);
            sb_unit(p, lds, b, h, ip, wave_s);
        }
    } else {
        for (int tl = vcu; tl < 1024; tl += G) { const int g = tl & 7, n = (tl >> 3) & 15, b = tl >> 7; gmlp_tile(p, lds, b, n, g, wave_s); }
    }
}
__device__ __forceinline__ void phase_mixers(const Params& p, LAS unsigned char* lds, int vcu, int G, const int wave_s) {
    mixers_half<0>(p, lds, vcu, G, wave_s);
    transpose_items(p, lds, TR_IN, TR_ALL, vcu, G, wave_s);
    __syncthreads();
    mixers_half<1>(p, lds, vcu, G, wave_s);
}

#define XB_TMO      128
#define XB_XCNT(j)  (256  + 64 * (j))
#define XB_XSUB(j)  (1280 + 64 * (j))
#define XB_XGEN(j)  (2304 + 64 * (j))
#define XB_TOP      3328
#define XB_TOPGEN   3392
#define XCD_BAR_WORDS 3456
#define XB_SPIN_CAP (1u << 18)

__device__ __forceinline__ unsigned xb_ld(unsigned* p)              { return __hip_atomic_load(p, __ATOMIC_RELAXED, __HIP_MEMORY_SCOPE_AGENT); }
__device__ __forceinline__ unsigned xb_add(unsigned* p, unsigned v) { return __hip_atomic_fetch_add(p, v, __ATOMIC_RELAXED, __HIP_MEMORY_SCOPE_AGENT); }
__device__ __forceinline__ unsigned xb_xcc_id() { return (unsigned)__builtin_amdgcn_s_getreg((3 << 11) | 20) & 0xFu; }
#define XB_SPIN(cond, bar) do { unsigned _sp = 0; while (cond) { __builtin_amdgcn_s_sleep(1); \
    if ((++_sp & 255u) == 0u) { if (xb_ld(&(bar)[XB_TMO])) break; if (_sp > XB_SPIN_CAP) { atomicAdd(&(bar)[XB_TMO], 1u); break; } } } } while (0)

struct XcdBarrier {
    unsigned* bar; unsigned x; int w;
    volatile LAS unsigned* st;
};

__device__ __forceinline__ XcdBarrier xcd_barrier_post(unsigned* bar, volatile LAS unsigned* st, int wave_s) {
    XcdBarrier b; b.bar = bar; b.x = xb_xcc_id(); b.st = st; b.w = wave_s;
    if (wave_s == 0 && lane_id() == 0) (void)xb_add(&bar[XB_XCNT(b.x)], 1u);
    return b;
}
__device__ __forceinline__ void xcd_barrier_complete(unsigned* bar, unsigned x, unsigned& nloc, unsigned& nx) {
    const unsigned G = gridDim.x * gridDim.y * gridDim.z;
    unsigned sum, cnt, mine, sp = 0u;
    for (;;) {
        sum = 0u; cnt = 0u; mine = 0u;
#pragma unroll
        for (unsigned j = 0; j < 16; ++j) { const unsigned c = xb_ld(&bar[XB_XCNT(j)]); sum += c; cnt += (c > 0u) ? 1u : 0u; mine = (j == x) ? c : mine; }
        if (sum == G) break;
        __builtin_amdgcn_s_sleep(1);
        if ((++sp & 255u) == 0u) { if (xb_ld(&bar[XB_TMO])) break; if (sp > XB_SPIN_CAP) { atomicAdd(&bar[XB_TMO], 1u); break; } }
    }
    nloc = mine > 0u ? mine : 1u; nx = cnt > 0u ? cnt : 1u;
}

__device__ __forceinline__ void xcd_barrier(const XcdBarrier& b) {
    asm volatile("s_waitcnt vmcnt(0)" ::: "memory");
    __syncthreads();
    if (b.w == 0 && lane_id() == 0) {
        unsigned* bar = b.bar;
        __builtin_amdgcn_s_waitcnt(0);
        unsigned nloc = b.st[0], nx = b.st[1];
        if (nloc == 0u) { xcd_barrier_complete(bar, b.x, nloc, nx); b.st[0] = nloc; b.st[1] = nx; }
        const unsigned old = xb_add(&bar[XB_XSUB(b.x)], 1u);
        const unsigned gen = old / nloc;
        if (old + 1u == (gen + 1u) * nloc) {
            __builtin_amdgcn_fence(__ATOMIC_RELEASE, "agent");
            asm volatile("s_waitcnt vmcnt(0)" ::: "memory");
            const unsigned og = xb_add(&bar[XB_TOP], 1u);
            const unsigned tg = og / nx;
            if (og + 1u == (tg + 1u) * nx) xb_add(&bar[XB_TOPGEN], 1u);
            else XB_SPIN(xb_ld(&bar[XB_TOPGEN]) == tg, bar);
            __builtin_amdgcn_fence(__ATOMIC_ACQUIRE, "agent");
            xb_add(&bar[XB_XGEN(b.x)], 1u);
            asm volatile("s_waitcnt vmcnt(0)" ::: "memory");
        } else {
            XB_SPIN(xb_ld(&bar[XB_XGEN(b.x)]) == gen, bar);
            __builtin_amdgcn_fence(__ATOMIC_ACQUIRE, "agent");
            asm volatile("s_waitcnt vmcnt(0)" ::: "memory");
        }
    }
    __syncthreads();
}

#ifndef PH_MASK
#define PH_MASK 0x3ff
#endif
#define PH(k) if constexpr ((PH_MASK >> (k)) & 1)
#ifndef DUP_MASK
#define DUP_MASK 0
#endif
#define DUP(k) _Pragma("unroll 1") for (int _r = 0; _r < ((((DUP_MASK) >> (k)) & 1) ? 2 : 1); ++_r)
__global__ void __launch_bounds__(NTHREADS, 2) fwd_megakernel(Params p) {
    extern __shared__ __attribute__((aligned(16))) unsigned char lds_raw[];
    LAS unsigned char* lds = (LAS unsigned char*)lds_raw;
    cg::grid_group grid = cg::this_grid();
    if (p.ws == nullptr) grid.sync();
    volatile LAS unsigned* bst = (volatile LAS unsigned*)(lds + LDS_BYTES - 64);
    const int wave_s = __builtin_amdgcn_readfirstlane((int)(threadIdx.x >> 6));
    if (wave_s == 0 && lane_id() == 0) { bst[0] = 0u; bst[1] = 0u; }
    __syncthreads();
    const XcdBarrier bar = xcd_barrier_post((unsigned*)(p.ws + WS_BAR), bst, wave_s);
    const int G = gridDim.x, bx = blockIdx.x;
    const int vcu = (G % 8 == 0) ? (bx % 8) * (G / 8) + bx / 8 : bx;
    unsigned char* ws = p.ws;
    bf16* Win = (bf16*)(ws + WS_WIN); bf16* Wout = (bf16*)(ws + WS_WOUT); bf16* Wgu = (bf16*)(ws + WS_WGU); bf16* Wdn = (bf16*)(ws + WS_WDN);
    bf16* H = (bf16*)(ws + WS_H); bf16* PROJ = (bf16*)(ws + WS_PROJ); bf16* VT = (bf16*)(ws + WS_VT); bf16* O = (bf16*)(ws + WS_O); bf16* GU = (bf16*)(ws + WS_GU); bf16* X1 = (bf16*)(ws + WS_X1);
    float* mod = (float*)(ws + WS_MOD); float* SS1 = (float*)(ws + WS_SS1); float* SS2 = (float*)(ws + WS_SS2);

#if TS_SEL >= 0
    unsigned long long* tsb = (unsigned long long*)(ws + 49152 + 1024);
#define STAMP(k) do { if (bx == 0 && wave_s == 0 && lane_id() == 0) __hip_atomic_store(tsb + (k), (unsigned long long)__builtin_amdgcn_s_memrealtime(), __ATOMIC_RELAXED, __HIP_MEMORY_SCOPE_AGENT); } while (0)
#else
#define STAMP(k) do { } while (0)
#endif
    STAMP(0);
    PH(0) DUP(0) phase_prep(p, lds, vcu, G, wave_s);
    { if (wave_s == 0) { unsigned sp = 0;
          while ((unsigned)__builtin_amdgcn_readfirstlane(__hip_atomic_load((unsigned*)(ws + WS_MODCNT), __ATOMIC_RELAXED, __HIP_MEMORY_SCOPE_AGENT)) < (unsigned)(NMOD / 64)) { __builtin_amdgcn_s_sleep(2); if (++sp > (1u << 22)) break; }
          __builtin_amdgcn_fence(__ATOMIC_ACQUIRE, "agent"); asm volatile("s_waitcnt vmcnt(0)" ::: "memory"); }
      __syncthreads(); }
    STAMP(1);
    PH(1) DUP(1) phase_norm_mod<0>(p, p.x, nullptr, p.norm1_g, 0, H, vcu, G, wave_s);
    xcd_barrier(bar); STAMP(2);
    PH(2) DUP(2) {
        pg8::Gemm g{H, Win, T, NPROJ, DM}; pg8::StaticOrder S; S.init(T, NPROJ, G, bx);
        pg8::EpiProj E{PROJ, NPROJ, 8, 8, 12, QSCALE};
        pg8::gemm_phase<pg8::EpiProj, pg8::StaticOrder, true, true>(lds, g, S, E, wave_s);
    }
    PH(9) DUP(2) {
        pg8::Gemm g{Win + (size_t)NPROJ * DM, H, 1024, T, DM}; pg8::StaticOrder S; S.init(1024, T, G, bx);
        pg8::EpiProj E{VT, T, 0, 0, 0, 1.f};
        pg8::gemm_phase<pg8::EpiProj, pg8::StaticOrder, true, true>(lds, g, S, E, wave_s);
    }
    xcd_barrier(bar); STAMP(3);
    PH(3) DUP(3) phase_mixers(p, lds, vcu, G, wave_s);
    xcd_barrier(bar); STAMP(4);
    PH(4) DUP(4) {
        pg8::Gemm g{O, Wout, T, DM, DM}; pg8::PanelOrder S; S.init(T, DM, G, bx);
        pg8::EpiResNorm<0> E{p.x, X1, mod + 2 * DM, SS1, (unsigned*)(ws + WS_CNT1), H, p.norm2_g, mod, 3, nullptr, nullptr, lds + 131072};
        pg8::gemm_phase<pg8::EpiResNorm<0>, pg8::PanelOrder, true, true>(lds, g, S, E, wave_s);
    }
    xcd_barrier(bar); STAMP(5);
    PH(6) DUP(6) {
        pg8::Gemm g{H, Wgu, T, 2 * DFF, DM}; pg8::StaticOrder S; S.init(T, 2 * DFF, G, bx);
        pg8::EpiGU E{GU, DFF};
        pg8::gemm_phase<pg8::EpiGU, pg8::StaticOrder, true, true>(lds, g, S, E, wave_s);
    }
    xcd_barrier(bar); STAMP(6);
    PH(7) {
        pg8::Gemm g{GU, Wdn, T, DM, DFF}; pg8::PanelOrder S; S.init(T, DM, G, bx);
        pg8::EpiResNorm<1> E{X1, X1, mod + 5 * DM, SS2, (unsigned*)(ws + WS_CNT2), nullptr, nullptr, nullptr, 0, p.out, p.final_g, lds + 131072};
        pg8::gemm_phase<pg8::EpiResNorm<1>, pg8::PanelOrder, true, true>(lds, g, S, E, wave_s);
    }
#if TS_SEL >= 0
    xcd_barrier(bar); STAMP(7);
    xcd_barrier(bar);
    { const unsigned long long t0 = __hip_atomic_load(tsb + TS_SEL, __ATOMIC_RELAXED, __HIP_MEMORY_SCOPE_AGENT), t1 = __hip_atomic_load(tsb + TS_SEL + 1, __ATOMIC_RELAXED, __HIP_MEMORY_SCOPE_AGENT);
#ifdef TS_CAL
      const float pert = 1.0f + sqrtf((float)TS_CAL * 8e-7f * TS_SCALE) + 0.0f * (float)(t1 - t0);
#else
      const float pert = 1.0f + sqrtf((float)(t1 - t0) * 0.01f * 8e-7f * TS_SCALE);
#endif
      for (size_t i = (size_t)bx * NTHREADS + fresh_tid(wave_s); i < (size_t)SEQ * DM / 4; i += (size_t)G * NTHREADS) { f32x4 v = ((f32x4*)p.out)[i]; v = v * pert; ((f32x4*)p.out)[i] = v; } }
#endif
}

extern "C" void kernel_launch(void* const* d_in, const int* in_sizes, int n_in, void* d_out, int out_size, void* d_ws, size_t ws_size, hipStream_t stream) {
    static int grid_blocks = 0;
    if (grid_blocks == 0) {
        if (n_in != 16 || ws_size < WS_END) { fprintf(stderr, "kernel_launch: unexpected n_in %d / ws_size %zu (need %zu)\n", n_in, ws_size, (size_t)WS_END); grid_blocks = -1; return; }
        int dev = 0, cus = 0, per_cu = 0;
        (void)hipGetDevice(&dev);
        (void)hipDeviceGetAttribute(&cus, hipDeviceAttributeMultiprocessorCount, dev);
        if (hipFuncSetAttribute((const void*)fwd_megakernel, hipFuncAttributeMaxDynamicSharedMemorySize, LDS_BYTES) != hipSuccess) { fprintf(stderr, "kernel_launch: hipFuncSetAttribute failed\n"); grid_blocks = -1; return; }
        if (hipOccupancyMaxActiveBlocksPerMultiprocessor(&per_cu, (const void*)fwd_megakernel, NTHREADS, LDS_BYTES) != hipSuccess || per_cu < 1) { fprintf(stderr, "kernel_launch: occupancy query says %d\n", per_cu); per_cu = 1; }
        (void)hipGetLastError();
        if (cus != 256) { fprintf(stderr, "kernel_launch: built for a 256-CU device (the fused-norm epilogues need exactly 256 workgroups); found %d CUs, nothing launched\n", cus); grid_blocks = -1; return; }
        grid_blocks = cus * 1;
    }
    if (grid_blocks < 0) return;
    if (hipMemsetAsync((char*)d_ws + WS_BAR, 0, 49152, stream) != hipSuccess) { fprintf(stderr, "kernel_launch: memset failed\n"); return; }
    Params p{};
    p.x = (const float*)d_in[0]; p.c = (const float*)d_in[1]; p.w_ada = (const float*)d_in[2]; p.b_ada = (const float*)d_in[3]; p.norm1_g = (const float*)d_in[4];
    p.w_in = (const float*)d_in[5]; p.v_norm_g = (const float*)d_in[6]; p.w_spatial = (const float*)d_in[7]; p.b_spatial = (const float*)d_in[8]; p.out_norm_g = (const float*)d_in[9];
    p.w_out = (const float*)d_in[10]; p.norm2_g = (const float*)d_in[11]; p.w_gate = (const float*)d_in[12]; p.w_up = (const float*)d_in[13]; p.w_down = (const float*)d_in[14]; p.final_g = (const float*)d_in[15];
    p.out = (float*)d_out; p.ws = (unsigned char*)d_ws;
    void* args[] = {&p};
    hipError_t e = hipLaunchCooperativeKernel((const void*)fwd_megakernel, dim3(grid_blocks), dim3(NTHREADS), args, LDS_BYTES, stream);
    if (e != hipSuccess) fprintf(stderr, "cooperative launch failed: %s (grid %d)\n", hipGetErrorString(e), grid_blocks);
}
```
